# Optimizing an MI355X kernel written in HIP

```python
import jax, jax.numpy as jnp
from jax import lax
import numpy as np

D_MODEL = 1024
BATCH = 8
SEQ = 2048
DEPTH = 1
DEC_BATCH = 128
DEC_SEQ = 4
PAST_LEN = 8192
PAGE_SIZE = 128

N_META = 16
N_HEADS = 8
QK_NOPE = 64
QK_ROPE = 32
V_HEAD = 64
QK_HEAD = QK_NOPE + QK_ROPE
Q_LORA = 384
KV_LORA = 256
ATTN_WIDTH = N_HEADS * V_HEAD
CONV_CH = D_MODEL - ATTN_WIDTH
CONV_GROUPS = 8
CONV_W = 3
D_FF = 4 * D_MODEL
IN_WIDTH = Q_LORA + KV_LORA + QK_ROPE + 3 * CONV_CH
ROPE_THETA = 10000.0
EPS = 1e-6
Q_BLOCK = 128
ATTN_SCALE = QK_HEAD ** -0.5

kernel_name = "hymba_mla_shortconv_decode_step"


def _rmsnorm(x, g):
    xf = x.astype(jnp.float32)
    y = xf * lax.rsqrt(jnp.mean(xf * xf, axis=-1, keepdims=True) + EPS)
    return (y * g.astype(jnp.float32)).astype(x.dtype)


def _rope_tables(pos):
    inv_freq = ROPE_THETA ** (-(jnp.arange(0, QK_ROPE, 2, dtype=jnp.float32) / QK_ROPE))
    ang = pos.astype(jnp.float32)[:, None] * inv_freq[None, :]
    return jnp.cos(ang), jnp.sin(ang)


def _apply_rope(x, cos, sin):
    xf = x.astype(jnp.float32)
    x1, x2 = xf[..., : QK_ROPE // 2], xf[..., QK_ROPE // 2:]
    out = jnp.concatenate([x1 * cos - x2 * sin, x2 * cos + x1 * sin], axis=-1)
    return out.astype(x.dtype)


def _mixer_inputs(h, w_in, q_lora_g, kv_lora_g, w_uq, q_norm_g, cos, sin):
    B, T = h.shape[0], h.shape[1]
    z = h @ w_in
    o1 = Q_LORA
    o2 = o1 + KV_LORA
    o3 = o2 + QK_ROPE
    o4 = o3 + CONV_CH
    o5 = o4 + CONV_CH
    cq, ckv, kpe = z[..., :o1], z[..., o1:o2], z[..., o2:o3]
    gb, gc, hc = z[..., o3:o4], z[..., o4:o5], z[..., o5:]
    q = (_rmsnorm(cq, q_lora_g) @ w_uq).reshape(B, T, N_HEADS, QK_HEAD)
    q_pe = _apply_rope(q[..., QK_NOPE:], cos[:, None, :], sin[:, None, :])
    q = _rmsnorm(jnp.concatenate([q[..., :QK_NOPE], q_pe], axis=-1), q_norm_g)
    lat = _rmsnorm(ckv, kv_lora_g)
    k_pe = _apply_rope(kpe, cos, sin)
    u = gc * hc
    return q, lat, k_pe, gb, u


def _expand_kv(lat, k_pe, w_ukv, k_norm_g):
    kv = (lat @ w_ukv).reshape(lat.shape[:-1] + (N_HEADS, QK_NOPE + V_HEAD))
    k_nope, v = kv[..., :QK_NOPE], kv[..., QK_NOPE:]
    k_rot = jnp.broadcast_to(k_pe[..., None, :], k_nope.shape[:-1] + (QK_ROPE,))
    k = _rmsnorm(jnp.concatenate([k_nope, k_rot], axis=-1), k_norm_g)
    return k, v


def _prompt_attention(q, k, v):
    B, T = q.shape[0], q.shape[1]
    nb = -(-T // Q_BLOCK)
    Tp = nb * Q_BLOCK
    pad = ((0, 0), (0, Tp - T), (0, 0), (0, 0))
    q, k, v = jnp.pad(q, pad), jnp.pad(k, pad), jnp.pad(v, pad)
    qb = q.reshape(B, nb, Q_BLOCK, N_HEADS, QK_HEAD).transpose(1, 0, 2, 3, 4)
    kpos = jnp.arange(Tp)

    def block(args):
        qblk, i = args
        qpos = i * Q_BLOCK + jnp.arange(Q_BLOCK)
        s = jnp.einsum('bqhd,bkhd->bhqk', qblk, k).astype(jnp.float32) * ATTN_SCALE
        s = jnp.where(kpos[None, :] <= qpos[:, None], s, -jnp.inf)
        p = jax.nn.softmax(s, axis=-1).astype(v.dtype)
        return jnp.einsum('bhqk,bkhd->bqhd', p, v)

    out = lax.map(block, (qb, jnp.arange(nb)))
    out = out.transpose(1, 0, 2, 3, 4).reshape(B, Tp, N_HEADS, V_HEAD)
    return out[:, :T]


def _sample_attention(q, lat_new, kpe_new, page_table, cache_lat, cache_kpe, w_ukv, k_norm_g):
    S = q.shape[1]
    past = page_table.shape[1] * PAGE_SIZE
    L = past + S
    kidx = jnp.arange(L)
    qidx = past + jnp.arange(S)
    mask = kidx[None, :] <= qidx[:, None]

    def one(args):
        pages, qs, lat, kp = args
        lat_all = jnp.concatenate([cache_lat[pages].reshape(past, KV_LORA), lat], axis=0)
        kp_all = jnp.concatenate([cache_kpe[pages].reshape(past, QK_ROPE), kp], axis=0)
        k, v = _expand_kv(lat_all, kp_all, w_ukv, k_norm_g)
        s = jnp.einsum('qhd,khd->hqk', qs, k).astype(jnp.float32) * ATTN_SCALE
        s = jnp.where(mask[None], s, -jnp.inf)
        p = jax.nn.softmax(s, axis=-1).astype(v.dtype)
        return jnp.einsum('hqk,khd->qhd', p, v)

    return lax.map(one, (page_table, q, lat_new, kpe_new))


def _short_conv(u_padded, gb, conv_w, conv_b):
    T = gb.shape[1]
    y = conv_b
    for j in range(CONV_W):
        y = y + u_padded[:, j:j + T] * conv_w[j]
    return gb * y


def _merge_and_ffn(x, attn, conv, attn_out_g, conv_out_g, w_o, norm_ffn_g, w_up, w_down):
    B, T = x.shape[0], x.shape[1]
    mix = jnp.concatenate([_rmsnorm(attn.reshape(B, T, ATTN_WIDTH), attn_out_g),
                           _rmsnorm(conv, conv_out_g)], axis=-1)
    x = x + mix @ w_o
    hf = _rmsnorm(x, norm_ffn_g)
    return x + jnp.square(jax.nn.relu(hf @ w_up)) @ w_down


def setup_inputs(seed: int = 0) -> dict:
    key = jax.random.key(seed)
    ks = jax.random.split(key, 24)
    n_pages = PAST_LEN // PAGE_SIZE
    n_pool = (DEC_BATCH * n_pages * 5) // 4
    f32 = jnp.float32

    def nrm(k, shape, scale):
        return jax.random.normal(k, shape, f32) * scale

    def gain(k, shape):
        return 1.0 + 0.02 * jax.random.normal(k, shape, f32)

    page_table = jax.random.permutation(ks[5], n_pool)[: DEC_BATCH * n_pages]
    page_table = page_table.reshape(DEC_BATCH, n_pages).astype(jnp.int32)
    return {
        "x_prompt": nrm(ks[0], (BATCH, SEQ, D_MODEL), 1.0),
        "x_sample": nrm(ks[1], (DEC_BATCH, DEC_SEQ, D_MODEL), 1.0),
        "cache_kv_latent": nrm(ks[2], (DEPTH, n_pool, PAGE_SIZE, KV_LORA), 1.0),
        "cache_k_rope": nrm(ks[3], (DEPTH, n_pool, PAGE_SIZE, QK_ROPE), 1.0),
        "state_conv": nrm(ks[4], (DEPTH, DEC_BATCH, CONV_W - 1, CONV_CH), 1.0),
        "page_table": page_table,
        "meta_tokens": nrm(ks[6], (N_META, D_MODEL), 1.0),
        "norm_mix_g": gain(ks[7], (DEPTH, D_MODEL)),
        "w_in": nrm(ks[8], (DEPTH, D_MODEL, IN_WIDTH), D_MODEL ** -0.5),
        "q_lora_g": gain(ks[9], (DEPTH, Q_LORA)),
        "kv_lora_g": gain(ks[10], (DEPTH, KV_LORA)),
        "w_uq": nrm(ks[11], (DEPTH, Q_LORA, N_HEADS * QK_HEAD), Q_LORA ** -0.5),
        "w_ukv": nrm(ks[12], (DEPTH, KV_LORA, N_HEADS * (QK_NOPE + V_HEAD)), KV_LORA ** -0.5),
        "q_norm_g": gain(ks[13], (DEPTH, QK_HEAD)),
        "k_norm_g": gain(ks[14], (DEPTH, QK_HEAD)),
        "conv_w": nrm(ks[15], (DEPTH, CONV_W, CONV_CH), CONV_W ** -0.5),
        "conv_b": nrm(ks[16], (DEPTH, CONV_CH), 0.01),
        "attn_out_g": gain(ks[17], (DEPTH, ATTN_WIDTH)),
        "conv_out_g": gain(ks[18], (DEPTH, CONV_CH)),
        "w_o": nrm(ks[19], (DEPTH, D_MODEL, D_MODEL), D_MODEL ** -0.5),
        "norm_ffn_g": gain(ks[20], (DEPTH, D_MODEL)),
        "w_up": nrm(ks[21], (DEPTH, D_MODEL, D_FF), D_MODEL ** -0.5),
        "w_down": nrm(ks[22], (DEPTH, D_FF, D_MODEL), D_FF ** -0.5),
    }


def reference(x_prompt, x_sample, cache_kv_latent, cache_k_rope, state_conv, page_table, meta_tokens,
              norm_mix_g, w_in, q_lora_g, kv_lora_g, w_uq, w_ukv, q_norm_g, k_norm_g, conv_w, conv_b,
              attn_out_g, conv_out_g, w_o, norm_ffn_g, w_up, w_down):
    B = x_prompt.shape[0]
    meta = jnp.broadcast_to(meta_tokens[None].astype(x_prompt.dtype), (B, N_META, D_MODEL))
    xp = jnp.concatenate([meta, x_prompt], axis=1)
    xs = x_sample
    Tp = xp.shape[1]
    S = xs.shape[1]
    past = page_table.shape[1] * PAGE_SIZE
    cos_p, sin_p = _rope_tables(jnp.arange(Tp))
    cos_s, sin_s = _rope_tables(past + jnp.arange(S))

    lat_p_all, kpe_p_all, conv_p_all = [], [], []
    lat_s_all, kpe_s_all, conv_s_all = [], [], []
    for l in range(DEPTH):
        hp = _rmsnorm(xp, norm_mix_g[l])
        q, lat, kpe, gb, u = _mixer_inputs(hp, w_in[l], q_lora_g[l], kv_lora_g[l], w_uq[l],
                                           q_norm_g[l], cos_p, sin_p)
        k, v = _expand_kv(lat, kpe, w_ukv[l], k_norm_g[l])
        attn = _prompt_attention(q, k, v)
        up = jnp.concatenate([jnp.zeros((B, CONV_W - 1, CONV_CH), u.dtype), u], axis=1)
        conv = _short_conv(up, gb, conv_w[l], conv_b[l])
        xp = _merge_and_ffn(xp, attn, conv, attn_out_g[l], conv_out_g[l], w_o[l],
                            norm_ffn_g[l], w_up[l], w_down[l])
        lat_p_all.append(lat)
        kpe_p_all.append(kpe)
        conv_p_all.append(up[:, -(CONV_W - 1):])

        hs = _rmsnorm(xs, norm_mix_g[l])
        q, lat, kpe, gb, u = _mixer_inputs(hs, w_in[l], q_lora_g[l], kv_lora_g[l], w_uq[l],
                                           q_norm_g[l], cos_s, sin_s)
        attn = _sample_attention(q, lat, kpe, page_table, cache_kv_latent[l], cache_k_rope[l],
                                 w_ukv[l], k_norm_g[l])
        us = jnp.concatenate([state_conv[l].astype(u.dtype), u], axis=1)
        conv = _short_conv(us, gb, conv_w[l], conv_b[l])
        xs = _merge_and_ffn(xs, attn, conv, attn_out_g[l], conv_out_g[l], w_o[l],
                            norm_ffn_g[l], w_up[l], w_down[l])
        lat_s_all.append(lat)
        kpe_s_all.append(kpe)
        conv_s_all.append(us[:, -(CONV_W - 1):])

    y_prompt = xp[:, N_META:]
    y_sample = xs
    return (y_prompt, y_sample,
            jnp.stack(lat_p_all), jnp.stack(kpe_p_all), jnp.stack(conv_p_all),
            jnp.stack(lat_s_all), jnp.stack(kpe_s_all), jnp.stack(conv_s_all))
```

```cpp
#include <hip/hip_runtime.h>
#include <cstdio>
#include <cstdint>
namespace pg8 {
#define PG8_LAS __attribute__((address_space(3)))
typedef unsigned short bf16_t;
typedef short bf16x8 __attribute__((ext_vector_type(8)));
typedef float f32x4 __attribute__((ext_vector_type(4)));
typedef unsigned u32x4 __attribute__((ext_vector_type(4)));
constexpr int BM = 256, BK = 64, HALF = 128, HTB = HALF * BK * 2  , STAGE_BYTES = 8 * HTB, NXCD = 8, WGM = 8;

__host__ __device__ __forceinline__ int lds_byte(int r, int c) { const int st = (r >> 4) * 2 + (c >> 5), rr = r & 15, cc = c & 31, ob = rr * 64 + cc * 2; return st * 1024 + (ob ^ (((ob >> 9) & 1) << 5)); }
__host__ __device__ __forceinline__ void stage_rc(int b, int& R, int& C) { const int st = b / 1024, sb = b % 1024, swz = sb ^ (((sb >> 9) & 1) << 5); R = (st >> 1) * 16 + swz / 64; C = (st & 1) * 32 + (swz % 64) / 2; }
__host__ __device__ __forceinline__ int perm32(int rho) { const int n = rho >> 4, i = rho & 15; return 8 * (i >> 2) + 4 * n + (i & 3); }

struct Unit { int pm, pn; };
struct Gemm { const bf16_t* A; const bf16_t* Bt; int M, N, K; };

struct StaticOrder {
    int nM, nN, nwg, G, c;
    __host__ __device__ void init(int M, int N, int G_, int c_) { nM = M / BM; nN = N / BM; nwg = nM * nN; G = G_; c = c_; }
    __host__ __device__ bool next(int i, Unit& u) const {
        const long L = (long)i * G + c; if (L >= nwg) return false;
        int wgid = (int)L; { const int q = nwg / NXCD, r = nwg % NXCD, xcd = wgid % NXCD, off = wgid / NXCD; wgid = (xcd < r ? xcd * (q + 1) : r * (q + 1) + (xcd - r) * q) + off; }
        const int nig = WGM * nN, gid = wgid / nig, fm = gid * WGM, gsz = (nM - fm) < WGM ? (nM - fm) : WGM;
        u.pm = fm + ((wgid % nig) % gsz); u.pn = (wgid % nig) / gsz; return true;
    }
    __device__ __forceinline__ void a_ready(const Unit&) const {}
    __device__ __forceinline__ void done(const Unit&) const {}
};


__device__ __forceinline__ unsigned cvt_pk_bf16(float lo, float hi) { unsigned r; asm volatile("v_cvt_pk_bf16_f32 %0, %1, %2" : "=v"(r) : "v"(lo), "v"(hi)); return r; }

__device__ __forceinline__ void st_wt16(void* p, u32x4 v) { asm volatile("global_store_dwordx4 %0, %1, off sc1\n\ts_nop 1" :: "v"(p), "v"(v) : "memory"); }
template <int ACT  > struct EpiBf16 {
    static constexpr bool PERM = true, AFTER_DRAIN = false, HAS_MID = false;
    bf16_t* O; int ldc; const float* rowss; int wt_pn;
    __device__ __forceinline__ void operator()(const f32x4 (&acc)[2][2][4][2], const Unit& u, int wr, int wc, int fr, int fq) const {
        const int row0 = u.pm * BM + wr * 64 + fr; const int col0 = u.pn * BM + wc * 32 + 8 * fq;
#pragma unroll
        for (int ai = 0; ai < 2; ++ai)
#pragma unroll
            for (int m = 0; m < 4; ++m) { bf16_t* rowp = O + (size_t)(row0 + ai * HALF + m * 16) * ldc + col0;
                const float rsc = rowss ? __builtin_amdgcn_rsqf(rowss[row0 + ai * HALF + m * 16] * (1.0f / 1024.0f) + 1e-6f) : 1.0f;
#pragma unroll
                for (int bj = 0; bj < 2; ++bj) { f32x4 v0 = acc[ai][bj][m][0] * rsc, v1 = acc[ai][bj][m][1] * rsc;
                    if (ACT == 2) {
#pragma unroll
                        for (int e = 0; e < 4; ++e) { const float a = v0[e] > 0.f ? v0[e] : 0.f, b = v1[e] > 0.f ? v1[e] : 0.f; v0[e] = a * a; v1[e] = b * b; } }
                    u32x4 w; w.x = cvt_pk_bf16(v0[0], v0[1]); w.y = cvt_pk_bf16(v0[2], v0[3]); w.z = cvt_pk_bf16(v1[0], v1[1]); w.w = cvt_pk_bf16(v1[2], v1[3]);
                    if (u.pn >= wt_pn) st_wt16(rowp + bj * HALF, w); else *(u32x4*)(rowp + bj * HALF) = w; } }
    }
};
struct EpiF32Res {
    static constexpr bool PERM = false, AFTER_DRAIN = false, HAS_MID = false;
    const float* base; const float* base2; int split_row; float* out; int ldc;
    __device__ __forceinline__ void operator()(const f32x4 (&acc)[2][2][4][2], const Unit& u, int wr, int wc, int fr, int fq) const {
        const int col0 = u.pn * BM + wc * 32 + 4 * fq;
#pragma unroll
        for (int ai = 0; ai < 2; ++ai) {
            f32x4 pre[4][2][2];
#pragma unroll
            for (int m = 0; m < 4; ++m) { const int r = u.pm * BM + ai * HALF + wr * 64 + m * 16 + fr;
                const float* bp = (r < split_row) ? base + (size_t)r * ldc : base2 + (size_t)(r - split_row) * ldc;
#pragma unroll
                for (int bj = 0; bj < 2; ++bj)
#pragma unroll
                    for (int n = 0; n < 2; ++n) pre[m][bj][n] = *(const f32x4*)(bp + col0 + bj * HALF + n * 16); }
            asm volatile("" ::: "memory");
#pragma unroll
            for (int m = 0; m < 4; ++m) { const int r = u.pm * BM + ai * HALF + wr * 64 + m * 16 + fr; float* op = out + (size_t)r * ldc;
#pragma unroll
                for (int bj = 0; bj < 2; ++bj)
#pragma unroll
                    for (int n = 0; n < 2; ++n) *(f32x4*)(op + col0 + bj * HALF + n * 16) = pre[m][bj][n] + acc[ai][bj][m][n]; }
            asm volatile("" ::: "memory");
        }
    }
};
struct EpiF32ResX {
    static constexpr bool PERM = false, AFTER_DRAIN = false, HAS_MID = true;
    const float* base; bf16_t* xb; float* rowss; int ldc; const float* rsa;
    __device__ __forceinline__ void mid(f32x4 (&acc)[2][2][4][2], const Unit& u, int t, int wr, int fr) const {
        if (t != 8) return;
        float rs[2][4];
#pragma unroll
        for (int ai = 0; ai < 2; ++ai)
#pragma unroll
            for (int m = 0; m < 4; ++m) rs[ai][m] = rsa[u.pm * BM + ai * HALF + wr * 64 + m * 16 + fr];
#pragma unroll
        for (int ai = 0; ai < 2; ++ai)
#pragma unroll
            for (int bj = 0; bj < 2; ++bj)
#pragma unroll
                for (int m = 0; m < 4; ++m)
#pragma unroll
                    for (int n = 0; n < 2; ++n) acc[ai][bj][m][n] = acc[ai][bj][m][n] * rs[ai][m];
    }
    __device__ __forceinline__ void operator()(const f32x4 (&acc)[2][2][4][2], const Unit& u, int wr, int wc, int fr, int fq) const {
        const int col0 = u.pn * BM + wc * 32 + 4 * fq;
        typedef unsigned u32x2 __attribute__((ext_vector_type(2)));
#pragma unroll
        for (int ai = 0; ai < 2; ++ai) {
            f32x4 pre[4][2][2];
#pragma unroll
            for (int m = 0; m < 4; ++m) { const int r = u.pm * BM + ai * HALF + wr * 64 + m * 16 + fr; const float* bp = base + (size_t)r * ldc;
#pragma unroll
                for (int bj = 0; bj < 2; ++bj)
#pragma unroll
                    for (int n = 0; n < 2; ++n) pre[m][bj][n] = __builtin_nontemporal_load((const f32x4*)(bp + col0 + bj * HALF + n * 16)); }
            asm volatile("" ::: "memory");
#pragma unroll
            for (int m = 0; m < 4; ++m) { const int r = u.pm * BM + ai * HALF + wr * 64 + m * 16 + fr;
                bf16_t* xp = xb + (size_t)r * ldc; float ss = 0.f;
#pragma unroll
                for (int bj = 0; bj < 2; ++bj)
#pragma unroll
                    for (int n = 0; n < 2; ++n) { const int c = col0 + bj * HALF + n * 16; const f32x4 x1 = pre[m][bj][n] + acc[ai][bj][m][n];
                        ss += (x1[0] * x1[0] + x1[1] * x1[1]) + (x1[2] * x1[2] + x1[3] * x1[3]);
                        u32x2 w; w.x = cvt_pk_bf16(x1[0], x1[1]); w.y = cvt_pk_bf16(x1[2], x1[3]); *(u32x2*)(xp + c) = w; }
                { auto r16 = __builtin_amdgcn_permlane16_swap(__float_as_uint(ss), __float_as_uint(ss), false, false); ss = __uint_as_float(r16[0]) + __uint_as_float(r16[1]);
                  auto r32 = __builtin_amdgcn_permlane32_swap(__float_as_uint(ss), __float_as_uint(ss), false, false); ss = __uint_as_float(r32[0]) + __uint_as_float(r32[1]); }
                if (fq == 0) atomicAdd(rowss + r, ss); }
            asm volatile("" ::: "memory");
        }
    }
};

struct EpiF32ResB {
    static constexpr bool PERM = false, AFTER_DRAIN = false, HAS_MID = false;
    const bf16_t* xb; float* out; int ldc;
    __device__ __forceinline__ void operator()(const f32x4 (&acc)[2][2][4][2], const Unit& u, int wr, int wc, int fr, int fq) const {
        const int col0 = u.pn * BM + wc * 32 + 4 * fq;
        typedef unsigned u32x2 __attribute__((ext_vector_type(2)));
#pragma unroll
        for (int ai = 0; ai < 2; ++ai) {
            u32x2 pre[4][2][2];
#pragma unroll
            for (int m = 0; m < 4; ++m) { const int r = u.pm * BM + ai * HALF + wr * 64 + m * 16 + fr; const bf16_t* bp = xb + (size_t)r * ldc;
#pragma unroll
                for (int bj = 0; bj < 2; ++bj)
#pragma unroll
                    for (int n = 0; n < 2; ++n) pre[m][bj][n] = __builtin_nontemporal_load((const u32x2*)(bp + col0 + bj * HALF + n * 16)); }
            asm volatile("" ::: "memory");
#pragma unroll
            for (int m = 0; m < 4; ++m) { const int r = u.pm * BM + ai * HALF + wr * 64 + m * 16 + fr; float* op = out + (size_t)r * ldc;
#pragma unroll
                for (int bj = 0; bj < 2; ++bj)
#pragma unroll
                    for (int n = 0; n < 2; ++n) { const u32x2 p = pre[m][bj][n];
                        const f32x4 x1 = (f32x4){__uint_as_float(p.x << 16), __uint_as_float(p.x & 0xffff0000u), __uint_as_float(p.y << 16), __uint_as_float(p.y & 0xffff0000u)};
                        __builtin_nontemporal_store(x1 + acc[ai][bj][m][n], (f32x4*)(op + col0 + bj * HALF + n * 16)); } }
            asm volatile("" ::: "memory");
        }
    }
};

template <class Epi, class Sched, bool ALIGN_EPI = false, bool SP2 = false>
__device__ __forceinline__ void gemm_phase(PG8_LAS unsigned char* lds, const Gemm g, const Sched& S, const Epi& E) {
    int tid_l = threadIdx.x; asm volatile("" : "+v"(tid_l));
    const int tid = tid_l, wid = __builtin_amdgcn_readfirstlane(tid >> 6), lane = tid & 63, wr = wid >> 2, wc = wid & 3, fr = lane & 15, fq = lane >> 4;
    const int K = g.K, nt = K / BK;
    unsigned voffA[2], voffB[2];
#pragma unroll
    for (int i = 0; i < 2; ++i) { int R, C; stage_rc(tid * 16 + i * 8192, R, C); const int Rb = Epi::PERM ? ((R & ~31) + perm32(R & 31)) : R;
        voffA[i] = (unsigned)(R * K + C) * 2u; voffB[i] = (unsigned)(Rb * K + C) * 2u; }
    const size_t kstep = (size_t)(BK * 2);
    const size_t hstep = (size_t)HALF * K * 2;
    const size_t tstep = 2 * hstep;
    const unsigned ldsw = (unsigned)wid * 1024u;
    const int aoff = lds_byte(wr * 64 + fr, fq * 8), boff = lds_byte(wc * 32 + fr, fq * 8);
#define PG8_SA(b, h) (((b) * 2 + (h)) * HTB)
#define PG8_SB(b, h) ((4 + (b) * 2 + (h)) * HTB)
#define PG8_STAGE(bufoff, gbase, voff) do { _Pragma("unroll") for (int _i = 0; _i < 2; ++_i) \
        __builtin_amdgcn_global_load_lds((const unsigned*)((const char*)(gbase) + (voff)[_i]), (PG8_LAS unsigned*)(lds + (bufoff) + ldsw + _i * 8192), 16, 0, 0); } while (0)
#define PG8_LDA(dst, b, h) do { _Pragma("unroll") for (int m = 0; m < 4; ++m) _Pragma("unroll") for (int k = 0; k < 2; ++k) dst[m][k] = *(const PG8_LAS bf16x8*)(lds + PG8_SA(b, h) + aoff + m * 2048 + k * 1024); } while (0)
#define PG8_LDB(dst, b, h) do { _Pragma("unroll") for (int n = 0; n < 2; ++n) _Pragma("unroll") for (int k = 0; k < 2; ++k) dst[n][k] = *(const PG8_LAS bf16x8*)(lds + PG8_SB(b, h) + boff + n * 2048 + k * 1024); } while (0)
#define PG8_MMA(ai, bj, At, Bt) do { __builtin_amdgcn_s_setprio(1); _Pragma("unroll") for (int m = 0; m < 4; ++m) _Pragma("unroll") for (int n = 0; n < 2; ++n) _Pragma("unroll") for (int k = 0; k < 2; ++k) \
        acc[ai][bj][m][n] = __builtin_amdgcn_mfma_f32_16x16x32_bf16(Bt[n][k], At[m][k], acc[ai][bj][m][n], 0, 0, 0); __builtin_amdgcn_s_setprio(0); } while (0)
#define PG8_WAIT_V(n) asm volatile("s_waitcnt vmcnt(" #n ")" ::: "memory")
#define PG8_WAIT_L(n) asm volatile("s_waitcnt lgkmcnt(" #n ")" ::: "memory")
#define PG8_BAR __builtin_amdgcn_s_barrier()
#define PG8_SCHED __builtin_amdgcn_sched_barrier(0)
    Unit cur, nxt; int ui = 0;
    if (!S.next(0, cur)) return;
    f32x4 acc[2][2][4][2];
#pragma unroll
    for (int a = 0; a < 2; ++a)
#pragma unroll
        for (int b = 0; b < 2; ++b)
#pragma unroll
            for (int m = 0; m < 4; ++m)
#pragma unroll
                for (int n = 0; n < 2; ++n) acc[a][b][m][n] = (f32x4){0.f, 0.f, 0.f, 0.f};
    bf16x8 At[4][2], B0[2][2], B1[2][2];
    const char* cA = (const char*)g.A + (size_t)cur.pm * tstep; const char* cB = (const char*)g.Bt + (size_t)cur.pn * tstep;
    S.a_ready(cur);
    if constexpr (SP2) {
        PG8_STAGE(PG8_SB(0, 0), cB, voffB); PG8_STAGE(PG8_SB(0, 1), cB + hstep, voffB); PG8_STAGE(PG8_SA(0, 0), cA, voffA); PG8_STAGE(PG8_SA(0, 1), cA + hstep, voffA);
        if (wr == 1) PG8_BAR;
        PG8_WAIT_V(2); PG8_BAR;
        PG8_STAGE(PG8_SB(1, 0), cB + kstep, voffB); PG8_STAGE(PG8_SA(1, 0), cA + kstep, voffA); PG8_STAGE(PG8_SB(1, 1), cB + hstep + kstep, voffB);
        PG8_WAIT_V(6); PG8_BAR;
    } else {
        PG8_STAGE(PG8_SB(0, 0), cB, voffB); PG8_STAGE(PG8_SA(0, 0), cA, voffA); PG8_STAGE(PG8_SB(0, 1), cB + hstep, voffB); PG8_STAGE(PG8_SA(0, 1), cA + hstep, voffA);
        if (wr == 1) PG8_BAR;
        PG8_WAIT_V(4); PG8_BAR;
        PG8_STAGE(PG8_SB(1, 0), cB + kstep, voffB); PG8_STAGE(PG8_SA(1, 0), cA + kstep, voffA); PG8_STAGE(PG8_SB(1, 1), cB + hstep + kstep, voffB);
        PG8_WAIT_V(6); PG8_BAR;
    }
    for (;;) {
        const bool has_next = S.next(ui + 1, nxt);
        const char* nA = has_next ? (const char*)g.A + (size_t)nxt.pm * tstep : cA; const char* nB = has_next ? (const char*)g.Bt + (size_t)nxt.pn * tstep : cB;
        for (int t = 0; t < nt; t += 2) {
            const bool last = (t == nt - 2);
            const char* a1 = cA + (size_t)(t + 1) * kstep;
            const char* a2 = last ? nA : cA + (size_t)(t + 2) * kstep; const char* b2 = last ? nB : cB + (size_t)(t + 2) * kstep;
            const char* a3 = a2 + kstep; const char* b3 = b2 + kstep;
            if (last && has_next) S.a_ready(nxt);
            if constexpr (Epi::HAS_MID) E.mid(acc, cur, t, wr, fr);
            if constexpr (SP2) {
            PG8_LDB(B0, 0, 0); PG8_LDB(B1, 0, 1); PG8_SCHED; PG8_LDA(At, 0, 0); PG8_STAGE(PG8_SA(1, 1), a1 + hstep, voffA);
            PG8_WAIT_V(8); PG8_WAIT_L(0); PG8_BAR; PG8_MMA(0, 0, At, B0); PG8_MMA(0, 1, At, B1); PG8_BAR; PG8_SCHED;
            PG8_LDA(At, 0, 1); PG8_STAGE(PG8_SB(0, 0), b2, voffB); PG8_STAGE(PG8_SB(0, 1), b2 + hstep, voffB); PG8_STAGE(PG8_SA(0, 0), a2, voffA);
            PG8_WAIT_V(8); PG8_WAIT_L(0); PG8_BAR; PG8_MMA(1, 0, At, B0); PG8_MMA(1, 1, At, B1); PG8_BAR; PG8_SCHED;
            PG8_LDB(B0, 1, 0); PG8_LDB(B1, 1, 1); PG8_SCHED; PG8_LDA(At, 1, 0); PG8_STAGE(PG8_SA(0, 1), a2 + hstep, voffA);
            PG8_WAIT_V(8); PG8_WAIT_L(0); PG8_BAR; PG8_MMA(0, 0, At, B0); PG8_MMA(0, 1, At, B1); PG8_BAR; PG8_SCHED;
            PG8_LDA(At, 1, 1); PG8_STAGE(PG8_SB(1, 0), b3, voffB); PG8_STAGE(PG8_SB(1, 1), b3 + hstep, voffB); PG8_STAGE(PG8_SA(1, 0), a3, voffA);
            PG8_WAIT_V(8); PG8_WAIT_L(0); PG8_BAR; PG8_MMA(1, 0, At, B0); PG8_MMA(1, 1, At, B1); PG8_BAR; PG8_SCHED;
            } else {
            PG8_LDB(B0, 0, 0); PG8_SCHED; PG8_LDA(At, 0, 0); PG8_STAGE(PG8_SA(1, 1), a1 + hstep, voffA);
            PG8_WAIT_L(8); PG8_BAR; PG8_WAIT_L(0); PG8_MMA(0, 0, At, B0); PG8_BAR; PG8_SCHED;
            PG8_LDB(B1, 0, 1); PG8_STAGE(PG8_SB(0, 0), b2, voffB);
            PG8_BAR; PG8_WAIT_L(0); PG8_MMA(0, 1, At, B1); PG8_BAR;
            PG8_LDA(At, 0, 1); PG8_STAGE(PG8_SA(0, 0), a2, voffA);
            PG8_BAR; PG8_WAIT_L(0); PG8_MMA(1, 0, At, B0); PG8_BAR; PG8_SCHED;
            PG8_STAGE(PG8_SB(0, 1), b2 + hstep, voffB);
            PG8_WAIT_V(6); PG8_BAR; PG8_MMA(1, 1, At, B1); PG8_BAR;
            PG8_LDB(B0, 1, 0); PG8_SCHED; PG8_LDA(At, 1, 0); PG8_STAGE(PG8_SA(0, 1), a2 + hstep, voffA);
            PG8_WAIT_L(8); PG8_BAR; PG8_WAIT_L(0); PG8_MMA(0, 0, At, B0); PG8_BAR; PG8_SCHED;
            PG8_LDB(B1, 1, 1); PG8_STAGE(PG8_SB(1, 0), b3, voffB);
            PG8_BAR; PG8_WAIT_L(0); PG8_MMA(0, 1, At, B1); PG8_BAR;
            PG8_LDA(At, 1, 1); PG8_STAGE(PG8_SA(1, 0), a3, voffA);
            PG8_BAR; PG8_WAIT_L(0); PG8_MMA(1, 0, At, B0); PG8_BAR; PG8_SCHED;
            PG8_STAGE(PG8_SB(1, 1), b3 + hstep, voffB);
            PG8_WAIT_V(6); PG8_BAR; PG8_MMA(1, 1, At, B1); PG8_BAR;
            }
        }
        if constexpr (ALIGN_EPI) { if (wr == 0) PG8_BAR; }
        if constexpr (!Epi::AFTER_DRAIN) { E(acc, cur, wr, wc, fr, fq); S.done(cur); }
        if (!has_next) break;
#pragma unroll
        for (int a = 0; a < 2; ++a)
#pragma unroll
            for (int b = 0; b < 2; ++b)
#pragma unroll
                for (int m = 0; m < 4; ++m)
#pragma unroll
                    for (int n = 0; n < 2; ++n) acc[a][b][m][n] = (f32x4){0.f, 0.f, 0.f, 0.f};
        cur = nxt; cA = nA; cB = nB; ++ui;
        if constexpr (ALIGN_EPI) { if (wr == 1) PG8_BAR; }
    }
    PG8_WAIT_V(0);
    if constexpr (!ALIGN_EPI) { if (wr == 0) PG8_BAR; }
    PG8_BAR;
    if constexpr (Epi::AFTER_DRAIN) { E.fused(acc, cur, wr, wc, fr, fq, lds, wid, lane); S.done(cur); }
#undef PG8_SA
#undef PG8_SB
#undef PG8_STAGE
#undef PG8_LDA
#undef PG8_LDB
#undef PG8_MMA
#undef PG8_WAIT_V
#undef PG8_WAIT_L
#undef PG8_BAR
#undef PG8_SCHED
}
}

#ifndef MK_N_LAUNCHES
#define MK_N_LAUNCHES 1
#endif
constexpr int N_PHASES = 11;
constexpr int NWAVES = 8;

constexpr int DM = 1024, NB = 8, SEQ = 2048, NMETA = 16, TP = SEQ + NMETA  , DB = 128, DS = 4, PAST = 8192, PAGE = 128, NPAGES = 64;
constexpr int NH = 8, QKN = 64, QKR = 32, VH = 64, QKH = 96, QL = 384, KVL = 256, AW = 512, CC = 512, DFF = 4096;
constexpr int INW = 2208, INWP = 2304;
constexpr int MP = NB * SEQ;
constexpr int MS = DB * DS;
constexpr int MR = MP + MS;
constexpr int MMETA0 = MR;
constexpr int MALL = MR + NMETA;
constexpr int MPAD = 17152;
constexpr int TPP = 2112;
constexpr float EPS = 1e-6f;
constexpr float QSCALE = 0.10206207261596577f * 1.4426950408889634f;
constexpr int SA_NS = 2;

constexpr size_t O_YP = 0, O_YS = O_YP + (size_t)MP * DM, O_LATP = O_YS + (size_t)MS * DM, O_KPEP = O_LATP + (size_t)NB * TP * KVL, O_CONVP = O_KPEP + (size_t)NB * TP * QKR,
                 O_LATS = O_CONVP + (size_t)NB * 2 * CC, O_KPES = O_LATS + (size_t)MS * KVL, O_CONVS = O_KPES + (size_t)MS * QKR, O_END = O_CONVS + (size_t)DB * 2 * CC;

constexpr size_t MiB = 1u << 20;
constexpr size_t WS_CTL = 0, CTL_ZERO_BYTES = 1 * MiB;
constexpr size_t WS_ROWSS = 512 * 1024;
constexpr size_t WS_WIN = 2 * MiB;
constexpr size_t WS_WUQ = 7 * MiB;
constexpr size_t WS_WUKV = 8 * MiB;
constexpr size_t WS_WUKVB = 9 * MiB;
constexpr size_t WS_WF8 = 9 * MiB + 512 * 1024;
constexpr size_t WS_WO = 10 * MiB;
constexpr size_t WS_WUP = 12 * MiB;
constexpr size_t WS_WDN = 20 * MiB;
constexpr size_t WS_ROPE = 28 * MiB;
constexpr size_t WS_XN = 32 * MiB;
constexpr size_t WS_Z = 68 * MiB;
constexpr size_t WS_CQN = 146 * MiB;
constexpr size_t WS_LATB = 160 * MiB;
constexpr size_t WS_KPER = 170 * MiB;
constexpr size_t WS_QRAW = 174 * MiB;
constexpr size_t WS_KVRAW = 200 * MiB;
constexpr size_t WS_Q = 236 * MiB;
constexpr size_t WS_SSQ = 236 * MiB;
constexpr size_t WS_KSS = 238 * MiB;
constexpr size_t WS_RSA = 237 * MiB;
constexpr size_t WS_K = 262 * MiB;
constexpr size_t WS_V = 288 * MiB;
constexpr size_t WS_MIX = 306 * MiB;
constexpr size_t WS_PART = 342 * MiB;
constexpr size_t WS_LPART = 360 * MiB;
constexpr size_t WS_NEWLAT = 352 * MiB;
constexpr size_t WS_NEWKPE = 357 * MiB;
constexpr size_t WS_H = WS_Z;
constexpr size_t WS_END = 500 * MiB;
constexpr int CW_BAR = 4096;

constexpr int RING_OFF = 0, RING_BYTES = 131072;
constexpr int LDS_BYTES = 163840;
constexpr int LDSCTL_OFF = LDS_BYTES - 512, MISC_OFF = LDSCTL_OFF + 320;

#define GAS __attribute__((address_space(1)))
#define LAS __attribute__((address_space(3)))
typedef unsigned short bf16;
typedef unsigned v4u __attribute__((ext_vector_type(4)));
typedef unsigned v2u __attribute__((ext_vector_type(2)));
typedef float f32x4 __attribute__((ext_vector_type(4)));
typedef float f32x16 __attribute__((ext_vector_type(16)));
typedef short bf16x8 __attribute__((ext_vector_type(8)));
typedef short s16x4 __attribute__((ext_vector_type(4)));
typedef GAS unsigned gu32;
#define RLX_AGENT __ATOMIC_RELAXED, __HIP_MEMORY_SCOPE_AGENT
#define LDS_WAIT() asm volatile("s_waitcnt lgkmcnt(0)" ::: "memory")
#define VM_WAIT() asm volatile("s_waitcnt vmcnt(0)" ::: "memory")
typedef float f32x2_t __attribute__((ext_vector_type(2))); typedef __bf16 bf16x2_t __attribute__((ext_vector_type(2)));
#define NTS(v, p) __builtin_nontemporal_store((v), (p))
#define NTL(p) __builtin_nontemporal_load(p)
__device__ __forceinline__ unsigned pk2(float lo, float hi) { f32x2_t v = {lo, hi}; bf16x2_t b = __builtin_convertvector(v, bf16x2_t); return __builtin_bit_cast(unsigned, b); }
__device__ __forceinline__ float bflo(unsigned w) { return __uint_as_float(w << 16); }
__device__ __forceinline__ float bfhi(unsigned w) { return __uint_as_float(w & 0xffff0000u); }
__device__ __forceinline__ void unpack8(const v4u x, float (&e)[8]) { e[0] = bflo(x.x); e[1] = bfhi(x.x); e[2] = bflo(x.y); e[3] = bfhi(x.y); e[4] = bflo(x.z); e[5] = bfhi(x.z); e[6] = bflo(x.w); e[7] = bfhi(x.w); }
__device__ __forceinline__ v4u pack8(const float (&e)[8]) { v4u o; o.x = pk2(e[0], e[1]); o.y = pk2(e[2], e[3]); o.z = pk2(e[4], e[5]); o.w = pk2(e[6], e[7]); return o; }
__device__ __forceinline__ float bf1(bf16 b) { return __uint_as_float((unsigned)b << 16); }
#define XB_TMO      128
#define XB_XCNT(j)  (256  + 64 * (j))
#define XB_XSUB(j)  (1280 + 64 * (j))
#define XB_XGEN(j)  (2304 + 64 * (j))
#define XB_TOP      3328
#define XB_TOPGEN   3392
#define XCD_BAR_WORDS 3456
#define XB_SPIN_CAP (1u << 18)

__device__ __forceinline__ unsigned xb_ld(unsigned* p)              { return __hip_atomic_load(p, __ATOMIC_RELAXED, __HIP_MEMORY_SCOPE_AGENT); }
__device__ __forceinline__ unsigned xb_add(unsigned* p, unsigned v) { return __hip_atomic_fetch_add(p, v, __ATOMIC_RELAXED, __HIP_MEMORY_SCOPE_AGENT); }
__device__ __forceinline__ unsigned xb_xcc_id() { return (unsigned)__builtin_amdgcn_s_getreg((3 << 11) | 20) & 0xFu; }
#define XB_SPIN(cond, bar) do { unsigned _sp = 0; while (cond) { __builtin_amdgcn_s_sleep(1); \
    if ((++_sp & 255u) == 0u) { if (xb_ld(&(bar)[XB_TMO])) break; if (_sp > XB_SPIN_CAP) { atomicAdd(&(bar)[XB_TMO], 1u); break; } } } } while (0)

struct XcdBarrier {
    unsigned* bar; unsigned x;
    volatile LAS unsigned* st;
};

__device__ __forceinline__ XcdBarrier xcd_barrier_post(unsigned* bar, volatile LAS unsigned* st) {
    XcdBarrier b; b.bar = bar; b.x = xb_xcc_id(); b.st = st;
    if (threadIdx.x == 0) (void)xb_add(&bar[XB_XCNT(b.x)], 1u);
    return b;
}
__device__ __forceinline__ void xcd_barrier_complete(unsigned* bar, unsigned x, unsigned& nloc, unsigned& nx) {
    const unsigned G = gridDim.x * gridDim.y * gridDim.z;
    unsigned sum, cnt, mine, sp = 0u;
    for (;;) {
        sum = 0u; cnt = 0u; mine = 0u;
#pragma unroll
        for (unsigned j = 0; j < 16; ++j) { const unsigned c = xb_ld(&bar[XB_XCNT(j)]); sum += c; cnt += (c > 0u) ? 1u : 0u; mine = (j == x) ? c : mine; }
        if (sum == G) break;
        __builtin_amdgcn_s_sleep(1);
        if ((++sp & 255u) == 0u) { if (xb_ld(&bar[XB_TMO])) break; if (sp > XB_SPIN_CAP) { atomicAdd(&bar[XB_TMO], 1u); break; } }
    }
    nloc = mine > 0u ? mine : 1u; nx = cnt > 0u ? cnt : 1u;
}

__device__ __forceinline__ void xcd_barrier(const XcdBarrier& b) {
    asm volatile("s_waitcnt vmcnt(0)" ::: "memory");
    __syncthreads();
    if (threadIdx.x == 0) {
        unsigned* bar = b.bar;
        __builtin_amdgcn_s_waitcnt(0);
        unsigned nloc = b.st[0], nx = b.st[1];
        if (nloc == 0u) { xcd_barrier_complete(bar, b.x, nloc, nx); b.st[0] = nloc; b.st[1] = nx; }
        const unsigned old = xb_add(&bar[XB_XSUB(b.x)], 1u);
        const unsigned gen = old / nloc;
        if (old + 1u == (gen + 1u) * nloc) {
            __builtin_amdgcn_fence(__ATOMIC_RELEASE, "agent");
            asm volatile("s_waitcnt vmcnt(0)" ::: "memory");
            const unsigned og = xb_add(&bar[XB_TOP], 1u);
            const unsigned tg = og / nx;
            if (og + 1u == (tg + 1u) * nx) xb_add(&bar[XB_TOPGEN], 1u);
            else XB_SPIN(xb_ld(&bar[XB_TOPGEN]) == tg, bar);
            __builtin_amdgcn_fence(__ATOMIC_ACQUIRE, "agent");
            xb_add(&bar[XB_XGEN(b.x)], 1u);
            asm volatile("s_waitcnt vmcnt(0)" ::: "memory");
        } else {
            XB_SPIN(xb_ld(&bar[XB_XGEN(b.x)]) == gen, bar);
            __builtin_amdgcn_fence(__ATOMIC_ACQUIRE, "agent");
            asm volatile("s_waitcnt vmcnt(0)" ::: "memory");
        }
    }
    __syncthreads();
}

struct Params {
    const float* x_prompt; const float* x_sample; const float* cache_lat; const float* cache_kpe; const float* state_conv; const int* page_table; const float* meta;
    const float* norm_mix_g; const float* w_in; const float* q_lora_g; const float* kv_lora_g; const float* w_uq; const float* w_ukv; const float* q_norm_g; const float* k_norm_g;
    const float* conv_w; const float* conv_b; const float* attn_out_g; const float* conv_out_g; const float* w_o; const float* norm_ffn_g; const float* w_up; const float* w_down;
    float* out; unsigned char* ws; int ph_lo, ph_hi, li, pad;
};
struct Frame {
    LAS unsigned char* lds;
    volatile LAS unsigned* MISC;
    gu32* ctl;
    int tid, lane, wave, G, gw, NGW;
};
__device__ __forceinline__ float wave_sum(float v) {
#pragma unroll
    for (int o = 1; o < 64; o <<= 1) v += __shfl_xor(v, o);
    return v;
}

__device__ __forceinline__ void p0_transpose_item(const float* W, int K, int N, bf16* WT, LAS float* scr, int item, int lane, const float* kscale = nullptr, int klim = 1 << 30) {
    const int nblk = N / 32, kb = item / nblk, nb = item % nblk, k0 = 64 * kb, n0 = 32 * nb;
#pragma unroll 16
    for (int i = 0; i < 32; ++i) { const int kk = 2 * i + (lane >> 5); scr[kk * 33 + (lane & 31)] = NTL(&W[(size_t)(k0 + kk) * N + n0 + (lane & 31)]) * ((kscale && k0 < klim) ? kscale[k0 + kk] : 1.0f); }
    LDS_WAIT(); asm volatile("" ::: "memory");
    const int c = lane & 7;
#pragma unroll
    for (int j = 0; j < 4; ++j) { const int n = (lane >> 3) + 8 * j; const LAS float* s = scr + (8 * c) * 33 + n;
        v4u o; o.x = pk2(s[0 * 33], s[1 * 33]); o.y = pk2(s[2 * 33], s[3 * 33]); o.z = pk2(s[4 * 33], s[5 * 33]); o.w = pk2(s[6 * 33], s[7 * 33]);
        *(GAS v4u*)(WT + (size_t)(n0 + n) * K + k0 + 8 * c) = o; }
    LDS_WAIT(); asm volatile("" ::: "memory");
}
__device__ __forceinline__ void rms_row_to_bf16(const float* xrow, const float* g, bf16* orow, int lane) {
    const GAS f32x4* xr = (const GAS f32x4*)xrow + lane; const GAS f32x4* gr = (const GAS f32x4*)g + lane;
    f32x4 v[4]; float s = 0.f;
#pragma unroll
    for (int j = 0; j < 4; ++j) { v[j] = NTL(xr + 64 * j); s += (v[j].x * v[j].x + v[j].y * v[j].y) + (v[j].z * v[j].z + v[j].w * v[j].w); }
    const float rs = 1.0f / sqrtf(wave_sum(s) * (1.f / DM) + EPS);
    GAS v2u* o8 = (GAS v2u*)orow + lane;
#pragma unroll
    for (int j = 0; j < 4; ++j) { const f32x4 gg = gr[64 * j]; v2u w; w.x = pk2(v[j].x * rs * gg.x, v[j].y * rs * gg.y); w.y = pk2(v[j].z * rs * gg.z, v[j].w * rs * gg.w); o8[64 * j] = w; }
}
__device__ __forceinline__ void p0_prologue(const Params& P, Frame& F) {
    unsigned char* ws = P.ws;
    LAS float* scr = (LAS float*)(F.lds + RING_OFF + F.wave * 16384);
    constexpr int I_IN = (DM / 64) * (INW / 32);
    for (int it = F.gw; it < I_IN; it += F.NGW) p0_transpose_item(P.w_in, DM, INW, (bf16*)(ws + WS_WIN), scr, it, F.lane);
    const int gt = F.gw * 64 + F.lane, NGT = F.NGW * 64;
    for (int i = gt; i < 96 * 128; i += NGT) ((GAS v4u*)(ws + WS_WIN + (size_t)INW * DM * 2))[i] = (v4u){0u, 0u, 0u, 0u};
    for (int i = gt; i < (MPAD - MALL) * DM / 8; i += NGT) ((GAS v4u*)(ws + WS_XN + (size_t)MALL * DM * 2))[i] = (v4u){0u, 0u, 0u, 0u};
    bf16* XN = (bf16*)(ws + WS_XN);
    {
        const int lane = F.lane;
        f32x4 gg[4];
#pragma unroll
        for (int j = 0; j < 4; ++j) gg[j] = ((const GAS f32x4*)P.norm_mix_g)[lane + 64 * j];
#define P0_SRC(m) (((m) < MP) ? P.x_prompt + (size_t)(m) * DM : ((m) < MR) ? P.x_sample + (size_t)((m) - MP) * DM : P.meta + (size_t)((m) - MR) * DM)
        int m = F.gw;
        f32x4 vn[4];
        if (m < MALL) { const GAS f32x4* xr = (const GAS f32x4*)P0_SRC(m) + lane;
#pragma unroll
            for (int j = 0; j < 4; ++j) vn[j] = NTL(xr + 64 * j); }
        while (m < MALL) {
            f32x4 v[4];
#pragma unroll
            for (int j = 0; j < 4; ++j) v[j] = vn[j];
            const int m2 = m + F.NGW;
            if (m2 < MALL) { const GAS f32x4* xr = (const GAS f32x4*)P0_SRC(m2) + lane;
#pragma unroll
                for (int j = 0; j < 4; ++j) vn[j] = NTL(xr + 64 * j); }
            float ss = 0.f;
#pragma unroll
            for (int j = 0; j < 4; ++j) ss += (v[j].x * v[j].x + v[j].y * v[j].y) + (v[j].z * v[j].z + v[j].w * v[j].w);
            const float rs = 1.0f / sqrtf(wave_sum(ss) * (1.f / DM) + EPS);
            GAS v2u* o8 = (GAS v2u*)(XN + (size_t)m * DM) + lane;
#pragma unroll
            for (int j = 0; j < 4; ++j) { v2u w; w.x = pk2(v[j].x * rs * gg[j].x, v[j].y * rs * gg[j].y); w.y = pk2(v[j].z * rs * gg[j].z, v[j].w * rs * gg[j].w); o8[64 * j] = w; }
            m = m2;
        }
#undef P0_SRC
    }
}
__device__ __forceinline__ void p0_late(const Params& P, Frame& F, int wv, int nwv) {
    unsigned char* ws = P.ws;
    LAS float* scr = (LAS float*)(F.lds + RING_OFF + F.wave * 16384);
    constexpr int I_UQ = (QL / 64) * (768 / 32), I_UKV = (KVL / 64) * (1024 / 32), I_O = (DM / 64) * (DM / 32), I_UP = (DM / 64) * (DFF / 32), I_DN = (DFF / 64) * (DM / 32);
    constexpr int NITEMS = I_UQ + I_UKV + I_O + I_UP + I_DN;
    for (int it = wv; it < NITEMS; it += nwv) {
        int r = it;
        if (r < I_UQ) { p0_transpose_item(P.w_uq, QL, 768, (bf16*)(ws + WS_WUQ), scr, r, F.lane); continue; } r -= I_UQ;
        if (r < I_UKV) { p0_transpose_item(P.w_ukv, KVL, 1024, (bf16*)(ws + WS_WUKV), scr, r, F.lane); continue; } r -= I_UKV;
        if (r < I_O) { p0_transpose_item(P.w_o, DM, DM, (bf16*)(ws + WS_WO), scr, r, F.lane, P.attn_out_g, AW); continue; } r -= I_O;
        if (r < I_UP) { p0_transpose_item(P.w_up, DM, DFF, (bf16*)(ws + WS_WUP), scr, r, F.lane, P.norm_ffn_g); continue; } r -= I_UP;
        p0_transpose_item(P.w_down, DFF, DM, (bf16*)(ws + WS_WDN), scr, r, F.lane);
    }
    const int gt = wv * 64 + F.lane, NGT = nwv * 64;
    for (int i = gt; i < KVL * 1024 / 8; i += NGT) { const f32x4 a = ((const GAS f32x4*)P.w_ukv)[2 * i], b = ((const GAS f32x4*)P.w_ukv)[2 * i + 1];
        v4u o; o.x = pk2(a.x, a.y); o.y = pk2(a.z, a.w); o.z = pk2(b.x, b.y); o.w = pk2(b.z, b.w); ((GAS v4u*)(ws + WS_WUKVB))[i] = o; }
    for (int i = gt; i < 512 * 64; i += NGT) { const int n = i >> 6, c4 = i & 63, col = (n >> 6) * 128 + (n & 63); const float* wp = P.w_ukv + (size_t)(4 * c4) * 1024 + col;
        int w = 0; w = __builtin_amdgcn_cvt_pk_fp8_f32(16.f * wp[0], 16.f * wp[1024], w, false); w = __builtin_amdgcn_cvt_pk_fp8_f32(16.f * wp[2048], 16.f * wp[3072], w, true);
        ((int*)(ws + WS_WF8))[i] = w; }
    for (int i = gt; i < 2068 * 16; i += NGT) { const int p = i >> 4, f = i & 15; const double pos = (p < TP) ? (double)p : (double)(PAST + (p - TP));
        const double f4 = (f & 3) == 0 ? 1.0 : (f & 3) == 1 ? 5.62341325190349072827e-01 : (f & 3) == 2 ? 3.16227766016837941176e-01 : 1.77827941003892292526e-01;
        const double dec = (f >> 2) == 0 ? 1.0 : (f >> 2) == 1 ? 1e-1 : (f >> 2) == 2 ? 1e-2 : 1e-3;
        const double ang = pos * (f4 * dec); const double kq = rint(ang * 0.15915494309189533577); const double rr = fma(-kq, 6.283185307179586232, ang) - kq * 2.4492935982947064e-16;
        const float rf = (float)rr;
        ((float*)(ws + WS_ROPE))[i] = cosf(rf); ((float*)(ws + WS_ROPE))[2068 * 16 + i] = sinf(rf); }
    for (int i = gt; i < NB * (TPP - TP) * 768 / 8; i += NGT) { const int b = i / ((TPP - TP) * 96), r = i % ((TPP - TP) * 96); ((GAS v4u*)(ws + WS_K + ((size_t)(b * TPP + TP) * 768) * 2))[r] = (v4u){0u, 0u, 0u, 0u}; }
    for (int i = gt; i < DB * 32 * KVL / 4; i += NGT) ((GAS f32x4*)(ws + WS_NEWLAT))[i] = (f32x4){0.f, 0.f, 0.f, 0.f};
    for (int i = gt; i < DB * 32 * QKR / 4; i += NGT) ((GAS f32x4*)(ws + WS_NEWKPE))[i] = (f32x4){0.f, 0.f, 0.f, 0.f};
}

__device__ __forceinline__ void conv_u(const bf16* zrow, int lane, float (&u)[8]) {
    float a[8], b[8]; unpack8(*(const GAS v4u*)(zrow + 1184 + 8 * lane), a); unpack8(*(const GAS v4u*)(zrow + 1696 + 8 * lane), b);
#pragma unroll
    for (int i = 0; i < 8; ++i) u[i] = a[i] * b[i];
}
__device__ __forceinline__ void p2a_row(const Params& P, Frame& F, int r) {
    unsigned char* ws = P.ws; const int lane = F.lane;
    const bf16* Z = (const bf16*)(ws + WS_Z); const bf16* z = Z + (size_t)r * INWP;
    int kind, b, t, pidx;
    if (r < MP) { kind = 0; b = r >> 11; t = r & 2047; pidx = t + NMETA; }
    else if (r < MR) { kind = 1; b = (r - MP) >> 2; t = (r - MP) & 3; pidx = TP + t; }
    else { kind = 2; b = 0; t = r - MR; pidx = t; }
    const int l48p = lane < 48 ? lane : 0, l32p = lane & 31;
    const v4u zq_ = *(const GAS v4u*)(z + 8 * l48p), zk_ = *(const GAS v4u*)(z + 384 + 8 * l32p);
    const bf16 zp_ = z[640 + l32p];
    const float* rope_ = (const float*)(ws + WS_ROPE); const float rc_ = rope_[pidx * 16 + (l32p & 15)], rsn_ = rope_[2068 * 16 + pidx * 16 + (l32p & 15)];
    const f32x4 qg0_ = *(const GAS f32x4*)(P.q_lora_g + 8 * l48p), qg1_ = *(const GAS f32x4*)(P.q_lora_g + 8 * l48p + 4);
    const f32x4 kg0_ = *(const GAS f32x4*)(P.kv_lora_g + 8 * l32p), kg1_ = *(const GAS f32x4*)(P.kv_lora_g + 8 * l32p + 4);
    v4u zb_ = {0u, 0u, 0u, 0u}, zg0_ = zb_, zh0_ = zb_, zg1_ = zb_, zh1_ = zb_, zg2_ = zb_, zh2_ = zb_;
    f32x4 cb_[2], cw_[3][2], og_[2];
#pragma unroll
    for (int q = 0; q < 2; ++q) { cb_[q] = (f32x4){0.f, 0.f, 0.f, 0.f}; og_[q] = cb_[q]; cw_[0][q] = cb_[q]; cw_[1][q] = cb_[q]; cw_[2][q] = cb_[q]; }
    if (kind != 2) {
        zb_ = *(const GAS v4u*)(z + 672 + 8 * lane); zg0_ = *(const GAS v4u*)(z + 1184 + 8 * lane); zh0_ = *(const GAS v4u*)(z + 1696 + 8 * lane);
#pragma unroll
        for (int q = 0; q < 2; ++q) { cb_[q] = *(const GAS f32x4*)(P.conv_b + 8 * lane + 4 * q); og_[q] = *(const GAS f32x4*)(P.conv_out_g + 8 * lane + 4 * q);
            cw_[0][q] = *(const GAS f32x4*)(P.conv_w + 8 * lane + 4 * q); cw_[1][q] = *(const GAS f32x4*)(P.conv_w + CC + 8 * lane + 4 * q); cw_[2][q] = *(const GAS f32x4*)(P.conv_w + 2 * CC + 8 * lane + 4 * q); }
        if (kind == 0) {
            const bf16* z1 = (t >= 1) ? z - INWP : Z + (size_t)(MMETA0 + 15) * INWP;
            const bf16* z2 = (t >= 2) ? z - 2 * INWP : Z + (size_t)(MMETA0 + 14 + t) * INWP;
            zg1_ = *(const GAS v4u*)(z1 + 1184 + 8 * lane); zh1_ = *(const GAS v4u*)(z1 + 1696 + 8 * lane); zg2_ = *(const GAS v4u*)(z2 + 1184 + 8 * lane); zh2_ = *(const GAS v4u*)(z2 + 1696 + 8 * lane);
        }
    }
    if (kind != 2) {
        float v[8]; unpack8(zq_, v);
        float ss = 0.f;
#pragma unroll
        for (int i = 0; i < 8; ++i) ss += v[i] * v[i];
        if (lane >= 48) ss = 0.f;
        const float rs = 1.0f / sqrtf(wave_sum(ss) * (1.f / QL) + EPS);
        if (lane < 48) { const f32x4 g0 = qg0_, g1 = qg1_;
            float o[8] = {v[0] * rs * g0.x, v[1] * rs * g0.y, v[2] * rs * g0.z, v[3] * rs * g0.w, v[4] * rs * g1.x, v[5] * rs * g1.y, v[6] * rs * g1.z, v[7] * rs * g1.w};
            *(GAS v4u*)((bf16*)(ws + WS_CQN) + (size_t)r * QL + 8 * lane) = pack8(o); }
    }
    {
        float v[8]; unpack8(zk_, v);
        float ss = 0.f;
#pragma unroll
        for (int i = 0; i < 8; ++i) ss += v[i] * v[i];
        if (lane >= 32) ss = 0.f;
        const float rs = 1.0f / sqrtf(wave_sum(ss) * (1.f / KVL) + EPS);
        if (lane < 32) { const f32x4 g0 = kg0_, g1 = kg1_;
            float o[8] = {v[0] * rs * g0.x, v[1] * rs * g0.y, v[2] * rs * g0.z, v[3] * rs * g0.w, v[4] * rs * g1.x, v[5] * rs * g1.y, v[6] * rs * g1.z, v[7] * rs * g1.w};
            *(GAS v4u*)((bf16*)(ws + WS_LATB) + (size_t)r * KVL + 8 * lane) = pack8(o);
            const f32x4 o0 = {o[0], o[1], o[2], o[3]}, o1 = {o[4], o[5], o[6], o[7]};
            if (kind == 0) { float* d = P.out + O_LATP + ((size_t)(b * TP + NMETA + t)) * KVL + 8 * lane; NTS(o0, (GAS f32x4*)d); NTS(o1, (GAS f32x4*)(d + 4)); }
            else if (kind == 1) { float* d = P.out + O_LATS + ((size_t)(b * DS + t)) * KVL + 8 * lane; NTS(o0, (GAS f32x4*)d); NTS(o1, (GAS f32x4*)(d + 4));
                float* d2 = (float*)(ws + WS_NEWLAT) + ((size_t)(b * 32 + t)) * KVL + 8 * lane; *(GAS f32x4*)d2 = o0; *(GAS f32x4*)(d2 + 4) = o1; }
            else { for (int bb = 0; bb < NB; ++bb) { float* d = P.out + O_LATP + ((size_t)(bb * TP + t)) * KVL + 8 * lane; NTS(o0, (GAS f32x4*)d); NTS(o1, (GAS f32x4*)(d + 4)); } }
        }
    }
    {
        const int l32 = lane & 31; const float x = bf1(zp_); const float xp = __shfl_xor(x, 16);
        const float c = rc_, s = rsn_;
        const float o = (l32 < 16) ? (x * c - xp * s) : (x * c + xp * s);
        { const float q2 = wave_sum(lane < 32 ? o * o : 0.f); if (lane == 0) ((float*)(ws + WS_KSS))[r] = q2; }
        if (lane < 32) {
            ((float*)(ws + WS_KPER))[(size_t)r * QKR + lane] = o;
            if (kind == 0) NTS(o, &P.out[O_KPEP + ((size_t)(b * TP + NMETA + t)) * QKR + lane]);
            else if (kind == 1) { P.out[O_KPES + ((size_t)(b * DS + t)) * QKR + lane] = o; ((float*)(ws + WS_NEWKPE))[((size_t)(b * 32 + t)) * QKR + lane] = o; }
            else { for (int bb = 0; bb < NB; ++bb) P.out[O_KPEP + ((size_t)(bb * TP + t)) * QKR + lane] = o; }
        }
    }
    if (kind != 2) {
        float u0[8], u1[8], u2[8];
        { float a_[8], b_[8]; unpack8(zg0_, a_); unpack8(zh0_, b_);
#pragma unroll
          for (int i = 0; i < 8; ++i) u0[i] = a_[i] * b_[i]; }
        if (kind == 0) { float a_[8], b_[8]; unpack8(zg1_, a_); unpack8(zh1_, b_);
#pragma unroll
            for (int i = 0; i < 8; ++i) u1[i] = a_[i] * b_[i];
            unpack8(zg2_, a_); unpack8(zh2_, b_);
#pragma unroll
            for (int i = 0; i < 8; ++i) u2[i] = a_[i] * b_[i];
        } else {
            const float* st = P.state_conv + (size_t)b * 2 * CC + 8 * lane;
            if (t >= 1) conv_u(z - INWP, lane, u1); else { const f32x4 a = *(const GAS f32x4*)(st + CC), c = *(const GAS f32x4*)(st + CC + 4); u1[0] = a.x; u1[1] = a.y; u1[2] = a.z; u1[3] = a.w; u1[4] = c.x; u1[5] = c.y; u1[6] = c.z; u1[7] = c.w; }
            if (t >= 2) conv_u(z - 2 * INWP, lane, u2); else { const float* s2 = st + (t == 1 ? CC : 0); const f32x4 a = *(const GAS f32x4*)(s2), c = *(const GAS f32x4*)(s2 + 4); u2[0] = a.x; u2[1] = a.y; u2[2] = a.z; u2[3] = a.w; u2[4] = c.x; u2[5] = c.y; u2[6] = c.z; u2[7] = c.w; }
        }
        float gb[8]; unpack8(zb_, gb);
        float co[8]; float ss = 0.f;
#pragma unroll
        for (int i = 0; i < 8; ++i) { const float y = cb_[i >> 2][i & 3] + cw_[0][i >> 2][i & 3] * u2[i] + cw_[1][i >> 2][i & 3] * u1[i] + cw_[2][i >> 2][i & 3] * u0[i]; co[i] = gb[i] * y; ss += co[i] * co[i]; }
        const float rs = 1.0f / sqrtf(wave_sum(ss) * (1.f / CC) + EPS);
#pragma unroll
        for (int i = 0; i < 8; ++i) co[i] = co[i] * rs * og_[i >> 2][i & 3];
        *(GAS v4u*)((bf16*)(ws + WS_MIX) + (size_t)r * DM + AW + 8 * lane) = pack8(co);
        const f32x4 o0 = {u0[0], u0[1], u0[2], u0[3]}, o1 = {u0[4], u0[5], u0[6], u0[7]};
        if (kind == 0 && t >= SEQ - 2) { float* d = P.out + O_CONVP + ((size_t)(b * 2 + (t - (SEQ - 2)))) * CC + 8 * lane; *(GAS f32x4*)d = o0; *(GAS f32x4*)(d + 4) = o1; }
        if (kind == 1 && t >= DS - 2) { float* d = P.out + O_CONVS + ((size_t)(b * 2 + (t - (DS - 2)))) * CC + 8 * lane; *(GAS f32x4*)d = o0; *(GAS f32x4*)(d + 4) = o1; }
    }
}

__device__ __forceinline__ void p2c_k_item8(const Params& P, LAS unsigned char* scr, int r0, int lane_in) {
    unsigned char* ws = P.ws; asm volatile("" : "+s"(ws)); int lane = lane_in; asm volatile("" : "+v"(lane));
    const GAS unsigned char* src = (const GAS unsigned char*)((const bf16*)(ws + WS_KVRAW) + (size_t)r0 * 1024);
    { v4u in[8];
#pragma unroll
      for (int j = 0; j < 8; ++j) { const int q = 64 * j + lane, bl = q >> 3, c = q & 7; in[j] = *(const GAS v4u*)(src + (size_t)bl * 256 + c * 16); }
#pragma unroll
      for (int j = 0; j < 8; ++j) { const int q = 64 * j + lane, bl = q >> 3, c = q & 7; *(LAS v4u*)(scr + bl * 128 + ((c ^ (bl & 7)) << 4)) = in[j]; } }
    const int r = r0 + (lane >> 3);
    f32x4 kr[8]; const float* kp = (const float*)(ws + WS_KPER) + (size_t)r * QKR;
#pragma unroll
    for (int c = 0; c < 8; ++c) kr[c] = *(const GAS f32x4*)(kp + 4 * c);
    LDS_WAIT(); asm volatile("" ::: "memory");
    v4u kw[8]; float ss = 0.f;
#pragma unroll
    for (int c = 0; c < 8; ++c) { kw[c] = *(const LAS v4u*)(scr + lane * 128 + ((c ^ (lane & 7)) << 4)); float e[8]; unpack8(kw[c], e);
#pragma unroll
        for (int i = 0; i < 8; ++i) ss += e[i] * e[i]; }
#pragma unroll
    for (int c = 0; c < 8; ++c) ss += (kr[c].x * kr[c].x + kr[c].y * kr[c].y) + (kr[c].z * kr[c].z + kr[c].w * kr[c].w);
    const float rs = 1.0f / sqrtf(ss * (1.f / QKH) + EPS);
    LAS unsigned char* kb = scr + lane * 192;
#pragma unroll
    for (int c = 0; c < 8; ++c) { float e[8]; unpack8(kw[c], e);
#pragma unroll
        for (int i = 0; i < 8; ++i) e[i] = e[i] * rs * P.k_norm_g[8 * c + i];
        *(LAS v4u*)(kb + 16 * c) = pack8(e); }
#pragma unroll
    for (int c = 0; c < 4; ++c) { float e[8] = {kr[2 * c].x, kr[2 * c].y, kr[2 * c].z, kr[2 * c].w, kr[2 * c + 1].x, kr[2 * c + 1].y, kr[2 * c + 1].z, kr[2 * c + 1].w};
#pragma unroll
        for (int i = 0; i < 8; ++i) e[i] = e[i] * rs * P.k_norm_g[64 + 8 * c + i];
        *(LAS v4u*)(kb + 128 + 16 * c) = pack8(e); }
    LDS_WAIT(); asm volatile("" ::: "memory");
    const bool meta = r0 >= MR; const int b0 = meta ? 0 : (r0 >> 11), b1 = meta ? NB : b0 + 1, tp0 = meta ? (r0 - MR) : (r0 & 2047) + NMETA;
    { v4u ko[12];
#pragma unroll
      for (int j = 0; j < 12; ++j) ko[j] = *(const LAS v4u*)(scr + (64 * j + lane) * 16);
      for (int b = b0; b < b1; ++b) { GAS v4u* kd = (GAS v4u*)((bf16*)(ws + WS_K) + ((size_t)(b * TPP + tp0)) * 768);
#pragma unroll
          for (int j = 0; j < 12; ++j) kd[64 * j + lane] = ko[j]; } }
    LDS_WAIT(); asm volatile("" ::: "memory");
}
__device__ __forceinline__ void p2c_phase(const Params& P, Frame& F) {
    LAS unsigned char* scr = F.lds + RING_OFF + F.wave * 16384;
    constexpr int NKV = (MP + NMETA) / 8;
    for (int it = F.gw; it < NKV; it += F.NGW) { int r0 = it * 8; if (r0 >= MP) r0 = MR + (r0 - MP); p2c_k_item8(P, scr, r0, F.lane); }
}

__device__ __forceinline__ void q_norm_frags(const Params& P, const bf16* qraw_head, int pidx, int hi, bf16x8 (&qf)[6]) {
    const float* rope = (const float*)(P.ws + WS_ROPE);
    float v[6][8];
#pragma unroll
    for (int s = 0; s < 6; ++s) unpack8(*(const GAS v4u*)(qraw_head + 16 * s + 8 * hi), v[s]);
    const f32x4 c0 = *(const GAS f32x4*)(rope + pidx * 16 + 8 * hi), c1 = *(const GAS f32x4*)(rope + pidx * 16 + 8 * hi + 4);
    const f32x4 s0 = *(const GAS f32x4*)(rope + 2068 * 16 + pidx * 16 + 8 * hi), s1 = *(const GAS f32x4*)(rope + 2068 * 16 + pidx * 16 + 8 * hi + 4);
    const float cs[8] = {c0.x, c0.y, c0.z, c0.w, c1.x, c1.y, c1.z, c1.w}, sn[8] = {s0.x, s0.y, s0.z, s0.w, s1.x, s1.y, s1.z, s1.w};
#pragma unroll
    for (int j = 0; j < 8; ++j) { const float x1 = v[4][j], x2 = v[5][j]; v[4][j] = x1 * cs[j] - x2 * sn[j]; v[5][j] = x2 * cs[j] + x1 * sn[j]; }
    float ss = 0.f;
#pragma unroll
    for (int s = 0; s < 6; ++s)
#pragma unroll
        for (int j = 0; j < 8; ++j) ss += v[s][j] * v[s][j];
    { auto rr = __builtin_amdgcn_permlane32_swap(__float_as_uint(ss), __float_as_uint(ss), false, false); ss = __uint_as_float(rr[0]) + __uint_as_float(rr[1]); }
    const float rs = QSCALE / sqrtf(ss * (1.f / QKH) + EPS);
#pragma unroll
    for (int s = 0; s < 6; ++s) { const f32x4 g0 = *(const GAS f32x4*)(P.q_norm_g + 16 * s + 8 * hi), g1 = *(const GAS f32x4*)(P.q_norm_g + 16 * s + 8 * hi + 4);
        float e[8] = {v[s][0] * rs * g0.x, v[s][1] * rs * g0.y, v[s][2] * rs * g0.z, v[s][3] * rs * g0.w, v[s][4] * rs * g1.x, v[s][5] * rs * g1.y, v[s][6] * rs * g1.z, v[s][7] * rs * g1.w};
        qf[s] = __builtin_bit_cast(bf16x8, pack8(e)); }
}
constexpr int PA_KS = 0, PA_KROW = 208, PA_VS = 64 * PA_KROW  , PA_VROW = 192, PA_BYTES = PA_VS + 64 * PA_VROW;
#define MFMA32(a, b, c) __builtin_amdgcn_mfma_f32_32x32x16_bf16((a), (b), (c), 0, 0, 0)
#define MFMA16(a, b, c) __builtin_amdgcn_mfma_f32_16x16x32_bf16((a), (b), (c), 0, 0, 0)
typedef short v4i16_t __attribute__((ext_vector_type(4)));
__device__ __forceinline__ s16x4 tr_read(const LAS unsigned char* p) { return __builtin_bit_cast(s16x4, __builtin_amdgcn_ds_read_tr16_b64_v4i16((LAS v4i16_t*)p)); }
__device__ __forceinline__ int crow(int r, int hi) { return (r & 3) + 8 * (r >> 2) + 4 * hi; }

__device__ __forceinline__ void pattn_unit(const Params& P, Frame& F, int b, int h, int qb) {
    unsigned char* ws = P.ws; LAS unsigned char* lds = F.lds;
    int tid_ = F.tid; asm volatile("" : "+v"(tid_));
    const int tid = tid_, lane = tid & 63, wave = F.wave, r32 = lane & 31, hi = lane >> 5;
    const int q0 = qb * 256 + wave * 32;
    const int qpos = NMETA + q0 + r32, wfirst = NMETA + q0, wlast = NMETA + q0 + 31;
    bf16x8 qf[6];
    q_norm_frags(P, (const bf16*)(ws + WS_QRAW) + (size_t)(b * SEQ + q0 + r32) * 768 + h * QKH, qpos, hi, qf);
    const int NT = 4 * qb + 5;
    f32x16 o0, o1;
#pragma unroll
    for (int r = 0; r < 16; ++r) { o0[r] = 0.f; o1[r] = 0.f; }
    float l = 0.f;
    const bf16* Kb = (const bf16*)(ws + WS_K) + (size_t)(b * TPP) * 768 + h * QKH;
    const bf16* Vraw = (const bf16*)(ws + WS_KVRAW) + h * 128 + 64;
#define PA_VROWP(tp_) (Vraw + (size_t)(((tp_) < NMETA) ? MR + (tp_) : b * SEQ + (tp_) - NMETA) * 1024)
    const int k0r = tid / 12, k0c = tid % 12, k1r = (tid + 512) / 12, k1c = (tid + 512) % 12, v0r = tid >> 3, v0c = tid & 7;
    v4u kr0, kr1 = (v4u){0u, 0u, 0u, 0u}, vr;
    {
        kr0 = *(const GAS v4u*)(Kb + (size_t)k0r * 768 + 8 * k0c); if (tid < 256) kr1 = *(const GAS v4u*)(Kb + (size_t)k1r * 768 + 8 * k1c); vr = *(const GAS v4u*)(PA_VROWP(v0r) + 8 * v0c);
    }
    const int blk = (lane >> 4) & 1, tq = (lane & 15) >> 2, tp = lane & 3;
    for (int j = 0; j < NT; ++j) {
        __syncthreads();
        *(LAS v4u*)(lds + PA_KS + k0r * PA_KROW + 16 * k0c) = kr0; if (tid < 256) *(LAS v4u*)(lds + PA_KS + k1r * PA_KROW + 16 * k1c) = kr1; *(LAS v4u*)(lds + PA_VS + v0r * PA_VROW + 16 * v0c) = vr;
        __syncthreads();
        if (j + 1 < NT) { const bf16* Kt = Kb + (size_t)(64 * (j + 1)) * 768;
            kr0 = *(const GAS v4u*)(Kt + (size_t)k0r * 768 + 8 * k0c); if (tid < 256) kr1 = *(const GAS v4u*)(Kt + (size_t)k1r * 768 + 8 * k1c); vr = *(const GAS v4u*)(PA_VROWP(64 * (j + 1) + v0r) + 8 * v0c); }
        if (64 * j <= wlast) {
            f32x16 p0, p1;
#pragma unroll
            for (int r = 0; r < 16; ++r) { p0[r] = 0.f; p1[r] = 0.f; }
#pragma unroll
            for (int s = 0; s < 6; ++s) {
                const bf16x8 a0 = *(const LAS bf16x8*)(lds + PA_KS + r32 * PA_KROW + 32 * s + 16 * hi);
                const bf16x8 a1 = *(const LAS bf16x8*)(lds + PA_KS + (r32 + 32) * PA_KROW + 32 * s + 16 * hi);
                p0 = MFMA32(a0, qf[s], p0); p1 = MFMA32(a1, qf[s], p1);
            }
            int need_mask = __builtin_amdgcn_readfirstlane((64 * j + 63 > wfirst) ? 1 : 0); asm volatile("" : "+s"(need_mask));
            float ls = 0.f;
#pragma unroll
            for (int r = 0; r < 16; ++r) { p0[r] = __builtin_amdgcn_exp2f(p0[r]); p1[r] = __builtin_amdgcn_exp2f(p1[r]); }
            if (need_mask) {
#pragma unroll
                for (int r = 0; r < 16; ++r) { const int kp = 64 * j + crow(r, hi); if (kp > qpos) p0[r] = 0.f; if (kp + 32 > qpos) p1[r] = 0.f; }
            }
#pragma unroll
            for (int r = 0; r < 16; ++r) ls += p0[r] + p1[r];
            l += ls;
            bf16x8 pf[4];
#pragma unroll
            for (int ks = 0; ks < 4; ++ks) { v4u w;
                if (ks < 2) { w.x = pk2(p0[8 * ks + 0], p0[8 * ks + 1]); w.y = pk2(p0[8 * ks + 2], p0[8 * ks + 3]); w.z = pk2(p0[8 * ks + 4], p0[8 * ks + 5]); w.w = pk2(p0[8 * ks + 6], p0[8 * ks + 7]); }
                else { const int k2 = ks - 2; w.x = pk2(p1[8 * k2 + 0], p1[8 * k2 + 1]); w.y = pk2(p1[8 * k2 + 2], p1[8 * k2 + 3]); w.z = pk2(p1[8 * k2 + 4], p1[8 * k2 + 5]); w.w = pk2(p1[8 * k2 + 6], p1[8 * k2 + 7]); }
                pf[ks] = __builtin_bit_cast(bf16x8, w); }
#pragma unroll
            for (int ks = 0; ks < 4; ++ks) {
#pragma unroll
                for (int db = 0; db < 2; ++db) {
                    const LAS unsigned char* base = lds + PA_VS + (16 * ks + 4 * hi + tq) * PA_VROW + (32 * db + 16 * blk + 4 * tp) * 2;
                    const s16x4 t0 = tr_read(base), t1 = tr_read(base + 8 * PA_VROW);
                    const bf16x8 a = (bf16x8){t0[0], t0[1], t0[2], t0[3], t1[0], t1[1], t1[2], t1[3]};
                    if (db == 0) o0 = MFMA32(a, pf[ks], o0); else o1 = MFMA32(a, pf[ks], o1);
                }
            }
        }
    }
    { auto rr = __builtin_amdgcn_permlane32_swap(__float_as_uint(l), __float_as_uint(l), false, false); l = __uint_as_float(rr[0]) + __uint_as_float(rr[1]); }
    const float inv = 1.0f / l;
    { float ss = 0.f;
#pragma unroll
      for (int r = 0; r < 16; ++r) { const float a = o0[r] * inv, c = o1[r] * inv; ss += a * a + c * c; }
      auto rr = __builtin_amdgcn_permlane32_swap(__float_as_uint(ss), __float_as_uint(ss), false, false); ss = __uint_as_float(rr[0]) + __uint_as_float(rr[1]);
      if (hi == 0) ((float*)(ws + WS_SSQ))[(size_t)(b * SEQ + q0 + r32) * NH + h] = ss; }
    bf16* Op = (bf16*)(ws + WS_MIX) + (size_t)(b * SEQ + q0 + r32) * DM + h * VH;
#pragma unroll
    for (int g = 0; g < 4; ++g) {
        v2u w0, w1; w0.x = pk2(o0[4 * g] * inv, o0[4 * g + 1] * inv); w0.y = pk2(o0[4 * g + 2] * inv, o0[4 * g + 3] * inv);
        w1.x = pk2(o1[4 * g] * inv, o1[4 * g + 1] * inv); w1.y = pk2(o1[4 * g + 2] * inv, o1[4 * g + 3] * inv);
        *(GAS v2u*)(Op + 8 * g + 4 * hi) = w0; *(GAS v2u*)(Op + 32 + 8 * g + 4 * hi) = w1;
    }
}

constexpr int SA_LT = 0, SA_LTB = 16384  , SA_KP = 65536, SA_KPB = 2048  , SA_KSQ = 73728, SA_KSB = 128,
              SA_F8 = 74240, SA_F8B = 8192  , SA_RS = 90624, SA_RSB = 1024  , SA_PL = 92672, SA_PLB = 2048, SA_PROW = 64  ,
              SA_QAL = 96768, SA_QROW = 576  , SA_LRED = 115200  , SA_BYTES = SA_LRED + 512;
static_assert(SA_BYTES <= LDSCTL_OFF, "sample attention LDS map");
__device__ __forceinline__ int sa_pi(int x) { return (0x1320 >> (4 * x)) & 3; }
__device__ __forceinline__ int sa_g(int key) { return ((key & 3) << 2) | sa_pi((key >> 2) & 3); }
__device__ __forceinline__ int sa_g8(int key) { return ((key & 3) << 2) | ((0x2310 >> (4 * ((key >> 2) & 3))) & 3); }
typedef int v8i __attribute__((ext_vector_type(8)));
#define MFMA_F8(a, b, c) __builtin_amdgcn_mfma_scale_f32_16x16x128_f8f6f4((a), (b), (c), 0, 0, 0, 0x7F7F7F7F, 0, 0x7F7F7F7F)

__device__ __forceinline__ void sattn_unit(const Params& P, Frame& F, int b, int sp) {
    unsigned char* ws = P.ws; asm volatile("" : "+s"(ws)); LAS unsigned char* lds = F.lds;
    int tid_ = F.tid; asm volatile("" : "+v"(tid_));
    int wave_ = F.wave; asm volatile("" : "+s"(wave_));
    const int tid = tid_, lane = tid & 63, wave = wave_, r32 = lane & 31, hi = lane >> 5, fr = lane & 15, fq = lane >> 4;
    const int h = wave, sg = wave & 1, skb = (wave >> 1) & 1, spar = wave >> 2;
    const int srow0 = MP + b * DS;
    __syncthreads();
    constexpr int NCD = (NPAGES / SA_NS) * 4;
    const int NC = NCD + ((sp == SA_NS - 1) ? 1 : 0);
    int ptv = P.page_table[b * NPAGES + sp * (NPAGES / SA_NS) + (lane & 31)]; asm volatile("" : "+v"(ptv));
    f32x4 st[4]; f32x2_t kst;
    unsigned goff = (unsigned)tid * 16u; asm volatile("" : "+v"(goff));
#define SA_LOAD(ii) do { const int i_ = (ii); const int page = __builtin_amdgcn_readlane(ptv, (i_ >> 2) & 31); const size_t k0 = (size_t)page * PAGE + (i_ & 3) * 32; \
        const GAS unsigned char* gl = (const GAS unsigned char*)((i_ < NCD) ? P.cache_lat + k0 * KVL : (const float*)(ws + WS_NEWLAT) + (size_t)b * 32 * KVL); \
        const GAS unsigned char* gk_ = (const GAS unsigned char*)((i_ < NCD) ? P.cache_kpe + k0 * QKR : (const float*)(ws + WS_NEWKPE) + (size_t)b * 32 * QKR); \
        _Pragma("unroll") \
        for (int j = 0; j < 4; ++j) st[j] = __builtin_nontemporal_load((const GAS f32x4*)(gl + (size_t)(goff + 8192u * j))); \
        kst = __builtin_nontemporal_load((const GAS f32x2_t*)(gk_ + (size_t)(goff >> 1))); \
    } while (0)
    SA_LOAD(0);
    {
        bf16x8 qn[6];
        q_norm_frags(P, (const bf16*)(ws + WS_QRAW) + (size_t)(srow0 + (r32 & 3)) * 768 + h * QKH, TP + (r32 & 3), hi, qn);
        bf16x8 bq[4];
#pragma unroll
        for (int ks = 0; ks < 4; ++ks) {
            float e[8]; unpack8(__builtin_bit_cast(v4u, qn[ks]), e);
#pragma unroll
            for (int i = 0; i < 8; ++i) e[i] = (r32 < 4) ? e[i] * P.k_norm_g[16 * ks + 8 * hi + i] : 0.f;
            bq[ks] = __builtin_bit_cast(bf16x8, pack8(e));
        }
        const bf16* WB = (const bf16*)(ws + WS_WUKVB);
        const int lr = lane >> 3, lc = lane & 7;
        const GAS unsigned char* wp = (const GAS unsigned char*)(WB + (size_t)lr * 1024 + h * 128) + 16 * lc;
        LAS unsigned char* wimg = lds + SA_LT + wave * 4608;
#pragma unroll 1
        for (int half = 0; half < 2; ++half) {
        v4u ra[4][4];
#pragma unroll
        for (int q = 0; q < 4; ++q)
#pragma unroll
            for (int j = 0; j < 4; ++j) ra[q][j] = *(const GAS v4u*)(wp + (size_t)(32 * (4 * half + q) + 8 * j) * 2048);
#pragma unroll
        for (int q = 0; q < 4; ++q) { const int cb = 4 * half + q;
#pragma unroll
            for (int j = 0; j < 4; ++j) *(LAS v4u*)(wimg + (lr + 8 * j) * 144 + lc * 16) = ra[q][j];
            f32x16 acc;
#pragma unroll
            for (int r = 0; r < 16; ++r) acc[r] = 0.f;
#pragma unroll
            for (int ks = 0; ks < 4; ++ks) { const bf16x8 a = *(const LAS bf16x8*)(wimg + r32 * 144 + (2 * ks + hi) * 16); acc = MFMA32(a, bq[ks], acc); }
            if (r32 < 4) {
#pragma unroll
                for (int g = 0; g < 4; ++g) { v2u w; w.x = pk2(acc[4 * g], acc[4 * g + 1]); w.y = pk2(acc[4 * g + 2], acc[4 * g + 3]);
                    *(LAS v2u*)(lds + SA_QAL + (h * 4 + r32) * SA_QROW + (32 * cb + 8 * g + 4 * hi) * 2) = w; }
            }
        }
        }
        if (r32 < 4) {
            float e[8], f[8]; unpack8(__builtin_bit_cast(v4u, qn[4]), e); unpack8(__builtin_bit_cast(v4u, qn[5]), f);
#pragma unroll
            for (int i = 0; i < 8; ++i) { e[i] *= P.k_norm_g[64 + 8 * hi + i]; f[i] *= P.k_norm_g[80 + 8 * hi + i]; }
            *(LAS v4u*)(lds + SA_QAL + (h * 4 + r32) * SA_QROW + (256 + 8 * hi) * 2) = pack8(e);
            *(LAS v4u*)(lds + SA_QAL + (h * 4 + r32) * SA_QROW + (256 + 16 + 8 * hi) * 2) = pack8(f);
        }
    }
    __syncthreads();
    const LAS unsigned char* qaf = lds + SA_QAL + (16 * sg + fr) * SA_QROW + 16 * fq;
    v8i Wf[4][2];
    {
        const unsigned char* WF = (const unsigned char*)(ws + WS_WF8);
#pragma unroll
        for (int db = 0; db < 4; ++db)
#pragma unroll
            for (int st = 0; st < 2; ++st) { const GAS v4u* p = (const GAS v4u*)(WF + (size_t)(h * 64 + 16 * db + fr) * 256 + 128 * st + 32 * fq); const v4u lo = p[0], hi4 = p[1];
                Wf[db][st] = (v8i){(int)lo.x, (int)lo.y, (int)lo.z, (int)lo.w, (int)hi4.x, (int)hi4.y, (int)hi4.z, (int)hi4.w}; }
    }
#pragma unroll
    for (int db = 0; db < 4; ++db)
#pragma unroll
        for (int st = 0; st < 2; ++st) asm volatile("" : "+v"(Wf[db][st]));
    int woff[4], foff[4], koff, ksoff;
#pragma unroll
    for (int j = 0; j < 4; ++j) { const int f = tid + 512 * j, key = f >> 6, c4 = f & 63;
        woff[j] = key * 512 + (((c4 >> 1) ^ sa_g(key)) << 4) + 8 * (c4 & 1); foff[j] = key * 256 + (((c4 >> 2) ^ sa_g8(key)) << 4) + 4 * (c4 & 3);
        asm volatile("" : "+v"(woff[j]), "+v"(foff[j])); }
    { const int key = tid >> 4, c2 = tid & 15; koff = key * 64 + (((c2 >> 2) ^ sa_pi((key >> 2) & 3)) << 4) + 4 * (c2 & 3); ksoff = key * 4; asm volatile("" : "+v"(koff), "+v"(ksoff)); }
    int nbase[2];
#pragma unroll
    for (int kb = 0; kb < 2; ++kb) { const int key = 16 * kb + fr; nbase[kb] = key * 256 + (((2 * fq) ^ sa_g8(key)) << 4); asm volatile("" : "+v"(nbase[kb])); }
#define DPP_ADD(v, ctrl) ((v) + __builtin_bit_cast(float, __builtin_amdgcn_update_dpp(0, __builtin_bit_cast(int, (v)), (ctrl), 0xf, 0xf, true)))
#define SA_WRITE(q4, q2) do { const int lo_ = (q4) * SA_LTB, fo_ = (q2) * SA_F8B, ko_ = (q4) * SA_KPB, so_ = (q4) * SA_KSB; \
        _Pragma("unroll") \
        for (int j = 0; j < 4; ++j) { \
            v2u w; w.x = pk2(st[j].x, st[j].y); w.y = pk2(st[j].z, st[j].w); \
            *(LAS v2u*)(lds + SA_LT + lo_ + woff[j]) = w; \
            int f8 = (int)w.x; f8 = __builtin_amdgcn_cvt_pk_fp8_f32(st[j].x, st[j].y, f8, false); f8 = __builtin_amdgcn_cvt_pk_fp8_f32(st[j].z, st[j].w, f8, true); \
            *(LAS int*)(lds + SA_F8 + fo_ + foff[j]) = f8; } \
        { *(LAS unsigned*)(lds + SA_KP + ko_ + koff) = pk2(kst.x, kst.y); \
            float ss = kst.x * kst.x + kst.y * kst.y; \
            ss = DPP_ADD(ss, 0xB1); ss = DPP_ADD(ss, 0x4E); ss = DPP_ADD(ss, 0x141); ss = DPP_ADD(ss, 0x140);     \
            if ((tid & 15) == 0) *(LAS float*)(lds + SA_KSQ + so_ + ksoff) = ss; } \
    } while (0)
    float lsum[4] = {0.f, 0.f, 0.f, 0.f};
    f32x16 ol;
#pragma unroll
    for (int r = 0; r < 16; ++r) ol[r] = 0.f;
    const int blk = (lane >> 4) & 1, tq = (lane & 15) >> 2, tp = lane & 3;
    int tro[2][2], pro[2][2];
#pragma unroll
    for (int ks = 0; ks < 2; ++ks)
#pragma unroll
        for (int t2 = 0; t2 < 2; ++t2) { const int row = 16 * ks + 8 * hi + tq + 4 * t2, ch = 4 * wave + 2 * blk + (tp >> 1);
            tro[ks][t2] = row * 512 + ((ch ^ sa_g(row)) << 4) + 8 * (tp & 1); pro[ks][t2] = row * SA_PROW + (16 * blk + 4 * tp) * 2; asm volatile("" : "+v"(tro[ks][t2]), "+v"(pro[ks][t2])); }
    SA_WRITE(0, 0); SA_LOAD(1);
    asm volatile("s_waitcnt lgkmcnt(0)" ::: "memory"); __builtin_amdgcn_s_barrier(); asm volatile("" ::: "memory");
#define SA_PV(q4, q2) do { const int pb_ = (q4) * SA_LTB, pp_ = (q2) * SA_PLB; \
            const s16x4 t00 = tr_read(lds + SA_LT + pb_ + tro[0][0]), t01 = tr_read(lds + SA_LT + pb_ + tro[0][1]), p00 = tr_read(lds + SA_PL + pp_ + pro[0][0]), p01 = tr_read(lds + SA_PL + pp_ + pro[0][1]); \
            const s16x4 t10 = tr_read(lds + SA_LT + pb_ + tro[1][0]), t11 = tr_read(lds + SA_LT + pb_ + tro[1][1]), p10 = tr_read(lds + SA_PL + pp_ + pro[1][0]), p11 = tr_read(lds + SA_PL + pp_ + pro[1][1]); \
            __builtin_amdgcn_sched_barrier(0); \
            ol = MFMA32(((bf16x8){t00[0], t00[1], t00[2], t00[3], t01[0], t01[1], t01[2], t01[3]}), ((bf16x8){p00[0], p00[1], p00[2], p00[3], p01[0], p01[1], p01[2], p01[3]}), ol); \
            ol = MFMA32(((bf16x8){t10[0], t10[1], t10[2], t10[3], t11[0], t11[1], t11[2], t11[3]}), ((bf16x8){p10[0], p10[1], p10[2], p10[3], p11[0], p11[1], p11[2], p11[3]}), ol); } while (0)
#ifndef SA_STAGGER
#define SA_STAGGER 1
#endif
#define SA_NLOAD(kb, Q20, dst) do { int nb_ = nbase[kb]; asm volatile("" : "+v"(nb_));     \
        const LAS unsigned char* frow = lds + SA_F8 + (Q20) * SA_F8B; \
        _Pragma("unroll") \
        for (int st2 = 0; st2 < 2; ++st2) { const v4u lo = *(const LAS v4u*)(frow + (nb_ ^ ((8 * st2) << 4))), hi4 = *(const LAS v4u*)(frow + (nb_ ^ ((8 * st2 + 1) << 4))); \
            dst[st2] = (v8i){(int)lo.x, (int)lo.y, (int)lo.z, (int)lo.w, (int)hi4.x, (int)hi4.y, (int)hi4.z, (int)hi4.w}; } } while (0)
#define SA_NMMA(src, acc_) do { \
        _Pragma("unroll") \
        for (int a = 0; a < 4; ++a) acc_[a] = (f32x4){0.f, 0.f, 0.f, 0.f}; \
        _Pragma("unroll") \
        for (int st2 = 0; st2 < 2; ++st2) \
            _Pragma("unroll") \
            for (int db = 0; db < 4; ++db) acc_[db] = MFMA_F8(Wf[db][st2], src[st2], acc_[db]); } while (0)
#define SA_NTAIL(kb, Q20, acc_, ksq_) do { const int key_ = (kb) * 16 + fr; float ss = 0.f; \
        _Pragma("unroll") \
        for (int db = 0; db < 4; ++db) ss += (acc_[db][0] * acc_[db][0] + acc_[db][1] * acc_[db][1]) + (acc_[db][2] * acc_[db][2] + acc_[db][3] * acc_[db][3]); \
        ss *= (1.0f / 256.0f);                            \
        { auto r16 = __builtin_amdgcn_permlane16_swap(__float_as_uint(ss), __float_as_uint(ss), false, false); ss = __uint_as_float(r16[0]) + __uint_as_float(r16[1]); \
          auto r32_ = __builtin_amdgcn_permlane32_swap(__float_as_uint(ss), __float_as_uint(ss), false, false); ss = __uint_as_float(r32_[0]) + __uint_as_float(r32_[1]); } \
        ss += (ksq_); \
        const float rs = __builtin_amdgcn_rsqf(ss * (1.f / QKH) + EPS); \
        if (fq == 0) *(LAS float*)(lds + SA_RS + (Q20) * SA_RSB + h * 128 + key_ * 4) = rs; } while (0)
#define SA_NSTAGE(Q20, Q40) do { \
        const float ksq0 = *(const LAS float*)(lds + SA_KSQ + (Q40) * SA_KSB + fr * 4), ksq1 = *(const LAS float*)(lds + SA_KSQ + (Q40) * SA_KSB + (16 + fr) * 4); \
        v8i nb[2]; f32x4 na0[4], na1[4]; \
        SA_NLOAD(0, Q20, nb); __builtin_amdgcn_sched_barrier(0); \
        SA_NMMA(nb, na0); __builtin_amdgcn_sched_barrier(0); \
        SA_NLOAD(1, Q20, nb); __builtin_amdgcn_sched_barrier(0); \
        SA_NTAIL(0, Q20, na0, ksq0); __builtin_amdgcn_sched_barrier(0); \
        SA_NMMA(nb, na1); __builtin_amdgcn_sched_barrier(0); \
        SA_NTAIL(1, Q20, na1, ksq1); } while (0)
#define SA_BODY(I, FULL, Q4M2, Q4M1, Q40, Q4P1, Q2M2, Q2M1, Q20, Q2P1) do { const int i = (I); \
        if ((SA_STAGGER ? wave >= 4 : true) && ((FULL) || i >= 2)) SA_PV(Q4M2, Q2M2); \
          \
        if ((FULL) || i < NC) SA_NSTAGE(Q20, Q40); \
          \
        if (((FULL) || (i >= 1 && i <= NC)) && (Q2M1) == spar) { \
            const int key = skb * 16 + fr; const bool newc = (FULL) ? false : (i - 1 >= NCD); \
            const LAS unsigned char* lrow = lds + SA_LT + (Q4M1) * SA_LTB + key * 512; const int gk = sa_g(key); \
            const LAS unsigned char* krow = lds + SA_KP + (Q4M1) * SA_KPB + key * 64 + ((fq ^ sa_pi((key >> 2) & 3)) << 4); \
            const float rsv = *(const LAS float*)(lds + SA_RS + (Q2M1) * SA_RSB + (4 * sg + fq) * 128 + key * 4);        \
            f32x4 sacc = (f32x4){0.f, 0.f, 0.f, 0.f}; \
            _Pragma("unroll") \
            for (int s = 0; s < 9; ++s) { const bf16x8 bf = (s < 8) ? *(const LAS bf16x8*)(lrow + (((4 * s + fq) ^ gk) << 4)) : *(const LAS bf16x8*)(krow); const bf16x8 qa = *(const LAS bf16x8*)(qaf + 64 * s); sacc = MFMA16(qa, bf, sacc); } \
            float pv[4]; \
            _Pragma("unroll") \
            for (int i4 = 0; i4 < 4; ++i4) { float p = __builtin_amdgcn_exp2f(sacc[i4] * rsv); if (newc && (key >= DS || key > i4)) p = 0.f; lsum[i4] += p; pv[i4] = p; } \
            v2u w; w.x = pk2(pv[0], pv[1]); w.y = pk2(pv[2], pv[3]); \
            *(LAS v2u*)(lds + SA_PL + (Q2M1) * SA_PLB + key * SA_PROW + sg * 32 + fq * 8) = w;         \
        } \
        if (SA_STAGGER && wave < 4 && ((FULL) || i >= 2)) SA_PV(Q4M2, Q2M2); \
        if ((FULL) || i + 1 < NC) { SA_WRITE(Q4P1, Q2P1); if ((FULL) || i + 2 < NC) SA_LOAD(i + 2); } \
        asm volatile("s_waitcnt lgkmcnt(0)" ::: "memory"); __builtin_amdgcn_s_barrier(); asm volatile("" ::: "memory"); \
    } while (0)
#define SA_GEN(I) SA_BODY(I, false, ((I) - 2) & 3, ((I) - 1) & 3, (I) & 3, ((I) + 1) & 3, (I) & 1, ((I) - 1) & 1, (I) & 1, ((I) + 1) & 1)
    SA_GEN(0); SA_GEN(1);
    int ii = 2;
    for (; ii + 3 <= NC - 3; ii += 4) {
        SA_BODY(ii,     true, 0, 1, 2, 3, 0, 1, 0, 1);
        SA_BODY(ii + 1, true, 1, 2, 3, 0, 1, 0, 1, 0);
        SA_BODY(ii + 2, true, 2, 3, 0, 1, 0, 1, 0, 1);
        SA_BODY(ii + 3, true, 3, 0, 1, 2, 1, 0, 1, 0);
    }
    for (; ii <= NC + 1; ++ii) SA_GEN(ii);
    {
        int l2 = lane; asm volatile("" : "+v"(l2)); const int r32e = l2 & 31, hie = l2 >> 5; asm volatile("" : "+s"(ws));
        float* part = (float*)(ws + WS_PART) + ((size_t)(b * SA_NS + sp) * 32 + r32e) * KVL + 32 * wave;
#pragma unroll
        for (int g = 0; g < 4; ++g) *(GAS f32x4*)(part + 8 * g + 4 * hie) = (f32x4){ol[4 * g], ol[4 * g + 1], ol[4 * g + 2], ol[4 * g + 3]};
#pragma unroll
        for (int i4 = 0; i4 < 4; ++i4) { float v = lsum[i4]; v += __shfl_xor(v, 1); v += __shfl_xor(v, 2); v += __shfl_xor(v, 4); v += __shfl_xor(v, 8);
            if ((l2 & 15) == 0) *(LAS float*)(lds + SA_LRED + (wave * 16 + 4 * (l2 >> 4) + i4) * 4) = v; }
        __syncthreads();
        if (wave == 0 && l2 < 32) { const int g = l2 >> 4, idx = l2 & 15; float t = 0.f;
#pragma unroll
            for (int w4 = 0; w4 < 4; ++w4) t += *(const LAS float*)(lds + SA_LRED + ((2 * w4 + g) * 16 + idx) * 4);
            ((float*)(ws + WS_LPART))[(size_t)(b * SA_NS + sp) * 32 + l2] = t; }
    }
#undef SA_LOAD
#undef SA_WRITE
#undef SA_PV
#undef SA_BODY
#undef SA_GEN
#undef SA_NLOAD
#undef SA_NMMA
#undef SA_NTAIL
#undef SA_NSTAGE
}

__device__ __forceinline__ void p3_attention(const Params& P, Frame& F) {
    const int c = blockIdx.x, G = F.G;
#ifndef PA_REP
#define PA_REP 1
#endif
#ifndef SA_REP
#define SA_REP 1
#endif
#ifndef NO_PA
    for (int rep = 0; rep < PA_REP; ++rep)
    for (int u = c; u < 512; u += G) { const int i = u >> 8, cc = u & 255; const int k = cc >> 6, bh = cc & 63; const int qb = (i == 0) ? 7 - k : k; pattn_unit(P, F, bh >> 3, bh & 7, qb); }
#endif
#ifndef NO_SA
    for (int rep = 0; rep < SA_REP; ++rep)
    for (int u = c; u < DB * SA_NS; u += G) sattn_unit(P, F, u / SA_NS, u % SA_NS);
#endif
}

__device__ __forceinline__ void p4a_sample(const Params& P, Frame& F) {
    unsigned char* ws = P.ws; const int lane = F.lane, h = F.wave;
    LAS float* scr = (LAS float*)(F.lds + RING_OFF + F.wave * 2048);
    LAS float* ssb = (LAS float*)(F.lds + RING_OFF + 16384);
    const int r0 = MP + 2 * (int)blockIdx.x; if (r0 >= MR) return;
    const int b = (r0 - MP) >> 2, m0 = h * 4 + ((r0 - MP) & 3);
    {
        float l[2] = {0.f, 0.f}; f32x4 acc[2] = {(f32x4){0.f, 0.f, 0.f, 0.f}, (f32x4){0.f, 0.f, 0.f, 0.f}};
#pragma unroll
        for (int sp = 0; sp < SA_NS; ++sp)
#pragma unroll
            for (int q = 0; q < 2; ++q) { l[q] += ((const float*)(ws + WS_LPART))[(size_t)(b * SA_NS + sp) * 32 + m0 + q];
                acc[q] = acc[q] + *(const GAS f32x4*)((const float*)(ws + WS_PART) + ((size_t)(b * SA_NS + sp) * 32 + m0 + q) * KVL + 4 * lane); }
#pragma unroll
        for (int q = 0; q < 2; ++q) *(LAS f32x4*)(scr + 256 * q + 4 * lane) = acc[q] * (1.0f / l[q]);
    }
    LDS_WAIT(); asm volatile("" ::: "memory");
    const int cg = lane >> 3, dq = lane & 7;
    const GAS unsigned char* wp = (const GAS unsigned char*)((const bf16*)(ws + WS_WUKVB) + (size_t)cg * 1024 + h * 128 + 64 + 8 * dq);
    float o8[2][8];
#pragma unroll
    for (int i = 0; i < 8; ++i) { o8[0][i] = 0.f; o8[1][i] = 0.f; }
#pragma unroll 1
    for (int kb = 0; kb < 2; ++kb) {
        v4u w[16];
#pragma unroll
        for (int kk = 0; kk < 16; ++kk) w[kk] = *(const GAS v4u*)(wp + (size_t)(8 * (16 * kb + kk)) * 2048);
#pragma unroll
        for (int kk = 0; kk < 16; ++kk) { const float sc0 = scr[8 * (16 * kb + kk) + cg], sc1 = scr[256 + 8 * (16 * kb + kk) + cg]; float e[8]; unpack8(w[kk], e);
#pragma unroll
            for (int i = 0; i < 8; ++i) { o8[0][i] += sc0 * e[i]; o8[1][i] += sc1 * e[i]; } }
    }
    float ssw[2] = {0.f, 0.f};
#pragma unroll
    for (int q = 0; q < 2; ++q) {
#pragma unroll
        for (int i = 0; i < 8; ++i) { float v = o8[q][i]; v += __shfl_xor(v, 8); v += __shfl_xor(v, 16); v += __shfl_xor(v, 32); o8[q][i] = v; ssw[q] += v * v; }
        ssw[q] += __shfl_xor(ssw[q], 1); ssw[q] += __shfl_xor(ssw[q], 2); ssw[q] += __shfl_xor(ssw[q], 4);
    }
    if (lane == 0) { ssb[h] = ssw[0]; ssb[8 + h] = ssw[1]; }
    __syncthreads();
#pragma unroll
    for (int q = 0; q < 2; ++q) {
        float tot = 0.f;
#pragma unroll
        for (int j = 0; j < NH; ++j) tot += ssb[8 * q + j];
        const float rs = 1.0f / sqrtf(tot * (1.f / AW) + EPS);
        if (cg == 0) { float e[8];
#pragma unroll
            for (int i = 0; i < 8; ++i) e[i] = o8[q][i] * rs;
            *(GAS v4u*)((bf16*)(ws + WS_MIX) + (size_t)(r0 + q) * DM + h * VH + 8 * dq) = pack8(e); }
    }
    __syncthreads();
}

__device__ __forceinline__ f32x16 skinny_tile(LAS unsigned char* wl  , const bf16* A, int lda, const bf16* Bt, int ldb, int row0, int col0, int kbeg, int kend, int lane) {
    const int r32 = lane & 31, hi = lane >> 5, lr = lane >> 3, lc = lane & 7;
    const GAS unsigned char* ap = (const GAS unsigned char*)(A + (size_t)(row0 + lr) * lda + kbeg) + 16 * lc;
    const GAS unsigned char* bp = (const GAS unsigned char*)(Bt + (size_t)(col0 + lr) * ldb + kbeg) + 16 * lc;
    const size_t astep = (size_t)8 * lda * 2, bstep = (size_t)8 * ldb * 2;
    f32x16 acc;
#pragma unroll
    for (int r = 0; r < 16; ++r) acc[r] = 0.f;
    v4u ra[4], rb[4];
#pragma unroll
    for (int j = 0; j < 4; ++j) { ra[j] = *(const GAS v4u*)(ap + j * astep); rb[j] = *(const GAS v4u*)(bp + j * bstep); }
    const int nit = (kend - kbeg) >> 6;
    LAS unsigned char* wst = wl + lr * 144 + lc * 16;
    const LAS unsigned char* rfa = wl + r32 * 144 + hi * 16;
#pragma unroll 1
    for (int it = 0; it < nit; ++it) {
#pragma unroll
        for (int j = 0; j < 4; ++j) { *(LAS v4u*)(wst + j * (8 * 144)) = ra[j]; *(LAS v4u*)(wst + 4608 + j * (8 * 144)) = rb[j]; }
        if (it + 1 < nit) {
#pragma unroll
            for (int j = 0; j < 4; ++j) { ra[j] = *(const GAS v4u*)(ap + (size_t)(it + 1) * 128 + j * astep); rb[j] = *(const GAS v4u*)(bp + (size_t)(it + 1) * 128 + j * bstep); } }
        bf16x8 a[4], b[4];
#pragma unroll
        for (int s4 = 0; s4 < 4; ++s4) { a[s4] = *(const LAS bf16x8*)(rfa + 32 * s4); b[s4] = *(const LAS bf16x8*)(rfa + 4608 + 32 * s4); }
#pragma unroll
        for (int s4 = 0; s4 < 4; ++s4) acc = MFMA32(a[s4], b[s4], acc);
    }
    return acc;
}
__device__ __forceinline__ f32x16 coop_tile(LAS unsigned char* img  , const bf16* A, int lda, const bf16* Bt, int ldb, int row0, int col0, int K, int tid, int wave) {
    const int lane = tid & 63, r32 = lane & 31, hi = lane >> 5, lr = tid >> 3, lc = tid & 7;
    const GAS unsigned char* ap = (const GAS unsigned char*)(A + (size_t)(row0 + lr) * lda) + 16 * lc;
    const GAS unsigned char* bp = (const GAS unsigned char*)(Bt + (size_t)(col0 + lr) * ldb) + 16 * lc;
    const size_t bstep = (size_t)64 * ldb * 2;
    constexpr int STG = 192 * 144;
    LAS unsigned char* wst = img + lr * 144 + lc * 16;
    const LAS unsigned char* rfa = img + (32 * (wave >> 2) + r32) * 144 + hi * 16;
    const LAS unsigned char* rfb = img + 9216 + (32 * (wave & 3) + r32) * 144 + hi * 16;
    f32x16 acc;
#pragma unroll
    for (int r = 0; r < 16; ++r) acc[r] = 0.f;
    v4u r0[3], r1[3];
#define CT_LOAD(R, blk) do { const size_t ko_ = (size_t)(blk) * 128; R[0] = *(const GAS v4u*)(ap + ko_); R[1] = *(const GAS v4u*)(bp + ko_); R[2] = *(const GAS v4u*)(bp + bstep + ko_); } while (0)
#define CT_PUT(R, st) do { *(LAS v4u*)(wst + (st) * STG) = R[0]; *(LAS v4u*)(wst + (st) * STG + 9216) = R[1]; *(LAS v4u*)(wst + (st) * STG + 9216 + 64 * 144) = R[2]; } while (0)
#define CT_MMA(st) do { bf16x8 a[4], b[4]; \
        _Pragma("unroll") \
        for (int s4 = 0; s4 < 4; ++s4) { a[s4] = *(const LAS bf16x8*)(rfa + (st) * STG + 32 * s4); b[s4] = *(const LAS bf16x8*)(rfb + (st) * STG + 32 * s4); } \
        _Pragma("unroll") \
        for (int s4 = 0; s4 < 4; ++s4) acc = MFMA32(a[s4], b[s4], acc); } while (0)
    CT_LOAD(r0, 0); CT_LOAD(r1, 1);
    const int nit = K >> 6;
#pragma unroll 1
    for (int it = 0; it < nit; it += 2) {
        CT_PUT(r0, 0); if (it + 2 < nit) CT_LOAD(r0, it + 2);
        __syncthreads();
        CT_MMA(0);
        CT_PUT(r1, 1); if (it + 3 < nit) CT_LOAD(r1, it + 3);
        __syncthreads();
        CT_MMA(1);
    }
#undef CT_LOAD
#undef CT_PUT
#undef CT_MMA
    __syncthreads();
    return acc;
}
template <bool XCOPY> __device__ __forceinline__ void skinny_res_n1024(Frame& F, const bf16* A, int lda, const bf16* Bt, int K, const float* base, float* out, bf16* xb, float* rowss) {
    int tid_ = threadIdx.x; asm volatile("" : "+v"(tid_)); const int lane = tid_ & 63, wave = __builtin_amdgcn_readfirstlane(tid_ >> 6), r32 = lane & 31, hi = lane >> 5;
    const int t = 2 * blockIdx.x + (wave >> 2), kq = wave & 3; const int row0 = 32 * (t >> 5), col0 = 32 * (t & 31);
    LAS float* red = (LAS float*)(F.lds + RING_OFF);
    f32x16 acc;
#pragma unroll
    for (int r = 0; r < 16; ++r) acc[r] = 0.f;
    if (t < 512) acc = skinny_tile(F.lds + RING_OFF + 32768 + wave * 9216, A, lda, Bt, K, row0, col0, kq * (K >> 2), (kq + 1) * (K >> 2), lane);
    if (kq != 0) {
#pragma unroll
        for (int r = 0; r < 16; ++r) red[wave * 1024 + r * 64 + lane] = acc[r]; }
    __syncthreads();
    if (kq == 0 && t < 512) {
#pragma unroll
        for (int r = 0; r < 16; ++r) { const float v = acc[r] + red[(wave + 1) * 1024 + r * 64 + lane] + red[(wave + 2) * 1024 + r * 64 + lane] + red[(wave + 3) * 1024 + r * 64 + lane];
            const size_t o = (size_t)(row0 + crow(r, hi)) * DM + col0 + r32;
            if (!XCOPY) { out[o] = __uint_as_float((unsigned)xb[o] << 16) + v; }
            else { const float x1 = base[o] + v; xb[o] = (bf16)(pk2(x1, 0.f) & 0xffffu); float q = x1 * x1; q += __shfl_xor(q, 1); q += __shfl_xor(q, 2); q += __shfl_xor(q, 4); q += __shfl_xor(q, 8); q += __shfl_xor(q, 16);
                if (r32 == 0) atomicAdd(rowss + row0 + crow(r, hi), q); } }
    }
    __syncthreads();
}
__device__ __forceinline__ void skinny_up(Frame& F, const bf16* A, const bf16* Bt, bf16* H, const float* rowss) {
    int tid_ = threadIdx.x; asm volatile("" : "+v"(tid_)); const int lane = tid_ & 63, wave = __builtin_amdgcn_readfirstlane(tid_ >> 6), r32 = lane & 31, hi = lane >> 5;
    const int c = blockIdx.x; if (c >= 256) return;
    const int row0 = 64 * (c >> 5) + 32 * (wave >> 2), col0 = 128 * (c & 31) + 32 * (wave & 3);
    const f32x16 acc = coop_tile(F.lds + RING_OFF, A, DM, Bt, DM, 64 * (c >> 5), 128 * (c & 31), DM, tid_, wave);
#pragma unroll
    for (int r = 0; r < 16; ++r) { const float a = acc[r] * __builtin_amdgcn_rsqf(rowss[row0 + crow(r, hi)] * (1.0f / 1024.0f) + 1e-6f); const float v = a > 0.f ? a : 0.f; H[(size_t)(row0 + crow(r, hi)) * DFF + col0 + r32] = (bf16)(pk2(v * v, 0.f) & 0xffffu); }
}

__device__ __forceinline__ void p1_leftover(const Params& P, Frame& F) {
    unsigned char* ws = P.ws;
    int tid_ = threadIdx.x; asm volatile("" : "+v"(tid_)); const int lane = tid_ & 63, wave = __builtin_amdgcn_readfirstlane(tid_ >> 6), r32 = lane & 31, hi = lane >> 5;
    const bf16* XN = (const bf16*)(ws + WS_XN); const bf16* WIN = (const bf16*)(ws + WS_WIN); bf16* Z = (bf16*)(ws + WS_Z);
    for (int ta = blockIdx.x; ta < 256 + 9 * 18; ta += gridDim.x) {
        int R0, C0; if (ta < 256) { R0 = 64 * ta; C0 = 2048; } else { const int u = ta - 256; R0 = MP + 64 * (u / 18); C0 = 128 * (u % 18); }
        const f32x16 acc = coop_tile(F.lds + RING_OFF, XN, DM, WIN, DM, R0, C0, DM, tid_, wave);
        const int row0 = R0 + 32 * (wave >> 2), col0 = C0 + 32 * (wave & 3);
#pragma unroll
        for (int r = 0; r < 16; ++r) Z[(size_t)(row0 + crow(r, hi)) * INWP + col0 + r32] = (bf16)(pk2(acc[r], 0.f) & 0xffffu);
    }
    LAS float* red = (LAS float*)(F.lds + RING_OFF);
    for (int tc = blockIdx.x; tc < MP / 64; tc += gridDim.x) {
        const int row0 = 64 * tc + 32 * (wave >> 2), kq = wave & 3;
        const f32x16 acc = skinny_tile(F.lds + RING_OFF + 32768 + wave * 9216, XN, DM, WIN, DM, row0, 2176, 256 * kq, 256 * (kq + 1), lane);
        if (kq != 0) {
#pragma unroll
            for (int r = 0; r < 16; ++r) red[wave * 1024 + r * 64 + lane] = acc[r]; }
        __syncthreads();
        if (kq == 0) {
#pragma unroll
            for (int r = 0; r < 16; ++r) { const float v = acc[r] + red[(wave + 1) * 1024 + r * 64 + lane] + red[(wave + 2) * 1024 + r * 64 + lane] + red[(wave + 3) * 1024 + r * 64 + lane];
                Z[(size_t)(row0 + crow(r, hi)) * INWP + 2176 + r32] = (bf16)(pk2(v, 0.f) & 0xffffu); } }
        __syncthreads();
    }
}

struct EpiKV {
    static constexpr bool PERM = true, AFTER_DRAIN = false, HAS_MID = false;
    bf16* KV; bf16* K; const float* kper; const float* kss; const float* g; LAS float* ex;
    __device__ __forceinline__ void operator()(const pg8::f32x4 (&acc)[2][2][4][2], const pg8::Unit& u, int wr_in, int wc_in, int fr_in, int fq_in) const {
        int wr = wr_in, wc = wc_in, fr = fr_in, fq = fq_in; asm volatile("" : "+s"(wr), "+s"(wc), "+v"(fr), "+v"(fq));
        const bool kpart = wc < 2;
        const int rowb = u.pm * 256 + wr * 64 + fr;
        if (kpart) {
#pragma unroll
            for (int ai = 0; ai < 2; ++ai)
#pragma unroll
                for (int m = 0; m < 4; ++m)
#pragma unroll
                    for (int bj = 0; bj < 2; ++bj) { const pg8::f32x4 a0 = acc[ai][bj][m][0], a1 = acc[ai][bj][m][1];
                        float ss = ((a0[0] * a0[0] + a0[1] * a0[1]) + (a0[2] * a0[2] + a0[3] * a0[3])) + ((a1[0] * a1[0] + a1[1] * a1[1]) + (a1[2] * a1[2] + a1[3] * a1[3]));
                        { auto r16 = __builtin_amdgcn_permlane16_swap(__float_as_uint(ss), __float_as_uint(ss), false, false); ss = __uint_as_float(r16[0]) + __uint_as_float(r16[1]);
                          auto r32 = __builtin_amdgcn_permlane32_swap(__float_as_uint(ss), __float_as_uint(ss), false, false); ss = __uint_as_float(r32[0]) + __uint_as_float(r32[1]); }
                        if (fq == 0) ex[((((wr * 2 + wc) * 2 + ai) * 4 + m) * 2 + bj) * 16 + fr] = ss; }
        } else {
            const int col0 = u.pn * 256 + wc * 32 + 8 * fq;
#pragma unroll
            for (int ai = 0; ai < 2; ++ai)
#pragma unroll
                for (int m = 0; m < 4; ++m) { bf16* rowp = KV + (size_t)(rowb + ai * 128 + m * 16) * 1024 + col0;
#pragma unroll
                    for (int bj = 0; bj < 2; ++bj) { const pg8::f32x4 v0 = acc[ai][bj][m][0], v1 = acc[ai][bj][m][1];
                        v4u w; w.x = pk2(v0[0], v0[1]); w.y = pk2(v0[2], v0[3]); w.z = pk2(v1[0], v1[1]); w.w = pk2(v1[2], v1[3]);
                        pg8::st_wt16(rowp + bj * 128, w); } }
        }
        asm volatile("s_waitcnt lgkmcnt(0)" ::: "memory"); __builtin_amdgcn_s_barrier(); asm volatile("" ::: "memory");
        const bool prompt = u.pm < MP / 256;
        if (!prompt && u.pm != MR / 256) return;
        const int d0 = kpart ? 32 * wc + 8 * fq : 64 + 8 * fq;
        const int nrep = prompt ? 1 : NB;
        const int bjr = wc & 1;
        const LAS float* exr = ex + wr * 512 + fr;
#pragma unroll
        for (int ai = 0; ai < 2; ++ai) {
#pragma unroll
            for (int m = 0; m < 4; ++m) { const int row = rowb + ai * 128 + m * 16;
                const bool rv = prompt || row < MR + NMETA;
                const float ks = kss[row];
                const pg8::f32x4 g0 = *(const GAS pg8::f32x4*)(g + d0), g1 = *(const GAS pg8::f32x4*)(g + d0 + 4);
                const int kofs = (prompt ? ((row >> 11) * TPP + NMETA + (row & 2047)) : (row - MR)) * 768 + 2 * u.pn * QKH + d0;
                if (kpart) {
#pragma unroll
                    for (int bj = 0; bj < 2; ++bj) {
                        const float tot = exr[(ai * 4 + m) * 32 + bj * 16] + exr[256 + (ai * 4 + m) * 32 + bj * 16] + ks;
                        const float rs = __builtin_amdgcn_rsqf(tot * (1.f / QKH) + EPS);
                        const pg8::f32x4 v0 = acc[ai][bj][m][0] * rs * g0, v1 = acc[ai][bj][m][1] * rs * g1;
                        v4u w; w.x = pk2(v0[0], v0[1]); w.y = pk2(v0[2], v0[3]); w.z = pk2(v1[0], v1[1]); w.w = pk2(v1[2], v1[3]);
                        if (rv) for (int b = 0; b < nrep; ++b) *(GAS v4u*)(K + (size_t)(kofs + bj * QKH) + (size_t)b * (TPP * 768)) = w; }
                } else {
                    const float tot = exr[(ai * 4 + m) * 32 + bjr * 16] + exr[256 + (ai * 4 + m) * 32 + bjr * 16] + ks;
                    const float rs = __builtin_amdgcn_rsqf(tot * (1.f / QKH) + EPS);
                    const pg8::f32x4 k0 = *(const GAS pg8::f32x4*)(kper + (size_t)row * QKR + 8 * fq), k1 = *(const GAS pg8::f32x4*)(kper + (size_t)row * QKR + 8 * fq + 4);
                    const pg8::f32x4 v0 = k0 * rs * g0, v1 = k1 * rs * g1;
                    v4u w; w.x = pk2(v0[0], v0[1]); w.y = pk2(v0[2], v0[3]); w.z = pk2(v1[0], v1[1]); w.w = pk2(v1[2], v1[3]);
                    if (rv) for (int b = 0; b < nrep; ++b) *(GAS v4u*)(K + (size_t)(kofs + bjr * QKH) + (size_t)b * (TPP * 768)) = w;
                }
                asm volatile("" ::: "memory");
            }
        }
    }
};

__global__ void __launch_bounds__(NWAVES * 64, 2) hymba_fwd(Params P) {
    extern __shared__ __attribute__((aligned(16))) unsigned char lds_raw[];
    Frame F;
    F.lds = (LAS unsigned char*)lds_raw;
    F.MISC = (volatile LAS unsigned*)(F.lds + MISC_OFF);
    F.tid = threadIdx.x; F.lane = F.tid & 63; F.wave = __builtin_amdgcn_readfirstlane(F.tid >> 6);
    F.G = gridDim.x; F.gw = blockIdx.x * NWAVES + F.wave; F.NGW = F.G * NWAVES;
    unsigned char* ws = P.ws;
    F.ctl = (gu32*)(ws + WS_CTL);
    for (int u = F.tid; u < (LDS_BYTES - LDSCTL_OFF) / 4; u += NWAVES * 64) ((LAS unsigned*)(F.lds + LDSCTL_OFF))[u] = 0u;
    __syncthreads();
    const bool multi = (P.ph_hi - P.ph_lo) > 1;
    XcdBarrier bar; bar.bar = (unsigned*)(F.ctl + CW_BAR); bar.x = 0; bar.st = nullptr;
    if (multi) bar = xcd_barrier_post((unsigned*)(F.ctl + CW_BAR), F.MISC + 8);
    const int lo = P.ph_lo, hi = P.ph_hi;
#define REFRESH() do { int t_ = threadIdx.x; asm volatile("" : "+v"(t_)); F.tid = t_; F.lane = t_ & 63; F.wave = __builtin_amdgcn_readfirstlane(t_ >> 6); F.gw = blockIdx.x * NWAVES + F.wave; } while (0)
#ifndef PHM
#define PHM 0x7ff
#endif
#ifndef PROBE_REP
#define PROBE_REP 0
#endif
#define DUP(k) (IN(k) && ((PROBE_REP >> (k)) & 1))
#define IN(k) (((PHM >> (k)) & 1) && lo <= (k) && (k) < hi)
#define SEAM(k) do { if (IN(k) && IN((k) + 1)) xcd_barrier(bar); } while (0)

    if (IN(0)) { REFRESH(); p0_prologue(P, F); } if (DUP(0)) { REFRESH(); p0_prologue(P, F); } SEAM(0);
    if (IN(1)) {
        pg8::Gemm g{(const bf16*)(ws + WS_XN), (const bf16*)(ws + WS_WIN), MP, 2048, DM}; pg8::StaticOrder S; S.init(MP, 2048, F.G, (int)blockIdx.x);
        pg8::EpiBf16<0> E{(bf16*)(ws + WS_Z), INWP, nullptr, 4};
        const bool early = ((blockIdx.x >> 3) & 1) != 0;
        if (early) { p1_leftover(P, F); __syncthreads(); REFRESH(); p0_late(P, F, F.gw, F.NGW); __syncthreads(); }
        pg8::gemm_phase<pg8::EpiBf16<0>, pg8::StaticOrder, true, true>(F.lds + RING_OFF, g, S, E);
        __syncthreads();
        if (!early) {
        p1_leftover(P, F);
        __syncthreads(); REFRESH(); p0_late(P, F, F.gw, F.NGW);
        }
    }
    SEAM(1);
    if (IN(2)) { REFRESH(); for (int r = F.gw; r < MALL; r += F.NGW) p2a_row(P, F, r); } if (DUP(2)) { REFRESH(); for (int r = F.gw; r < MALL; r += F.NGW) p2a_row(P, F, r); } SEAM(2);
    if (IN(3)) {
        { pg8::Gemm g{(const bf16*)(ws + WS_CQN), (const bf16*)(ws + WS_WUQ), MR, 768, QL}; pg8::StaticOrder S; S.init(MR, 768, F.G, (int)blockIdx.x);
          pg8::EpiBf16<0> E{(bf16*)(ws + WS_QRAW), 768, nullptr, 0};
          pg8::gemm_phase<pg8::EpiBf16<0>, pg8::StaticOrder, true, true>(F.lds + RING_OFF, g, S, E); }
        __syncthreads();
        { pg8::Gemm g{(const bf16*)(ws + WS_LATB), (const bf16*)(ws + WS_WUKV), MPAD, 1024, KVL}; pg8::StaticOrder S; S.init(MPAD, 1024, F.G, (int)((blockIdx.x + 58) % F.G));
          EpiKV E{(bf16*)(ws + WS_KVRAW), (bf16*)(ws + WS_K), (const float*)(ws + WS_KPER), (const float*)(ws + WS_KSS), P.k_norm_g, (LAS float*)(F.lds + RING_OFF + RING_BYTES)};
          pg8::gemm_phase<EpiKV, pg8::StaticOrder, true, true>(F.lds + RING_OFF, g, S, E); }
    }
    SEAM(4);
    if (IN(5)) { REFRESH(); p3_attention(P, F); } SEAM(5);
    if (IN(6)) { REFRESH();
        { const int i = (int)blockIdx.x * 512 + F.tid; if (i < MP) { const f32x4 a = ((const GAS f32x4*)(ws + WS_SSQ))[2 * i], c = ((const GAS f32x4*)(ws + WS_SSQ))[2 * i + 1];
            ((float*)(ws + WS_RSA))[i] = 1.0f / sqrtf(((a.x + a.y) + (a.z + a.w) + (c.x + c.y) + (c.z + c.w)) * (1.f / AW) + EPS); } }
        p4a_sample(P, F); } SEAM(6);
    if (IN(7)) {
        pg8::Gemm g{(const bf16*)(ws + WS_MIX), (const bf16*)(ws + WS_WO), MP, DM, DM}; pg8::StaticOrder S; S.init(MP, DM, F.G, (int)blockIdx.x);
        pg8::EpiF32ResX E{P.x_prompt, (bf16*)(ws + WS_XN), (float*)(ws + WS_ROWSS), DM, (const float*)(ws + WS_RSA)};
        const bool early = ((blockIdx.x >> 3) & 1) != 0;
        if (early) skinny_res_n1024<true>(F, (const bf16*)(ws + WS_MIX) + (size_t)MP * DM, DM, (const bf16*)(ws + WS_WO), DM, P.x_sample, nullptr, (bf16*)(ws + WS_XN) + (size_t)MP * DM, (float*)(ws + WS_ROWSS) + MP);
        pg8::gemm_phase<pg8::EpiF32ResX, pg8::StaticOrder, true, true>(F.lds + RING_OFF, g, S, E);
        __syncthreads();
        if (!early) skinny_res_n1024<true>(F, (const bf16*)(ws + WS_MIX) + (size_t)MP * DM, DM, (const bf16*)(ws + WS_WO), DM, P.x_sample, nullptr, (bf16*)(ws + WS_XN) + (size_t)MP * DM, (float*)(ws + WS_ROWSS) + MP);
    }
    SEAM(7);
    if (IN(9)) {
        pg8::Gemm g{(const bf16*)(ws + WS_XN), (const bf16*)(ws + WS_WUP), MP, DFF, DM}; pg8::StaticOrder S; S.init(MP, DFF, F.G, (int)blockIdx.x);
        pg8::EpiBf16<2> E{(bf16*)(ws + WS_H), DFF, (const float*)(ws + WS_ROWSS), 12};
        const bool early = ((blockIdx.x >> 3) & 1) != 0;
        if (early) { skinny_up(F, (const bf16*)(ws + WS_XN) + (size_t)MP * DM, (const bf16*)(ws + WS_WUP), (bf16*)(ws + WS_H) + (size_t)MP * DFF, (const float*)(ws + WS_ROWSS) + MP); __syncthreads(); }
        pg8::gemm_phase<pg8::EpiBf16<2>, pg8::StaticOrder, true, true>(F.lds + RING_OFF, g, S, E);
        __syncthreads();
        if (!early) skinny_up(F, (const bf16*)(ws + WS_XN) + (size_t)MP * DM, (const bf16*)(ws + WS_WUP), (bf16*)(ws + WS_H) + (size_t)MP * DFF, (const float*)(ws + WS_ROWSS) + MP);
    }
    SEAM(9);
    if (IN(10)) {
        pg8::Gemm g{(const bf16*)(ws + WS_H), (const bf16*)(ws + WS_WDN), MP, DM, DFF}; pg8::StaticOrder S; S.init(MP, DM, F.G, (int)blockIdx.x);
        pg8::EpiF32ResB E{(const bf16*)(ws + WS_XN), P.out + O_YP, DM};
        const bool early = ((blockIdx.x >> 3) & 1) != 0;
        if (early) skinny_res_n1024<false>(F, (const bf16*)(ws + WS_H) + (size_t)MP * DFF, DFF, (const bf16*)(ws + WS_WDN), DFF, nullptr, P.out + O_YS, (bf16*)(ws + WS_XN) + (size_t)MP * DM, nullptr);
        pg8::gemm_phase<pg8::EpiF32ResB, pg8::StaticOrder, true, true>(F.lds + RING_OFF, g, S, E);
        __syncthreads();
        if (!early) skinny_res_n1024<false>(F, (const bf16*)(ws + WS_H) + (size_t)MP * DFF, DFF, (const bf16*)(ws + WS_WDN), DFF, nullptr, P.out + O_YS, (bf16*)(ws + WS_XN) + (size_t)MP * DM, nullptr);
    }
#undef IN
#undef SEAM
}

extern "C" void kernel_launch(void* const* d_in, const int* in_sizes, int n_in, void* d_out, int out_size, void* d_ws, size_t ws_size, hipStream_t stream) {
    static int grid = 0;
    if (grid == 0) {
        if (n_in != 23 || (size_t)out_size != O_END || ws_size < WS_END) { fprintf(stderr, "kernel_launch: unexpected shapes (n_in %d out %d ws %zu)\n", n_in, out_size, ws_size); grid = -1; return; }
        int dev = 0, cus = 0, per_cu = 0;
        if (hipGetDevice(&dev) != hipSuccess || hipDeviceGetAttribute(&cus, hipDeviceAttributeMultiprocessorCount, dev) != hipSuccess) { grid = -1; return; }
        if (hipFuncSetAttribute((const void*)hymba_fwd, hipFuncAttributeMaxDynamicSharedMemorySize, LDS_BYTES) != hipSuccess) { fprintf(stderr, "kernel_launch: hipFuncSetAttribute failed\n"); grid = -1; return; }
        if (hipOccupancyMaxActiveBlocksPerMultiprocessor(&per_cu, (const void*)hymba_fwd, NWAVES * 64, LDS_BYTES) != hipSuccess || per_cu < 1) fprintf(stderr, "kernel_launch: occupancy query reports %d\n", per_cu);
        (void)hipGetLastError();
        grid = cus;
    }
    if (grid < 0) return;
    if (hipMemsetAsync((char*)d_ws + WS_CTL, 0, CTL_ZERO_BYTES, stream) != hipSuccess) return;
    Params p{};
    p.x_prompt = (const float*)d_in[0]; p.x_sample = (const float*)d_in[1]; p.cache_lat = (const float*)d_in[2]; p.cache_kpe = (const float*)d_in[3]; p.state_conv = (const float*)d_in[4];
    p.page_table = (const int*)d_in[5]; p.meta = (const float*)d_in[6]; p.norm_mix_g = (const float*)d_in[7]; p.w_in = (const float*)d_in[8]; p.q_lora_g = (const float*)d_in[9];
    p.kv_lora_g = (const float*)d_in[10]; p.w_uq = (const float*)d_in[11]; p.w_ukv = (const float*)d_in[12]; p.q_norm_g = (const float*)d_in[13]; p.k_norm_g = (const float*)d_in[14];
    p.conv_w = (const float*)d_in[15]; p.conv_b = (const float*)d_in[16]; p.attn_out_g = (const float*)d_in[17]; p.conv_out_g = (const float*)d_in[18]; p.w_o = (const float*)d_in[19];
    p.norm_ffn_g = (const float*)d_in[20]; p.w_up = (const float*)d_in[21]; p.w_down = (const float*)d_in[22];
    p.out = (float*)d_out; p.ws = (unsigned char*)d_ws;
#if MK_N_LAUNCHES == 1
    p.ph_lo = 0; p.ph_hi = N_PHASES; p.li = 0; p.pad = 0;
    hipLaunchKernelGGL(hymba_fwd, dim3(grid), dim3(NWAVES * 64), LDS_BYTES, stream, p);
#else
    for (int li = 0; li < N_PHASES; ++li) { p.ph_lo = li; p.ph_hi = li + 1; p.li = li; p.pad = 0;
        hipLaunchKernelGGL(hymba_fwd, dim3(grid), dim3(NWAVES * 64), LDS_BYTES, stream, p); }
#endif
}
```

```cpp
#include <hip/hip_runtime.h>
#include <cstdio>
#include <cstdint>
namespace pg8 {
#define PG8_LAS __attribute__((address_space(3)))
typedef unsigned short bf16_t;
typedef short bf16x8 __attribute__((ext_vector_type(8)));
typedef float f32x4 __attribute__((ext_vector_type(4)));
typedef unsigned u32x4 __attribute__((ext_vector_type(4)));
constexpr int BM = 256, BK = 64, HALF = 128, HTB = HALF * BK * 2  , STAGE_BYTES = 8 * HTB, NXCD = 8, WGM = 8;

__host__ __device__ __forceinline__ int lds_byte(int r, int c) { const int st = (r >> 4) * 2 + (c >> 5), rr = r & 15, cc = c & 31, ob = rr * 64 + cc * 2; return st * 1024 + (ob ^ (((ob >> 9) & 1) << 5)); }
__host__ __device__ __forceinline__ void stage_rc(int b, int& R, int& C) { const int st = b / 1024, sb = b % 1024, swz = sb ^ (((sb >> 9) & 1) << 5); R = (st >> 1) * 16 + swz / 64; C = (st & 1) * 32 + (swz % 64) / 2; }
__host__ __device__ __forceinline__ int perm32(int rho) { const int n = rho >> 4, i = rho & 15; return 8 * (i >> 2) + 4 * n + (i & 3); }

struct Unit { int pm, pn; };
struct Gemm { const bf16_t* A; const bf16_t* Bt; int M, N, K; };

struct StaticOrder {
    int nM, nN, nwg, G, c;
    __host__ __device__ void init(int M, int N, int G_, int c_) { nM = M / BM; nN = N / BM; nwg = nM * nN; G = G_; c = c_; }
    __host__ __device__ bool next(int i, Unit& u) const {
        const long L = (long)i * G + c; if (L >= nwg) return false;
        int wgid = (int)L; { const int q = nwg / NXCD, r = nwg % NXCD, xcd = wgid % NXCD, off = wgid / NXCD; wgid = (xcd < r ? xcd * (q + 1) : r * (q + 1) + (xcd - r) * q) + off; }
        const int nig = WGM * nN, gid = wgid / nig, fm = gid * WGM, gsz = (nM - fm) < WGM ? (nM - fm) : WGM;
        u.pm = fm + ((wgid % nig) % gsz); u.pn = (wgid % nig) / gsz; return true;
    }
    __device__ __forceinline__ void a_ready(const Unit&) const {}
    __device__ __forceinline__ void done(const Unit&) const {}
};


__device__ __forceinline__ unsigned cvt_pk_bf16(float lo, float hi) { unsigned r; asm volatile("v_cvt_pk_bf16_f32 %0, %1, %2" : "=v"(r) : "v"(lo), "v"(hi)); return r; }

__device__ __forceinline__ void st_wt16(void* p, u32x4 v) { asm volatile("global_store_dwordx4 %0, %1, off sc1\n\ts_nop 1" :: "v"(p), "v"(v) : "memory"); }
template <int ACT  > struct EpiBf16 {
    static constexpr bool PERM = true, AFTER_DRAIN = false, HAS_MID = false;
    bf16_t* O; int ldc; const float* rowss; int wt_pn;
    __device__ __forceinline__ void operator()(const f32x4 (&acc)[2][2][4][2], const Unit& u, int wr, int wc, int fr, int fq) const {
        const int row0 = u.pm * BM + wr * 64 + fr; const int col0 = u.pn * BM + wc * 32 + 8 * fq;
#pragma unroll
        for (int ai = 0; ai < 2; ++ai)
#pragma unroll
            for (int m = 0; m < 4; ++m) { bf16_t* rowp = O + (size_t)(row0 + ai * HALF + m * 16) * ldc + col0;
                const float rsc = rowss ? __builtin_amdgcn_rsqf(rowss[row0 + ai * HALF + m * 16] * (1.0f / 1024.0f) + 1e-6f) : 1.0f;
#pragma unroll
                for (int bj = 0; bj < 2; ++bj) { f32x4 v0 = acc[ai][bj][m][0] * rsc, v1 = acc[ai][bj][m][1] * rsc;
                    if (ACT == 2) {
#pragma unroll
                        for (int e = 0; e < 4; ++e) { const float a = v0[e] > 0.f ? v0[e] : 0.f, b = v1[e] > 0.f ? v1[e] : 0.f; v0[e] = a * a; v1[e] = b * b; } }
                    u32x4 w; w.x = cvt_pk_bf16(v0[0], v0[1]); w.y = cvt_pk_bf16(v0[2], v0[3]); w.z = cvt_pk_bf16(v1[0], v1[1]); w.w = cvt_pk_bf16(v1[2], v1[3]);
                    if (u.pn >= wt_pn) st_wt16(rowp + bj * HALF, w); else *(u32x4*)(rowp + bj * HALF) = w; } }
    }
};
struct EpiF32Res {
    static constexpr bool PERM = false, AFTER_DRAIN = false, HAS_MID = false;
    const float* base; const float* base2; int split_row; float* out; int ldc;
    __device__ __forceinline__ void operator()(const f32x4 (&acc)[2][2][4][2], const Unit& u, int wr, int wc, int fr, int fq) const {
        const int col0 = u.pn * BM + wc * 32 + 4 * fq;
#pragma unroll
        for (int ai = 0; ai < 2; ++ai) {
            f32x4 pre[4][2][2];
#pragma unroll
            for (int m = 0; m < 4; ++m) { const int r = u.pm * BM + ai * HALF + wr * 64 + m * 16 + fr;
                const float* bp = (r < split_row) ? base + (size_t)r * ldc : base2 + (size_t)(r - split_row) * ldc;
#pragma unroll
                for (int bj = 0; bj < 2; ++bj)
#pragma unroll
                    for (int n = 0; n < 2; ++n) pre[m][bj][n] = *(const f32x4*)(bp + col0 + bj * HALF + n * 16); }
            asm volatile("" ::: "memory");
#pragma unroll
            for (int m = 0; m < 4; ++m) { const int r = u.pm * BM + ai * HALF + wr * 64 + m * 16 + fr; float* op = out + (size_t)r * ldc;
#pragma unroll
                for (int bj = 0; bj < 2; ++bj)
#pragma unroll
                    for (int n = 0; n < 2; ++n) *(f32x4*)(op + col0 + bj * HALF + n * 16) = pre[m][bj][n] + acc[ai][bj][m][n]; }
            asm volatile("" ::: "memory");
        }
    }
};
struct EpiF32ResX {
    static constexpr bool PERM = false, AFTER_DRAIN = false, HAS_MID = true;
    const float* base; bf16_t* xb; float* rowss; int ldc; const float* rsa;
    __device__ __forceinline__ void mid(f32x4 (&acc)[2][2][4][2], const Unit& u, int t, int wr, int fr) const {
        if (t != 8) return;
        float rs[2][4];
#pragma unroll
        for (int ai = 0; ai < 2; ++ai)
#pragma unroll
            for (int m = 0; m < 4; ++m) rs[ai][m] = rsa[u.pm * BM + ai * HALF + wr * 64 + m * 16 + fr];
#pragma unroll
        for (int ai = 0; ai < 2; ++ai)
#pragma unroll
            for (int bj = 0; bj < 2; ++bj)
#pragma unroll
                for (int m = 0; m < 4; ++m)
#pragma unroll
                    for (int n = 0; n < 2; ++n) acc[ai][bj][m][n] = acc[ai][bj][m][n] * rs[ai][m];
    }
    __device__ __forceinline__ void operator()(const f32x4 (&acc)[2][2][4][2], const Unit& u, int wr, int wc, int fr, int fq) const {
        const int col0 = u.pn * BM + wc * 32 + 4 * fq;
        typedef unsigned u32x2 __attribute__((ext_vector_type(2)));
#pragma unroll
        for (int ai = 0; ai < 2; ++ai) {
            f32x4 pre[4][2][2];
#pragma unroll
            for (int m = 0; m < 4; ++m) { const int r = u.pm * BM + ai * HALF + wr * 64 + m * 16 + fr; const float* bp = base + (size_t)r * ldc;
#pragma unroll
                for (int bj = 0; bj < 2; ++bj)
#pragma unroll
                    for (int n = 0; n < 2; ++n) pre[m][bj][n] = __builtin_nontemporal_load((const f32x4*)(bp + col0 + bj * HALF + n * 16)); }
            asm volatile("" ::: "memory");
#pragma unroll
            for (int m = 0; m < 4; ++m) { const int r = u.pm * BM + ai * HALF + wr * 64 + m * 16 + fr;
                bf16_t* xp = xb + (size_t)r * ldc; float ss = 0.f;
#pragma unroll
                for (int bj = 0; bj < 2; ++bj)
#pragma unroll
                    for (int n = 0; n < 2; ++n) { const int c = col0 + bj * HALF + n * 16; const f32x4 x1 = pre[m][bj][n] + acc[ai][bj][m][n];
                        ss += (x1[0] * x1[0] + x1[1] * x1[1]) + (x1[2] * x1[2] + x1[3] * x1[3]);
                        u32x2 w; w.x = cvt_pk_bf16(x1[0], x1[1]); w.y = cvt_pk_bf16(x1[2], x1[3]); *(u32x2*)(xp + c) = w; }
                { auto r16 = __builtin_amdgcn_permlane16_swap(__float_as_uint(ss), __float_as_uint(ss), false, false); ss = __uint_as_float(r16[0]) + __uint_as_float(r16[1]);
                  auto r32 = __builtin_amdgcn_permlane32_swap(__float_as_uint(ss), __float_as_uint(ss), false, false); ss = __uint_as_float(r32[0]) + __uint_as_float(r32[1]); }
                if (fq == 0) atomicAdd(rowss + r, ss); }
            asm volatile("" ::: "memory");
        }
    }
};

struct EpiF32ResB {
    static constexpr bool PERM = false, AFTER_DRAIN = false, HAS_MID = false;
    const bf16_t* xb; float* out; int ldc;
    __device__ __forceinline__ void operator()(const f32x4 (&acc)[2][2][4][2], const Unit& u, int wr, int wc, int fr, int fq) const {
        const int col0 = u.pn * BM + wc * 32 + 4 * fq;
        typedef unsigned u32x2 __attribute__((ext_vector_type(2)));
#pragma unroll
        for (int ai = 0; ai < 2; ++ai) {
            u32x2 pre[4][2][2];
#pragma unroll
            for (int m = 0; m < 4; ++m) { const int r = u.pm * BM + ai * HALF + wr * 64 + m * 16 + fr; const bf16_t* bp = xb + (size_t)r * ldc;
#pragma unroll
                for (int bj = 0; bj < 2; ++bj)
#pragma unroll
                    for (int n = 0; n < 2; ++n) pre[m][bj][n] = __builtin_nontemporal_load((const u32x2*)(bp + col0 + bj * HALF + n * 16)); }
            asm volatile("" ::: "memory");
#pragma unroll
            for (int m = 0; m < 4; ++m) { const int r = u.pm * BM + ai * HALF + wr * 64 + m * 16 + fr; float* op = out + (size_t)r * ldc;
#pragma unroll
                for (int bj = 0; bj < 2; ++bj)
#pragma unroll
                    for (int n = 0; n < 2; ++n) { const u32x2 p = pre[m][bj][n];
                        const f32x4 x1 = (f32x4){__uint_as_float(p.x << 16), __uint_as_float(p.x & 0xffff0000u), __uint_as_float(p.y << 16), __uint_as_float(p.y & 0xffff0000u)};
                        __builtin_nontemporal_store(x1 + acc[ai][bj][m][n], (f32x4*)(op + col0 + bj * HALF + n * 16)); } }
            asm volatile("" ::: "memory");
        }
    }
};

template <class Epi, class Sched, bool ALIGN_EPI = false, bool SP2 = false>
__device__ __forceinline__ void gemm_phase(PG8_LAS unsigned char* lds, const Gemm g, const Sched& S, const Epi& E) {
    int tid_l = threadIdx.x; asm volatile("" : "+v"(tid_l));
    const int tid = tid_l, wid = __builtin_amdgcn_readfirstlane(tid >> 6), lane = tid & 63, wr = wid >> 2, wc = wid & 3, fr = lane & 15, fq = lane >> 4;
    const int K = g.K, nt = K / BK;
    unsigned voffA[2], voffB[2];
#pragma unroll
    for (int i = 0; i < 2; ++i) { int R, C; stage_rc(tid * 16 + i * 8192, R, C); const int Rb = Epi::PERM ? ((R & ~31) + perm32(R & 31)) : R;
        voffA[i] = (unsigned)(R * K + C) * 2u; voffB[i] = (unsigned)(Rb * K + C) * 2u; }
    const size_t kstep = (size_t)(BK * 2);
    const size_t hstep = (size_t)HALF * K * 2;
    const size_t tstep = 2 * hstep;
    const unsigned ldsw = (unsigned)wid * 1024u;
    const int aoff = lds_byte(wr * 64 + fr, fq * 8), boff = lds_byte(wc * 32 + fr, fq * 8);
#define PG8_SA(b, h) (((b) * 2 + (h)) * HTB)
#define PG8_SB(b, h) ((4 + (b) * 2 + (h)) * HTB)
#define PG8_STAGE(bufoff, gbase, voff) do { _Pragma("unroll") for (int _i = 0; _i < 2; ++_i) \
        __builtin_amdgcn_global_load_lds((const unsigned*)((const char*)(gbase) + (voff)[_i]), (PG8_LAS unsigned*)(lds + (bufoff) + ldsw + _i * 8192), 16, 0, 0); } while (0)
#define PG8_LDA(dst, b, h) do { _Pragma("unroll") for (int m = 0; m < 4; ++m) _Pragma("unroll") for (int k = 0; k < 2; ++k) dst[m][k] = *(const PG8_LAS bf16x8*)(lds + PG8_SA(b, h) + aoff + m * 2048 + k * 1024); } while (0)
#define PG8_LDB(dst, b, h) do { _Pragma("unroll") for (int n = 0; n < 2; ++n) _Pragma("unroll") for (int k = 0; k < 2; ++k) dst[n][k] = *(const PG8_LAS bf16x8*)(lds + PG8_SB(b, h) + boff + n * 2048 + k * 1024); } while (0)
#define PG8_MMA(ai, bj, At, Bt) do { __builtin_amdgcn_s_setprio(1); _Pragma("unroll") for (int m = 0; m < 4; ++m) _Pragma("unroll") for (int n = 0; n < 2; ++n) _Pragma("unroll") for (int k = 0; k < 2; ++k) \
        acc[ai][bj][m][n] = __builtin_amdgcn_mfma_f32_16x16x32_bf16(Bt[n][k], At[m][k], acc[ai][bj][m][n], 0, 0, 0); __builtin_amdgcn_s_setprio(0); } while (0)
#define PG8_WAIT_V(n) asm volatile("s_waitcnt vmcnt(" #n ")" ::: "memory")
#define PG8_WAIT_L(n) asm volatile("s_waitcnt lgkmcnt(" #n ")" ::: "memory")
#define PG8_BAR __builtin_amdgcn_s_barrier()
#define PG8_SCHED __builtin_amdgcn_sched_barrier(0)
    Unit cur, nxt; int ui = 0;
    if (!S.next(0, cur)) return;
    f32x4 acc[2][2][4][2];
#pragma unroll
    for (int a = 0; a < 2; ++a)
#pragma unroll
        for (int b = 0; b < 2; ++b)
#pragma unroll
            for (int m = 0; m < 4; ++m)
#pragma unroll
                for (int n = 0; n < 2; ++n) acc[a][b][m][n] = (f32x4){0.f, 0.f, 0.f, 0.f};
    bf16x8 At[4][2], B0[2][2], B1[2][2];
    const char* cA = (const char*)g.A + (size_t)cur.pm * tstep; const char* cB = (const char*)g.Bt + (size_t)cur.pn * tstep;
    S.a_ready(cur);
    if constexpr (SP2) {
        PG8_STAGE(PG8_SB(0, 0), cB, voffB); PG8_STAGE(PG8_SB(0, 1), cB + hstep, voffB); PG8_STAGE(PG8_SA(0, 0), cA, voffA); PG8_STAGE(PG8_SA(0, 1), cA + hstep, voffA);
        if (wr == 1) PG8_BAR;
        PG8_WAIT_V(2); PG8_BAR;
        PG8_STAGE(PG8_SB(1, 0), cB + kstep, voffB); PG8_STAGE(PG8_SA(1, 0), cA + kstep, voffA); PG8_STAGE(PG8_SB(1, 1), cB + hstep + kstep, voffB);
        PG8_WAIT_V(6); PG8_BAR;
    } else {
        PG8_STAGE(PG8_SB(0, 0), cB, voffB); PG8_STAGE(PG8_SA(0, 0), cA, voffA); PG8_STAGE(PG8_SB(0, 1), cB + hstep, voffB); PG8_STAGE(PG8_SA(0, 1), cA + hstep, voffA);
        if (wr == 1) PG8_BAR;
        PG8_WAIT_V(4); PG8_BAR;
        PG8_STAGE(PG8_SB(1, 0), cB + kstep, voffB); PG8_STAGE(PG8_SA(1, 0), cA + kstep, voffA); PG8_STAGE(PG8_SB(1, 1), cB + hstep + kstep, voffB);
        PG8_WAIT_V(6); PG8_BAR;
    }
    for (;;) {
        const bool has_next = S.next(ui + 1, nxt);
        const char* nA = has_next ? (const char*)g.A + (size_t)nxt.pm * tstep : cA; const char* nB = has_next ? (const char*)g.Bt + (size_t)nxt.pn * tstep : cB;
        for (int t = 0; t < nt; t += 2) {
            const bool last = (t == nt - 2);
            const char* a1 = cA + (size_t)(t + 1) * kstep;
            const char* a2 = last ? nA : cA + (size_t)(t + 2) * kstep; const char* b2 = last ? nB : cB + (size_t)(t + 2) * kstep;
            const char* a3 = a2 + kstep; const char* b3 = b2 + kstep;
            if (last && has_next) S.a_ready(nxt);
            if constexpr (Epi::HAS_MID) E.mid(acc, cur, t, wr, fr);
            if constexpr (SP2) {
            PG8_LDB(B0, 0, 0); PG8_LDB(B1, 0, 1); PG8_SCHED; PG8_LDA(At, 0, 0); PG8_STAGE(PG8_SA(1, 1), a1 + hstep, voffA);
            PG8_WAIT_V(8); PG8_WAIT_L(0); PG8_BAR; PG8_MMA(0, 0, At, B0); PG8_MMA(0, 1, At, B1); PG8_BAR; PG8_SCHED;
            PG8_LDA(At, 0, 1); PG8_STAGE(PG8_SB(0, 0), b2, voffB); PG8_STAGE(PG8_SB(0, 1), b2 + hstep, voffB); PG8_STAGE(PG8_SA(0, 0), a2, voffA);
            PG8_WAIT_V(8); PG8_WAIT_L(0); PG8_BAR; PG8_MMA(1, 0, At, B0); PG8_MMA(1, 1, At, B1); PG8_BAR; PG8_SCHED;
            PG8_LDB(B0, 1, 0); PG8_LDB(B1, 1, 1); PG8_SCHED; PG8_LDA(At, 1, 0); PG8_STAGE(PG8_SA(0, 1), a2 + hstep, voffA);
            PG8_WAIT_V(8); PG8_WAIT_L(0); PG8_BAR; PG8_MMA(0, 0, At, B0); PG8_MMA(0, 1, At, B1); PG8_BAR; PG8_SCHED;
            PG8_LDA(At, 1, 1); PG8_STAGE(PG8_SB(1, 0), b3, voffB); PG8_STAGE(PG8_SB(1, 1), b3 + hstep, voffB); PG8_STAGE(PG8_SA(1, 0), a3, voffA);
            PG8_WAIT_V(8); PG8_WAIT_L(0); PG8_BAR; PG8_MMA(1, 0, At, B0); PG8_MMA(1, 1, At, B1); PG8_BAR; PG8_SCHED;
            } else {
            PG8_LDB(B0, 0, 0); PG8_SCHED; PG8_LDA(At, 0, 0); PG8_STAGE(PG8_SA(1, 1), a1 + hstep, voffA);
            PG8_WAIT_L(8); PG8_BAR; PG8_WAIT_L(0); PG8_MMA(0, 0, At, B0); PG8_BAR; PG8_SCHED;
            PG8_LDB(B1, 0, 1); PG8_STAGE(PG8_SB(0, 0), b2, voffB);
            PG8_BAR; PG8_WAIT_L(0); PG8_MMA(0, 1, At, B1); PG8_BAR;
            PG8_LDA(At, 0, 1); PG8_STAGE(PG8_SA(0, 0), a2, voffA);
            PG8_BAR; PG8_WAIT_L(0); PG8_MMA(1, 0, At, B0); PG8_BAR; PG8_SCHED;
            PG8_STAGE(PG8_SB(0, 1), b2 + hstep, voffB);
            PG8_WAIT_V(6); PG8_BAR; PG8_MMA(1, 1, At, B1); PG8_BAR;
            PG8_LDB(B0, 1, 0); PG8_SCHED; PG8_LDA(At, 1, 0); PG8_STAGE(PG8_SA(0, 1), a2 + hstep, voffA);
            PG8_WAIT_L(8); PG8_BAR; PG8_WAIT_L(0); PG8_MMA(0, 0, At, B0); PG8_BAR; PG8_SCHED;
            PG8_LDB(B1, 1, 1); PG8_STAGE(PG8_SB(1, 0), b3, voffB);
            PG8_BAR; PG8_WAIT_L(0); PG8_MMA(0, 1, At, B1); PG8_BAR;
            PG8_LDA(At, 1, 1); PG8_STAGE(PG8_SA(1, 0), a3, voffA);
            PG8_BAR; PG8_WAIT_L(0); PG8_MMA(1, 0, At, B0); PG8_BAR; PG8_SCHED;
            PG8_STAGE(PG8_SB(1, 1), b3 + hstep, voffB);
            PG8_WAIT_V(6); PG8_BAR; PG8_MMA(1, 1, At, B1); PG8_BAR;
            }
        }
        if constexpr (ALIGN_EPI) { if (wr == 0) PG8_BAR; }
        if constexpr (!Epi::AFTER_DRAIN) { E(acc, cur, wr, wc, fr, fq); S.done(cur); }
        if (!has_next) break;
#pragma unroll
        for (int a = 0; a < 2; ++a)
#pragma unroll
            for (int b = 0; b < 2; ++b)
#pragma unroll
                for (int m = 0; m < 4; ++m)
#pragma unroll
                    for (int n = 0; n < 2; ++n) acc[a][b][m][n] = (f32x4){0.f, 0.f, 0.f, 0.f};
        cur = nxt; cA = nA; cB = nB; ++ui;
        if constexpr (ALIGN_EPI) { if (wr == 1) PG8_BAR; }
    }
    PG8_WAIT_V(0);
    if constexpr (!ALIGN_EPI) { if (wr == 0) PG8_BAR; }
    PG8_BAR;
    if constexpr (Epi::AFTER_DRAIN) { E.fused(acc, cur, wr, wc, fr, fq, lds, wid, lane); S.done(cur); }
#undef PG8_SA
#undef PG8_SB
#undef PG8_STAGE
#undef PG8_LDA
#undef PG8_LDB
#undef PG8_MMA
#undef PG8_WAIT_V
#undef PG8_WAIT_L
#undef PG8_BAR
#undef PG8_SCHED
}
}

#ifndef MK_N_LAUNCHES
#define MK_N_LAUNCHES 1
#endif
constexpr int N_PHASES = 11;
constexpr int NWAVES = 8;

constexpr int DM = 1024, NB = 8, SEQ = 2048, NMETA = 16, TP = SEQ + NMETA  , DB = 128, DS = 4, PAST = 8192, PAGE = 128, NPAGES = 64;
constexpr int NH = 8, QKN = 64, QKR = 32, VH = 64, QKH = 96, QL = 384, KVL = 256, AW = 512, CC = 512, DFF = 4096;
constexpr int INW = 2208, INWP = 2304;
constexpr int MP = NB * SEQ;
constexpr int MS = DB * DS;
constexpr int MR = MP + MS;
constexpr int MMETA0 = MR;
constexpr int MALL = MR + NMETA;
constexpr int MPAD = 17152;
constexpr int TPP = 2112;
constexpr float EPS = 1e-6f;
constexpr float QSCALE = 0.10206207261596577f * 1.4426950408889634f;
constexpr int SA_NS = 2;

constexpr size_t O_YP = 0, O_YS = O_YP + (size_t)MP * DM, O_LATP = O_YS + (size_t)MS * DM, O_KPEP = O_LATP + (size_t)NB * TP * KVL, O_CONVP = O_KPEP + (size_t)NB * TP * QKR,
                 O_LATS = O_CONVP + (size_t)NB * 2 * CC, O_KPES = O_LATS + (size_t)MS * KVL, O_CONVS = O_KPES + (size_t)MS * QKR, O_END = O_CONVS + (size_t)DB * 2 * CC;

constexpr size_t MiB = 1u << 20;
constexpr size_t WS_CTL = 0, CTL_ZERO_BYTES = 1 * MiB;
constexpr size_t WS_ROWSS = 512 * 1024;
constexpr size_t WS_WIN = 2 * MiB;
constexpr size_t WS_WUQ = 7 * MiB;
constexpr size_t WS_WUKV = 8 * MiB;
constexpr size_t WS_WUKVB = 9 * MiB;
constexpr size_t WS_WF8 = 9 * MiB + 512 * 1024;
constexpr size_t WS_WO = 10 * MiB;
constexpr size_t WS_WUP = 12 * MiB;
constexpr size_t WS_WDN = 20 * MiB;
constexpr size_t WS_ROPE = 28 * MiB;
constexpr size_t WS_XN = 32 * MiB;
constexpr size_t WS_Z = 68 * MiB;
constexpr size_t WS_CQN = 146 * MiB;
constexpr size_t WS_LATB = 160 * MiB;
constexpr size_t WS_KPER = 170 * MiB;
constexpr size_t WS_QRAW = 174 * MiB;
constexpr size_t WS_KVRAW = 200 * MiB;
constexpr size_t WS_Q = 236 * MiB;
constexpr size_t WS_SSQ = 236 * MiB;
constexpr size_t WS_KSS = 238 * MiB;
constexpr size_t WS_RSA = 237 * MiB;
constexpr size_t WS_K = 262 * MiB;
constexpr size_t WS_V = 288 * MiB;
constexpr size_t WS_MIX = 306 * MiB;
constexpr size_t WS_PART = 342 * MiB;
constexpr size_t WS_LPART = 360 * MiB;
constexpr size_t WS_NEWLAT = 352 * MiB;
constexpr size_t WS_NEWKPE = 357 * MiB;
constexpr size_t WS_H = WS_Z;
constexpr size_t WS_END = 500 * MiB;
constexpr int CW_BAR = 4096;

constexpr int RING_OFF = 0, RING_BYTES = 131072;
constexpr int LDS_BYTES = 163840;
constexpr int LDSCTL_OFF = LDS_BYTES - 512, MISC_OFF = LDSCTL_OFF + 320;

#define GAS __attribute__((address_space(1)))
#define LAS __attribute__((address_space(3)))
typedef unsigned short bf16;
typedef unsigned v4u __attribute__((ext_vector_type(4)));
typedef unsigned v2u __attribute__((ext_vector_type(2)));
typedef float f32x4 __attribute__((ext_vector_type(4)));
typedef float f32x16 __attribute__((ext_vector_type(16)));
typedef short bf16x8 __attribute__((ext_vector_type(8)));
typedef short s16x4 __attribute__((ext_vector_type(4)));
typedef GAS unsigned gu32;
#define RLX_AGENT __ATOMIC_RELAXED, __HIP_MEMORY_SCOPE_AGENT
#define LDS_WAIT() asm volatile("s_waitcnt lgkmcnt(0)" ::: "memory")
#define VM_WAIT() asm volatile("s_waitcnt vmcnt(0)" ::: "memory")
typedef float f32x2_t __attribute__((ext_vector_type(2))); typedef __bf16 bf16x2_t __attribute__((ext_vector_type(2)));
#define NTS(v, p) __builtin_nontemporal_store((v), (p))
#define NTL(p) __builtin_nontemporal_load(p)
__device__ __forceinline__ unsigned pk2(float lo, float hi) { f32x2_t v = {lo, hi}; bf16x2_t b = __builtin_convertvector(v, bf16x2_t); return __builtin_bit_cast(unsigned, b); }
__device__ __forceinline__ float bflo(unsigned w) { return __uint_as_float(w << 16); }
__device__ __forceinline__ float bfhi(unsigned w) { return __uint_as_float(w & 0xffff0000u); }
__device__ __forceinline__ void unpack8(const v4u x, float (&e)[8]) { e[0] = bflo(x.x); e[1] = bfhi(x.x); e[2] = bflo(x.y); e[3] = bfhi(x.y); e[4] = bflo(x.z); e[5] = bfhi(x.z); e[6] = bflo(x.w); e[7] = bfhi(x.w); }
__device__ __forceinline__ v4u pack8(const float (&e)[8]) { v4u o; o.x = pk2(e[0], e[1]); o.y = pk2(e[2], e[3]); o.z = pk2(e[4], e[5]); o.w = pk2(e[6], e[7]); return o; }
__device__ __forceinline__ float bf1(bf16 b) { return __uint_as_float((unsigned)b << 16); }
#define XB_TMO      128
#define XB_XCNT(j)  (256  + 64 * (j))
#define XB_XSUB(j)  (1280 + 64 * (j))
#define XB_XGEN(j)  (2304 + 64 * (j))
#define XB_TOP      3328
#define XB_TOPGEN   3392
#define XCD_BAR_WORDS 3456
#define XB_SPIN_CAP (1u << 18)

__device__ __forceinline__ unsigned xb_ld(unsigned* p)              { return __hip_atomic_load(p, __ATOMIC_RELAXED, __HIP_MEMORY_SCOPE_AGENT); }
__device__ __forceinline__ unsigned xb_add(unsigned* p, unsigned v) { return __hip_atomic_fetch_add(p, v, __ATOMIC_RELAXED, __HIP_MEMORY_SCOPE_AGENT); }
__device__ __forceinline__ unsigned xb_xcc_id() { return (unsigned)__builtin_amdgcn_s_getreg((3 << 11) | 20) & 0xFu; }
#define XB_SPIN(cond, bar) do { unsigned _sp = 0; while (cond) { __builtin_amdgcn_s_sleep(1); \
    if ((++_sp & 255u) == 0u) { if (xb_ld(&(bar)[XB_TMO])) break; if (_sp > XB_SPIN_CAP) { atomicAdd(&(bar)[XB_TMO], 1u); break; } } } } while (0)

struct XcdBarrier {
    unsigned* bar; unsigned x;
    volatile LAS unsigned* st;
};

__device__ __forceinline__ XcdBarrier xcd_barrier_post(unsigned* bar, volatile LAS unsigned* st) {
    XcdBarrier b; b.bar = bar; b.x = xb_xcc_id(); b.st = st;
    if (threadIdx.x == 0) (void)xb_add(&bar[XB_XCNT(b.x)], 1u);
    return b;
}
__device__ __forceinline__ void xcd_barrier_complete(unsigned* bar, unsigned x, unsigned& nloc, unsigned& nx) {
    const unsigned G = gridDim.x * gridDim.y * gridDim.z;
    unsigned sum, cnt, mine, sp = 0u;
    for (;;) {
        sum = 0u; cnt = 0u; mine = 0u;
#pragma unroll
        for (unsigned j = 0; j < 16; ++j) { const unsigned c = xb_ld(&bar[XB_XCNT(j)]); sum += c; cnt += (c > 0u) ? 1u : 0u; mine = (j == x) ? c : mine; }
        if (sum == G) break;
        __builtin_amdgcn_s_sleep(1);
        if ((++sp & 255u) == 0u) { if (xb_ld(&bar[XB_TMO])) break; if (sp > XB_SPIN_CAP) { atomicAdd(&bar[XB_TMO], 1u); break; } }
    }
    nloc = mine > 0u ? mine : 1u; nx = cnt > 0u ? cnt : 1u;
}

__device__ __forceinline__ void xcd_barrier(const XcdBarrier& b) {
    asm volatile("s_waitcnt vmcnt(0)" ::: "memory");
    __syncthreads();
    if (threadIdx.x == 0) {
        unsigned* bar = b.bar;
        __builtin_amdgcn_s_waitcnt(0);
        unsigned nloc = b.st[0], nx = b.st[1];
        if (nloc == 0u) { xcd_barrier_complete(bar, b.x, nloc, nx); b.st[0] = nloc; b.st[1] = nx; }
        const unsigned old = xb_add(&bar[XB_XSUB(b.x)], 1u);
        const unsigned gen = old / nloc;
        if (old + 1u == (gen + 1u) * nloc) {
            __builtin_amdgcn_fence(__ATOMIC_RELEASE, "agent");
            asm volatile("s_waitcnt vmcnt(0)" ::: "memory");
            const unsigned og = xb_add(&bar[XB_TOP], 1u);
            const unsigned tg = og / nx;
            if (og + 1u == (tg + 1u) * nx) xb_add(&bar[XB_TOPGEN], 1u);
            else XB_SPIN(xb_ld(&bar[XB_TOPGEN]) == tg, bar);
            __builtin_amdgcn_fence(__ATOMIC_ACQUIRE, "agent");
            xb_add(&bar[XB_XGEN(b.x)], 1u);
            asm volatile("s_waitcnt vmcnt(0)" ::: "memory");
        } else {
            XB_SPIN(xb_ld(&bar[XB_XGEN(b.x)]) == gen, bar);
            __builtin_amdgcn_fence(__ATOMIC_ACQUIRE, "agent");
            asm volatile("s_waitcnt vmcnt(0)" ::: "memory");
        }
    }
    __syncthreads();
}

struct Params {
    const float* x_prompt; const float* x_sample; const float* cache_lat; const float* cache_kpe; const float* state_conv; const int* page_table; const float* meta;
    const float* norm_mix_g; const float* w_in; const float* q_lora_g; const float* kv_lora_g; const float* w_uq; const float* w_ukv; const float* q_norm_g; const float* k_norm_g;
    const float* conv_w; const float* conv_b; const float* attn_out_g; const float* conv_out_g; const float* w_o; const float* norm_ffn_g; const float* w_up; const float* w_down;
    float* out; unsigned char* ws; int ph_lo, ph_hi, li, pad;
};
struct Frame {
    LAS unsigned char* lds;
    volatile LAS unsigned* MISC;
    gu32* ctl;
    int tid, lane, wave, G, gw, NGW;
};
__device__ __forceinline__ float wave_sum(float v) {
#pragma unroll
    for (int o = 1; o < 64; o <<= 1) v += __shfl_xor(v, o);
    return v;
}

__device__ __forceinline__ void p0_transpose_item(const float* W, int K, int N, bf16* WT, LAS float* scr, int item, int lane, const float* kscale = nullptr, int klim = 1 << 30) {
    const int nblk = N / 32, kb = item / nblk, nb = item % nblk, k0 = 64 * kb, n0 = 32 * nb;
#pragma unroll 16
    for (int i = 0; i < 32; ++i) { const int kk = 2 * i + (lane >> 5); scr[kk * 33 + (lane & 31)] = NTL(&W[(size_t)(k0 + kk) * N + n0 + (lane & 31)]) * ((kscale && k0 < klim) ? kscale[k0 + kk] : 1.0f); }
    LDS_WAIT(); asm volatile("" ::: "memory");
    const int c = lane & 7;
#pragma unroll
    for (int j = 0; j < 4; ++j) { const int n = (lane >> 3) + 8 * j; const LAS float* s = scr + (8 * c) * 33 + n;
        v4u o; o.x = pk2(s[0 * 33], s[1 * 33]); o.y = pk2(s[2 * 33], s[3 * 33]); o.z = pk2(s[4 * 33], s[5 * 33]); o.w = pk2(s[6 * 33], s[7 * 33]);
        *(GAS v4u*)(WT + (size_t)(n0 + n) * K + k0 + 8 * c) = o; }
    LDS_WAIT(); asm volatile("" ::: "memory");
}
__device__ __forceinline__ void rms_row_to_bf16(const float* xrow, const float* g, bf16* orow, int lane) {
    const GAS f32x4* xr = (const GAS f32x4*)xrow + lane; const GAS f32x4* gr = (const GAS f32x4*)g + lane;
    f32x4 v[4]; float s = 0.f;
#pragma unroll
    for (int j = 0; j < 4; ++j) { v[j] = NTL(xr + 64 * j); s += (v[j].x * v[j].x + v[j].y * v[j].y) + (v[j].z * v[j].z + v[j].w * v[j].w); }
    const float rs = 1.0f / sqrtf(wave_sum(s) * (1.f / DM) + EPS);
    GAS v2u* o8 = (GAS v2u*)orow + lane;
#pragma unroll
    for (int j = 0; j < 4; ++j) { const f32x4 gg = gr[64 * j]; v2u w; w.x = pk2(v[j].x * rs * gg.x, v[j].y * rs * gg.y); w.y = pk2(v[j].z * rs * gg.z, v[j].w * rs * gg.w); o8[64 * j] = w; }
}
__device__ __forceinline__ void p0_prologue(const Params& P, Frame& F) {
    unsigned char* ws = P.ws;
    LAS float* scr = (LAS float*)(F.lds + RING_OFF + F.wave * 16384);
    constexpr int I_IN = (DM / 64) * (INW / 32);
    for (int it = F.gw; it < I_IN; it += F.NGW) p0_transpose_item(P.w_in, DM, INW, (bf16*)(ws + WS_WIN), scr, it, F.lane);
    const int gt = F.gw * 64 + F.lane, NGT = F.NGW * 64;
    for (int i = gt; i < 96 * 128; i += NGT) ((GAS v4u*)(ws + WS_WIN + (size_t)INW * DM * 2))[i] = (v4u){0u, 0u, 0u, 0u};
    for (int i = gt; i < (MPAD - MALL) * DM / 8; i += NGT) ((GAS v4u*)(ws + WS_XN + (size_t)MALL * DM * 2))[i] = (v4u){0u, 0u, 0u, 0u};
    bf16* XN = (bf16*)(ws + WS_XN);
    {
        const int lane = F.lane;
        f32x4 gg[4];
#pragma unroll
        for (int j = 0; j < 4; ++j) gg[j] = ((const GAS f32x4*)P.norm_mix_g)[lane + 64 * j];
#define P0_SRC(m) (((m) < MP) ? P.x_prompt + (size_t)(m) * DM : ((m) < MR) ? P.x_sample + (size_t)((m) - MP) * DM : P.meta + (size_t)((m) - MR) * DM)
        int m = F.gw;
        f32x4 vn[4];
        if (m < MALL) { const GAS f32x4* xr = (const GAS f32x4*)P0_SRC(m) + lane;
#pragma unroll
            for (int j = 0; j < 4; ++j) vn[j] = NTL(xr + 64 * j); }
        while (m < MALL) {
            f32x4 v[4];
#pragma unroll
            for (int j = 0; j < 4; ++j) v[j] = vn[j];
            const int m2 = m + F.NGW;
            if (m2 < MALL) { const GAS f32x4* xr = (const GAS f32x4*)P0_SRC(m2) + lane;
#pragma unroll
                for (int j = 0; j < 4; ++j) vn[j] = NTL(xr + 64 * j); }
            float ss = 0.f;
#pragma unroll
            for (int j = 0; j < 4; ++j) ss += (v[j].x * v[j].x + v[j].y * v[j].y) + (v[j].z * v[j].z + v[j].w * v[j].w);
            const float rs = 1.0f / sqrtf(wave_sum(ss) * (1.f / DM) + EPS);
            GAS v2u* o8 = (GAS v2u*)(XN + (size_t)m * DM) + lane;
#pragma unroll
            for (int j = 0; j < 4; ++j) { v2u w; w.x = pk2(v[j].x * rs * gg[j].x, v[j].y * rs * gg[j].y); w.y = pk2(v[j].z * rs * gg[j].z, v[j].w * rs * gg[j].w); o8[64 * j] = w; }
            m = m2;
        }
#undef P0_SRC
    }
}
__device__ __forceinline__ void p0_late(const Params& P, Frame& F, int wv, int nwv) {
    unsigned char* ws = P.ws;
    LAS float* scr = (LAS float*)(F.lds + RING_OFF + F.wave * 16384);
    constexpr int I_UQ = (QL / 64) * (768 / 32), I_UKV = (KVL / 64) * (1024 / 32), I_O = (DM / 64) * (DM / 32), I_UP = (DM / 64) * (DFF / 32), I_DN = (DFF / 64) * (DM / 32);
    constexpr int NITEMS = I_UQ + I_UKV + I_O + I_UP + I_DN;
    for (int it = wv; it < NITEMS; it += nwv) {
        int r = it;
        if (r < I_UQ) { p0_transpose_item(P.w_uq, QL, 768, (bf16*)(ws + WS_WUQ), scr, r, F.lane); continue; } r -= I_UQ;
        if (r < I_UKV) { p0_transpose_item(P.w_ukv, KVL, 1024, (bf16*)(ws + WS_WUKV), scr, r, F.lane); continue; } r -= I_UKV;
        if (r < I_O) { p0_transpose_item(P.w_o, DM, DM, (bf16*)(ws + WS_WO), scr, r, F.lane, P.attn_out_g, AW); continue; } r -= I_O;
        if (r < I_UP) { p0_transpose_item(P.w_up, DM, DFF, (bf16*)(ws + WS_WUP), scr, r, F.lane, P.norm_ffn_g); continue; } r -= I_UP;
        p0_transpose_item(P.w_down, DFF, DM, (bf16*)(ws + WS_WDN), scr, r, F.lane);
    }
    const int gt = wv * 64 + F.lane, NGT = nwv * 64;
    for (int i = gt; i < KVL * 1024 / 8; i += NGT) { const f32x4 a = ((const GAS f32x4*)P.w_ukv)[2 * i], b = ((const GAS f32x4*)P.w_ukv)[2 * i + 1];
        v4u o; o.x = pk2(a.x, a.y); o.y = pk2(a.z, a.w); o.z = pk2(b.x, b.y); o.w = pk2(b.z, b.w); ((GAS v4u*)(ws + WS_WUKVB))[i] = o; }
    for (int i = gt; i < 512 * 64; i += NGT) { const int n = i >> 6, c4 = i & 63, col = (n >> 6) * 128 + (n & 63); const float* wp = P.w_ukv + (size_t)(4 * c4) * 1024 + col;
        int w = 0; w = __builtin_amdgcn_cvt_pk_fp8_f32(16.f * wp[0], 16.f * wp[1024], w, false); w = __builtin_amdgcn_cvt_pk_fp8_f32(16.f * wp[2048], 16.f * wp[3072], w, true);
        ((int*)(ws + WS_WF8))[i] = w; }
    for (int i = gt; i < 2068 * 16; i += NGT) { const int p = i >> 4, f = i & 15; const double pos = (p < TP) ? (double)p : (double)(PAST + (p - TP));
        const double f4 = (f & 3) == 0 ? 1.0 : (f & 3) == 1 ? 5.62341325190349072827e-01 : (f & 3) == 2 ? 3.16227766016837941176e-01 : 1.77827941003892292526e-01;
        const double dec = (f >> 2) == 0 ? 1.0 : (f >> 2) == 1 ? 1e-1 : (f >> 2) == 2 ? 1e-2 : 1e-3;
        const double ang = pos * (f4 * dec); const double kq = rint(ang * 0.15915494309189533577); const double rr = fma(-kq, 6.283185307179586232, ang) - kq * 2.4492935982947064e-16;
        const float rf = (float)rr;
        ((float*)(ws + WS_ROPE))[i] = cosf(rf); ((float*)(ws + WS_ROPE))[2068 * 16 + i] = sinf(rf); }
    for (int i = gt; i < NB * (TPP - TP) * 768 / 8; i += NGT) { const int b = i / ((TPP - TP) * 96), r = i % ((TPP - TP) * 96); ((GAS v4u*)(ws + WS_K + ((size_t)(b * TPP + TP) * 768) * 2))[r] = (v4u){0u, 0u, 0u, 0u}; }
    for (int i = gt; i < DB * 32 * KVL / 4; i += NGT) ((GAS f32x4*)(ws + WS_NEWLAT))[i] = (f32x4){0.f, 0.f, 0.f, 0.f};
    for (int i = gt; i < DB * 32 * QKR / 4; i += NGT) ((GAS f32x4*)(ws + WS_NEWKPE))[i] = (f32x4){0.f, 0.f, 0.f, 0.f};
}

__device__ __forceinline__ void conv_u(const bf16* zrow, int lane, float (&u)[8]) {
    float a[8], b[8]; unpack8(*(const GAS v4u*)(zrow + 1184 + 8 * lane), a); unpack8(*(const GAS v4u*)(zrow + 1696 + 8 * lane), b);
#pragma unroll
    for (int i = 0; i < 8; ++i) u[i] = a[i] * b[i];
}
__device__ __forceinline__ void p2a_row(const Params& P, Frame& F, int r) {
    unsigned char* ws = P.ws; const int lane = F.lane;
    const bf16* Z = (const bf16*)(ws + WS_Z); const bf16* z = Z + (size_t)r * INWP;
    int kind, b, t, pidx;
    if (r < MP) { kind = 0; b = r >> 11; t = r & 2047; pidx = t + NMETA; }
    else if (r < MR) { kind = 1; b = (r - MP) >> 2; t = (r - MP) & 3; pidx = TP + t; }
    else { kind = 2; b = 0; t = r - MR; pidx = t; }
    const int l48p = lane < 48 ? lane : 0, l32p = lane & 31;
    const v4u zq_ = *(const GAS v4u*)(z + 8 * l48p), zk_ = *(const GAS v4u*)(z + 384 + 8 * l32p);
    const bf16 zp_ = z[640 + l32p];
    const float* rope_ = (const float*)(ws + WS_ROPE); const float rc_ = rope_[pidx * 16 + (l32p & 15)], rsn_ = rope_[2068 * 16 + pidx * 16 + (l32p & 15)];
    const f32x4 qg0_ = *(const GAS f32x4*)(P.q_lora_g + 8 * l48p), qg1_ = *(const GAS f32x4*)(P.q_lora_g + 8 * l48p + 4);
    const f32x4 kg0_ = *(const GAS f32x4*)(P.kv_lora_g + 8 * l32p), kg1_ = *(const GAS f32x4*)(P.kv_lora_g + 8 * l32p + 4);
    v4u zb_ = {0u, 0u, 0u, 0u}, zg0_ = zb_, zh0_ = zb_, zg1_ = zb_, zh1_ = zb_, zg2_ = zb_, zh2_ = zb_;
    f32x4 cb_[2], cw_[3][2], og_[2];
#pragma unroll
    for (int q = 0; q < 2; ++q) { cb_[q] = (f32x4){0.f, 0.f, 0.f, 0.f}; og_[q] = cb_[q]; cw_[0][q] = cb_[q]; cw_[1][q] = cb_[q]; cw_[2][q] = cb_[q]; }
    if (kind != 2) {
        zb_ = *(const GAS v4u*)(z + 672 + 8 * lane); zg0_ = *(const GAS v4u*)(z + 1184 + 8 * lane); zh0_ = *(const GAS v4u*)(z + 1696 + 8 * lane);
#pragma unroll
        for (int q = 0; q < 2; ++q) { cb_[q] = *(const GAS f32x4*)(P.conv_b + 8 * lane + 4 * q); og_[q] = *(const GAS f32x4*)(P.conv_out_g + 8 * lane + 4 * q);
            cw_[0][q] = *(const GAS f32x4*)(P.conv_w + 8 * lane + 4 * q); cw_[1][q] = *(const GAS f32x4*)(P.conv_w + CC + 8 * lane + 4 * q); cw_[2][q] = *(const GAS f32x4*)(P.conv_w + 2 * CC + 8 * lane + 4 * q); }
        if (kind == 0) {
            const bf16* z1 = (t >= 1) ? z - INWP : Z + (size_t)(MMETA0 + 15) * INWP;
            const bf16* z2 = (t >= 2) ? z - 2 * INWP : Z + (size_t)(MMETA0 + 14 + t) * INWP;
            zg1_ = *(const GAS v4u*)(z1 + 1184 + 8 * lane); zh1_ = *(const GAS v4u*)(z1 + 1696 + 8 * lane); zg2_ = *(const GAS v4u*)(z2 + 1184 + 8 * lane); zh2_ = *(const GAS v4u*)(z2 + 1696 + 8 * lane);
        }
    }
    if (kind != 2) {
        float v[8]; unpack8(zq_, v);
        float ss = 0.f;
#pragma unroll
        for (int i = 0; i < 8; ++i) ss += v[i] * v[i];
        if (lane >= 48) ss = 0.f;
        const float rs = 1.0f / sqrtf(wave_sum(ss) * (1.f / QL) + EPS);
        if (lane < 48) { const f32x4 g0 = qg0_, g1 = qg1_;
            float o[8] = {v[0] * rs * g0.x, v[1] * rs * g0.y, v[2] * rs * g0.z, v[3] * rs * g0.w, v[4] * rs * g1.x, v[5] * rs * g1.y, v[6] * rs * g1.z, v[7] * rs * g1.w};
            *(GAS v4u*)((bf16*)(ws + WS_CQN) + (size_t)r * QL + 8 * lane) = pack8(o); }
    }
    {
        float v[8]; unpack8(zk_, v);
        float ss = 0.f;
#pragma unroll
        for (int i = 0; i < 8; ++i) ss += v[i] * v[i];
        if (lane >= 32) ss = 0.f;
        const float rs = 1.0f / sqrtf(wave_sum(ss) * (1.f / KVL) + EPS);
        if (lane < 32) { const f32x4 g0 = kg0_, g1 = kg1_;
            float o[8] = {v[0] * rs * g0.x, v[1] * rs * g0.y, v[2] * rs * g0.z, v[3] * rs * g0.w, v[4] * rs * g1.x, v[5] * rs * g1.y, v[6] * rs * g1.z, v[7] * rs * g1.w};
            *(GAS v4u*)((bf16*)(ws + WS_LATB) + (size_t)r * KVL + 8 * lane) = pack8(o);
            const f32x4 o0 = {o[0], o[1], o[2], o[3]}, o1 = {o[4], o[5], o[6], o[7]};
            if (kind == 0) { float* d = P.out + O_LATP + ((size_t)(b * TP + NMETA + t)) * KVL + 8 * lane; NTS(o0, (GAS f32x4*)d); NTS(o1, (GAS f32x4*)(d + 4)); }
            else if (kind == 1) { float* d = P.out + O_LATS + ((size_t)(b * DS + t)) * KVL + 8 * lane; NTS(o0, (GAS f32x4*)d); NTS(o1, (GAS f32x4*)(d + 4));
                float* d2 = (float*)(ws + WS_NEWLAT) + ((size_t)(b * 32 + t)) * KVL + 8 * lane; *(GAS f32x4*)d2 = o0; *(GAS f32x4*)(d2 + 4) = o1; }
            else { for (int bb = 0; bb < NB; ++bb) { float* d = P.out + O_LATP + ((size_t)(bb * TP + t)) * KVL + 8 * lane; NTS(o0, (GAS f32x4*)d); NTS(o1, (GAS f32x4*)(d + 4)); } }
        }
    }
    {
        const int l32 = lane & 31; const float x = bf1(zp_); const float xp = __shfl_xor(x, 16);
        const float c = rc_, s = rsn_;
        const float o = (l32 < 16) ? (x * c - xp * s) : (x * c + xp * s);
        { const float q2 = wave_sum(lane < 32 ? o * o : 0.f); if (lane == 0) ((float*)(ws + WS_KSS))[r] = q2; }
        if (lane < 32) {
            ((float*)(ws + WS_KPER))[(size_t)r * QKR + lane] = o;
            if (kind == 0) NTS(o, &P.out[O_KPEP + ((size_t)(b * TP + NMETA + t)) * QKR + lane]);
            else if (kind == 1) { P.out[O_KPES + ((size_t)(b * DS + t)) * QKR + lane] = o; ((float*)(ws + WS_NEWKPE))[((size_t)(b * 32 + t)) * QKR + lane] = o; }
            else { for (int bb = 0; bb < NB; ++bb) P.out[O_KPEP + ((size_t)(bb * TP + t)) * QKR + lane] = o; }
        }
    }
    if (kind != 2) {
        float u0[8], u1[8], u2[8];
        { float a_[8], b_[8]; unpack8(zg0_, a_); unpack8(zh0_, b_);
#pragma unroll
          for (int i = 0; i < 8; ++i) u0[i] = a_[i] * b_[i]; }
        if (kind == 0) { float a_[8], b_[8]; unpack8(zg1_, a_); unpack8(zh1_, b_);
#pragma unroll
            for (int i = 0; i < 8; ++i) u1[i] = a_[i] * b_[i];
            unpack8(zg2_, a_); unpack8(zh2_, b_);
#pragma unroll
            for (int i = 0; i < 8; ++i) u2[i] = a_[i] * b_[i];
        } else {
            const float* st = P.state_conv + (size_t)b * 2 * CC + 8 * lane;
            if (t >= 1) conv_u(z - INWP, lane, u1); else { const f32x4 a = *(const GAS f32x4*)(st + CC), c = *(const GAS f32x4*)(st + CC + 4); u1[0] = a.x; u1[1] = a.y; u1[2] = a.z; u1[3] = a.w; u1[4] = c.x; u1[5] = c.y; u1[6] = c.z; u1[7] = c.w; }
            if (t >= 2) conv_u(z - 2 * INWP, lane, u2); else { const float* s2 = st + (t == 1 ? CC : 0); const f32x4 a = *(const GAS f32x4*)(s2), c = *(const GAS f32x4*)(s2 + 4); u2[0] = a.x; u2[1] = a.y; u2[2] = a.z; u2[3] = a.w; u2[4] = c.x; u2[5] = c.y; u2[6] = c.z; u2[7] = c.w; }
        }
        float gb[8]; unpack8(zb_, gb);
        float co[8]; float ss = 0.f;
#pragma unroll
        for (int i = 0; i < 8; ++i) { const float y = cb_[i >> 2][i & 3] + cw_[0][i >> 2][i & 3] * u2[i] + cw_[1][i >> 2][i & 3] * u1[i] + cw_[2][i >> 2][i & 3] * u0[i]; co[i] = gb[i] * y; ss += co[i] * co[i]; }
        const float rs = 1.0f / sqrtf(wave_sum(ss) * (1.f / CC) + EPS);
#pragma unroll
        for (int i = 0; i < 8; ++i) co[i] = co[i] * rs * og_[i >> 2][i & 3];
        *(GAS v4u*)((bf16*)(ws + WS_MIX) + (size_t)r * DM + AW + 8 * lane) = pack8(co);
        const f32x4 o0 = {u0[0], u0[1], u0[2], u0[3]}, o1 = {u0[4], u0[5], u0[6], u0[7]};
        if (kind == 0 && t >= SEQ - 2) { float* d = P.out + O_CONVP + ((size_t)(b * 2 + (t - (SEQ - 2)))) * CC + 8 * lane; *(GAS f32x4*)d = o0; *(GAS f32x4*)(d + 4) = o1; }
        if (kind == 1 && t >= DS - 2) { float* d = P.out + O_CONVS + ((size_t)(b * 2 + (t - (DS - 2)))) * CC + 8 * lane; *(GAS f32x4*)d = o0; *(GAS f32x4*)(d + 4) = o1; }
    }
}

__device__ __forceinline__ void p2c_k_item8(const Params& P, LAS unsigned char* scr, int r0, int lane_in) {
    unsigned char* ws = P.ws; asm volatile("" : "+s"(ws)); int lane = lane_in; asm volatile("" : "+v"(lane));
    const GAS unsigned char* src = (const GAS unsigned char*)((const bf16*)(ws + WS_KVRAW) + (size_t)r0 * 1024);
    { v4u in[8];
#pragma unroll
      for (int j = 0; j < 8; ++j) { const int q = 64 * j + lane, bl = q >> 3, c = q & 7; in[j] = *(const GAS v4u*)(src + (size_t)bl * 256 + c * 16); }
#pragma unroll
      for (int j = 0; j < 8; ++j) { const int q = 64 * j + lane, bl = q >> 3, c = q & 7; *(LAS v4u*)(scr + bl * 128 + ((c ^ (bl & 7)) << 4)) = in[j]; } }
    const int r = r0 + (lane >> 3);
    f32x4 kr[8]; const float* kp = (const float*)(ws + WS_KPER) + (size_t)r * QKR;
#pragma unroll
    for (int c = 0; c < 8; ++c) kr[c] = *(const GAS f32x4*)(kp + 4 * c);
    LDS_WAIT(); asm volatile("" ::: "memory");
    v4u kw[8]; float ss = 0.f;
#pragma unroll
    for (int c = 0; c < 8; ++c) { kw[c] = *(const LAS v4u*)(scr + lane * 128 + ((c ^ (lane & 7)) << 4)); float e[8]; unpack8(kw[c], e);
#pragma unroll
        for (int i = 0; i < 8; ++i) ss += e[i] * e[i]; }
#pragma unroll
    for (int c = 0; c < 8; ++c) ss += (kr[c].x * kr[c].x + kr[c].y * kr[c].y) + (kr[c].z * kr[c].z + kr[c].w * kr[c].w);
    const float rs = 1.0f / sqrtf(ss * (1.f / QKH) + EPS);
    LAS unsigned char* kb = scr + lane * 192;
#pragma unroll
    for (int c = 0; c < 8; ++c) { float e[8]; unpack8(kw[c], e);
#pragma unroll
        for (int i = 0; i < 8; ++i) e[i] = e[i] * rs * P.k_norm_g[8 * c + i];
        *(LAS v4u*)(kb + 16 * c) = pack8(e); }
#pragma unroll
    for (int c = 0; c < 4; ++c) { float e[8] = {kr[2 * c].x, kr[2 * c].y, kr[2 * c].z, kr[2 * c].w, kr[2 * c + 1].x, kr[2 * c + 1].y, kr[2 * c + 1].z, kr[2 * c + 1].w};
#pragma unroll
        for (int i = 0; i < 8; ++i) e[i] = e[i] * rs * P.k_norm_g[64 + 8 * c + i];
        *(LAS v4u*)(kb + 128 + 16 * c) = pack8(e); }
    LDS_WAIT(); asm volatile("" ::: "memory");
    const bool meta = r0 >= MR; const int b0 = meta ? 0 : (r0 >> 11), b1 = meta ? NB : b0 + 1, tp0 = meta ? (r0 - MR) : (r0 & 2047) + NMETA;
    { v4u ko[12];
#pragma unroll
      for (int j = 0; j < 12; ++j) ko[j] = *(const LAS v4u*)(scr + (64 * j + lane) * 16);
      for (int b = b0; b < b1; ++b) { GAS v4u* kd = (GAS v4u*)((bf16*)(ws + WS_K) + ((size_t)(b * TPP + tp0)) * 768);
#pragma unroll
          for (int j = 0; j < 12; ++j) kd[64 * j + lane] = ko[j]; } }
    LDS_WAIT(); asm volatile("" ::: "memory");
}
__device__ __forceinline__ void p2c_phase(const Params& P, Frame& F) {
    LAS unsigned char* scr = F.lds + RING_OFF + F.wave * 16384;
    constexpr int NKV = (MP + NMETA) / 8;
    for (int it = F.gw; it < NKV; it += F.NGW) { int r0 = it * 8; if (r0 >= MP) r0 = MR + (r0 - MP); p2c_k_item8(P, scr, r0, F.lane); }
}

__device__ __forceinline__ void q_norm_frags(const Params& P, const bf16* qraw_head, int pidx, int hi, bf16x8 (&qf)[6]) {
    const float* rope = (const float*)(P.ws + WS_ROPE);
    float v[6][8];
#pragma unroll
    for (int s = 0; s < 6; ++s) unpack8(*(const GAS v4u*)(qraw_head + 16 * s + 8 * hi), v[s]);
    const f32x4 c0 = *(const GAS f32x4*)(rope + pidx * 16 + 8 * hi), c1 = *(const GAS f32x4*)(rope + pidx * 16 + 8 * hi + 4);
    const f32x4 s0 = *(const GAS f32x4*)(rope + 2068 * 16 + pidx * 16 + 8 * hi), s1 = *(const GAS f32x4*)(rope + 2068 * 16 + pidx * 16 + 8 * hi + 4);
    const float cs[8] = {c0.x, c0.y, c0.z, c0.w, c1.x, c1.y, c1.z, c1.w}, sn[8] = {s0.x, s0.y, s0.z, s0.w, s1.x, s1.y, s1.z, s1.w};
#pragma unroll
    for (int j = 0; j < 8; ++j) { const float x1 = v[4][j], x2 = v[5][j]; v[4][j] = x1 * cs[j] - x2 * sn[j]; v[5][j] = x2 * cs[j] + x1 * sn[j]; }
    float ss = 0.f;
#pragma unroll
    for (int s = 0; s < 6; ++s)
#pragma unroll
        for (int j = 0; j < 8; ++j) ss += v[s][j] * v[s][j];
    { auto rr = __builtin_amdgcn_permlane32_swap(__float_as_uint(ss), __float_as_uint(ss), false, false); ss = __uint_as_float(rr[0]) + __uint_as_float(rr[1]); }
    const float rs = QSCALE / sqrtf(ss * (1.f / QKH) + EPS);
#pragma unroll
    for (int s = 0; s < 6; ++s) { const f32x4 g0 = *(const GAS f32x4*)(P.q_norm_g + 16 * s + 8 * hi), g1 = *(const GAS f32x4*)(P.q_norm_g + 16 * s + 8 * hi + 4);
        float e[8] = {v[s][0] * rs * g0.x, v[s][1] * rs * g0.y, v[s][2] * rs * g0.z, v[s][3] * rs * g0.w, v[s][4] * rs * g1.x, v[s][5] * rs * g1.y, v[s][6] * rs * g1.z, v[s][7] * rs * g1.w};
        qf[s] = __builtin_bit_cast(bf16x8, pack8(e)); }
}
constexpr int PA_KS = 0, PA_KROW = 208, PA_VS = 64 * PA_KROW  , PA_VROW = 192, PA_BYTES = PA_VS + 64 * PA_VROW;
#define MFMA32(a, b, c) __builtin_amdgcn_mfma_f32_32x32x16_bf16((a), (b), (c), 0, 0, 0)
#define MFMA16(a, b, c) __builtin_amdgcn_mfma_f32_16x16x32_bf16((a), (b), (c), 0, 0, 0)
typedef short v4i16_t __attribute__((ext_vector_type(4)));
__device__ __forceinline__ s16x4 tr_read(const LAS unsigned char* p) { return __builtin_bit_cast(s16x4, __builtin_amdgcn_ds_read_tr16_b64_v4i16((LAS v4i16_t*)p)); }
__device__ __forceinline__ int crow(int r, int hi) { return (r & 3) + 8 * (r >> 2) + 4 * hi; }

__device__ __forceinline__ void pattn_unit(const Params& P, Frame& F, int b, int h, int qb) {
    unsigned char* ws = P.ws; LAS unsigned char* lds = F.lds;
    int tid_ = F.tid; asm volatile("" : "+v"(tid_));
    const int tid = tid_, lane = tid & 63, wave = F.wave, r32 = lane & 31, hi = lane >> 5;
    const int q0 = qb * 256 + wave * 32;
    const int qpos = NMETA + q0 + r32, wfirst = NMETA + q0, wlast = NMETA + q0 + 31;
    bf16x8 qf[6];
    q_norm_frags(P, (const bf16*)(ws + WS_QRAW) + (size_t)(b * SEQ + q0 + r32) * 768 + h * QKH, qpos, hi, qf);
    const int NT = 4 * qb + 5;
    f32x16 o0, o1;
#pragma unroll
    for (int r = 0; r < 16; ++r) { o0[r] = 0.f; o1[r] = 0.f; }
    float l = 0.f;
    const bf16* Kb = (const bf16*)(ws + WS_K) + (size_t)(b * TPP) * 768 + h * QKH;
    const bf16* Vraw = (const bf16*)(ws + WS_KVRAW) + h * 128 + 64;
#define PA_VROWP(tp_) (Vraw + (size_t)(((tp_) < NMETA) ? MR + (tp_) : b * SEQ + (tp_) - NMETA) * 1024)
    const int k0r = tid / 12, k0c = tid % 12, k1r = (tid + 512) / 12, k1c = (tid + 512) % 12, v0r = tid >> 3, v0c = tid & 7;
    v4u kr0, kr1 = (v4u){0u, 0u, 0u, 0u}, vr;
    {
        kr0 = *(const GAS v4u*)(Kb + (size_t)k0r * 768 + 8 * k0c); if (tid < 256) kr1 = *(const GAS v4u*)(Kb + (size_t)k1r * 768 + 8 * k1c); vr = *(const GAS v4u*)(PA_VROWP(v0r) + 8 * v0c);
    }
    const int blk = (lane >> 4) & 1, tq = (lane & 15) >> 2, tp = lane & 3;
    for (int j = 0; j < NT; ++j) {
        __syncthreads();
        *(LAS v4u*)(lds + PA_KS + k0r * PA_KROW + 16 * k0c) = kr0; if (tid < 256) *(LAS v4u*)(lds + PA_KS + k1r * PA_KROW + 16 * k1c) = kr1; *(LAS v4u*)(lds + PA_VS + v0r * PA_VROW + 16 * v0c) = vr;
        __syncthreads();
        if (j + 1 < NT) { const bf16* Kt = Kb + (size_t)(64 * (j + 1)) * 768;
            kr0 = *(const GAS v4u*)(Kt + (size_t)k0r * 768 + 8 * k0c); if (tid < 256) kr1 = *(const GAS v4u*)(Kt + (size_t)k1r * 768 + 8 * k1c); vr = *(const GAS v4u*)(PA_VROWP(64 * (j + 1) + v0r) + 8 * v0c); }
        if (64 * j <= wlast) {
            f32x16 p0, p1;
#pragma unroll
            for (int r = 0; r < 16; ++r) { p0[r] = 0.f; p1[r] = 0.f; }
#pragma unroll
            for (int s = 0; s < 6; ++s) {
                const bf16x8 a0 = *(const LAS bf16x8*)(lds + PA_KS + r32 * PA_KROW + 32 * s + 16 * hi);
                const bf16x8 a1 = *(const LAS bf16x8*)(lds + PA_KS + (r32 + 32) * PA_KROW + 32 * s + 16 * hi);
                p0 = MFMA32(a0, qf[s], p0); p1 = MFMA32(a1, qf[s], p1);
            }
            int need_mask = __builtin_amdgcn_readfirstlane((64 * j + 63 > wfirst) ? 1 : 0); asm volatile("" : "+s"(need_mask));
            float ls = 0.f;
#pragma unroll
            for (int r = 0; r < 16; ++r) { p0[r] = __builtin_amdgcn_exp2f(p0[r]); p1[r] = __builtin_amdgcn_exp2f(p1[r]); }
            if (need_mask) {
#pragma unroll
                for (int r = 0; r < 16; ++r) { const int kp = 64 * j + crow(r, hi); if (kp > qpos) p0[r] = 0.f; if (kp + 32 > qpos) p1[r] = 0.f; }
            }
#pragma unroll
            for (int r = 0; r < 16; ++r) ls += p0[r] + p1[r];
            l += ls;
            bf16x8 pf[4];
#pragma unroll
            for (int ks = 0; ks < 4; ++ks) { v4u w;
                if (ks < 2) { w.x = pk2(p0[8 * ks + 0], p0[8 * ks + 1]); w.y = pk2(p0[8 * ks + 2], p0[8 * ks + 3]); w.z = pk2(p0[8 * ks + 4], p0[8 * ks + 5]); w.w = pk2(p0[8 * ks + 6], p0[8 * ks + 7]); }
                else { const int k2 = ks - 2; w.x = pk2(p1[8 * k2 + 0], p1[8 * k2 + 1]); w.y = pk2(p1[8 * k2 + 2], p1[8 * k2 + 3]); w.z = pk2(p1[8 * k2 + 4], p1[8 * k2 + 5]); w.w = pk2(p1[8 * k2 + 6], p1[8 * k2 + 7]); }
                pf[ks] = __builtin_bit_cast(bf16x8, w); }
#pragma unroll
            for (int ks = 0; ks < 4; ++ks) {
#pragma unroll
                for (int db = 0; db < 2; ++db) {
                    const LAS unsigned char* base = lds + PA_VS + (16 * ks + 4 * hi + tq) * PA_VROW + (32 * db + 16 * blk + 4 * tp) * 2;
                    const s16x4 t0 = tr_read(base), t1 = tr_read(base + 8 * PA_VROW);
                    const bf16x8 a = (bf16x8){t0[0], t0[1], t0[2], t0[3], t1[0], t1[1], t1[2], t1[3]};
                    if (db == 0) o0 = MFMA32(a, pf[ks], o0); else o1 = MFMA32(a, pf[ks], o1);
                }
            }
        }
    }
    { auto rr = __builtin_amdgcn_permlane32_swap(__float_as_uint(l), __float_as_uint(l), false, false); l = __uint_as_float(rr[0]) + __uint_as_float(rr[1]); }
    const float inv = 1.0f / l;
    { float ss = 0.f;
#pragma unroll
      for (int r = 0; r < 16; ++r) { const float a = o0[r] * inv, c = o1[r] * inv; ss += a * a + c * c; }
      auto rr = __builtin_amdgcn_permlane32_swap(__float_as_uint(ss), __float_as_uint(ss), false, false); ss = __uint_as_float(rr[0]) + __uint_as_float(rr[1]);
      if (hi == 0) ((float*)(ws + WS_SSQ))[(size_t)(b * SEQ + q0 + r32) * NH + h] = ss; }
    bf16* Op = (bf16*)(ws + WS_MIX) + (size_t)(b * SEQ + q0 + r32) * DM + h * VH;
#pragma unroll
    for (int g = 0; g < 4; ++g) {
        v2u w0, w1; w0.x = pk2(o0[4 * g] * inv, o0[4 * g + 1] * inv); w0.y = pk2(o0[4 * g + 2] * inv, o0[4 * g + 3] * inv);
        w1.x = pk2(o1[4 * g] * inv, o1[4 * g + 1] * inv); w1.y = pk2(o1[4 * g + 2] * inv, o1[4 * g + 3] * inv);
        *(GAS v2u*)(Op + 8 * g + 4 * hi) = w0; *(GAS v2u*)(Op + 32 + 8 * g + 4 * hi) = w1;
    }
}

constexpr int SA_LT = 0, SA_LTB = 16384  , SA_KP = 65536, SA_KPB = 2048  , SA_KSQ = 73728, SA_KSB = 128,
              SA_F8 = 74240, SA_F8B = 8192  , SA_RS = 90624, SA_RSB = 1024  , SA_PL = 92672, SA_PLB = 2048, SA_PROW = 64  ,
              SA_QAL = 96768, SA_QROW = 576  , SA_LRED = 115200  , SA_BYTES = SA_LRED + 512;
static_assert(SA_BYTES <= LDSCTL_OFF, "sample attention LDS map");
__device__ __forceinline__ int sa_pi(int x) { return (0x1320 >> (4 * x)) & 3; }
__device__ __forceinline__ int sa_g(int key) { return ((key & 3) << 2) | sa_pi((key >> 2) & 3); }
__device__ __forceinline__ int sa_g8(int key) { return ((key & 3) << 2) | ((0x2310 >> (4 * ((key >> 2) & 3))) & 3); }
typedef int v8i __attribute__((ext_vector_type(8)));
#define MFMA_F8(a, b, c) __builtin_amdgcn_mfma_scale_f32_16x16x128_f8f6f4((a), (b), (c), 0, 0, 0, 0x7F7F7F7F, 0, 0x7F7F7F7F)

__device__ __forceinline__ void sattn_unit(const Params& P, Frame& F, int b, int sp) {
    unsigned char* ws = P.ws; asm volatile("" : "+s"(ws)); LAS unsigned char* lds = F.lds;
    int tid_ = F.tid; asm volatile("" : "+v"(tid_));
    int wave_ = F.wave; asm volatile("" : "+s"(wave_));
    const int tid = tid_, lane = tid & 63, wave = wave_, r32 = lane & 31, hi = lane >> 5, fr = lane & 15, fq = lane >> 4;
    const int h = wave, sg = wave & 1, skb = (wave >> 1) & 1, spar = wave >> 2;
    const int srow0 = MP + b * DS;
    __syncthreads();
    {
        bf16x8 qn[6];
        q_norm_frags(P, (const bf16*)(ws + WS_QRAW) + (size_t)(srow0 + (r32 & 3)) * 768 + h * QKH, TP + (r32 & 3), hi, qn);
        bf16x8 bq[4];
#pragma unroll
        for (int ks = 0; ks < 4; ++ks) {
            float e[8]; unpack8(__builtin_bit_cast(v4u, qn[ks]), e);
#pragma unroll
            for (int i = 0; i < 8; ++i) e[i] = (r32 < 4) ? e[i] * P.k_norm_g[16 * ks + 8 * hi + i] : 0.f;
            bq[ks] = __builtin_bit_cast(bf16x8, pack8(e));
        }
        const bf16* WB = (const bf16*)(ws + WS_WUKVB);
        const int lr = lane >> 3, lc = lane & 7;
        const GAS unsigned char* wp = (const GAS unsigned char*)(WB + (size_t)lr * 1024 + h * 128) + 16 * lc;
        LAS unsigned char* wimg = lds + SA_LT + wave * 4608;
#pragma unroll 1
        for (int half = 0; half < 2; ++half) {
        v4u ra[4][4];
#pragma unroll
        for (int q = 0; q < 4; ++q)
#pragma unroll
            for (int j = 0; j < 4; ++j) ra[q][j] = *(const GAS v4u*)(wp + (size_t)(32 * (4 * half + q) + 8 * j) * 2048);
#pragma unroll
        for (int q = 0; q < 4; ++q) { const int cb = 4 * half + q;
#pragma unroll
            for (int j = 0; j < 4; ++j) *(LAS v4u*)(wimg + (lr + 8 * j) * 144 + lc * 16) = ra[q][j];
            f32x16 acc;
#pragma unroll
            for (int r = 0; r < 16; ++r) acc[r] = 0.f;
#pragma unroll
            for (int ks = 0; ks < 4; ++ks) { const bf16x8 a = *(const LAS bf16x8*)(wimg + r32 * 144 + (2 * ks + hi) * 16); acc = MFMA32(a, bq[ks], acc); }
            if (r32 < 4) {
#pragma unroll
                for (int g = 0; g < 4; ++g) { v2u w; w.x = pk2(acc[4 * g], acc[4 * g + 1]); w.y = pk2(acc[4 * g + 2], acc[4 * g + 3]);
                    *(LAS v2u*)(lds + SA_QAL + (h * 4 + r32) * SA_QROW + (32 * cb + 8 * g + 4 * hi) * 2) = w; }
            }
        }
        }
        if (r32 < 4) {
            float e[8], f[8]; unpack8(__builtin_bit_cast(v4u, qn[4]), e); unpack8(__builtin_bit_cast(v4u, qn[5]), f);
#pragma unroll
            for (int i = 0; i < 8; ++i) { e[i] *= P.k_norm_g[64 + 8 * hi + i]; f[i] *= P.k_norm_g[80 + 8 * hi + i]; }
            *(LAS v4u*)(lds + SA_QAL + (h * 4 + r32) * SA_QROW + (256 + 8 * hi) * 2) = pack8(e);
            *(LAS v4u*)(lds + SA_QAL + (h * 4 + r32) * SA_QROW + (256 + 16 + 8 * hi) * 2) = pack8(f);
        }
    }
    __syncthreads();
    const LAS unsigned char* qaf = lds + SA_QAL + (16 * sg + fr) * SA_QROW + 16 * fq;
    v8i Wf[4][2];
    {
        const unsigned char* WF = (const unsigned char*)(ws + WS_WF8);
#pragma unroll
        for (int db = 0; db < 4; ++db)
#pragma unroll
            for (int st = 0; st < 2; ++st) { const GAS v4u* p = (const GAS v4u*)(WF + (size_t)(h * 64 + 16 * db + fr) * 256 + 128 * st + 32 * fq); const v4u lo = p[0], hi4 = p[1];
                Wf[db][st] = (v8i){(int)lo.x, (int)lo.y, (int)lo.z, (int)lo.w, (int)hi4.x, (int)hi4.y, (int)hi4.z, (int)hi4.w}; }
    }
#pragma unroll
    for (int db = 0; db < 4; ++db)
#pragma unroll
        for (int st = 0; st < 2; ++st) asm volatile("" : "+v"(Wf[db][st]));
    constexpr int NCD = (NPAGES / SA_NS) * 4;
    const int NC = NCD + ((sp == SA_NS - 1) ? 1 : 0);
    int ptv = P.page_table[b * NPAGES + sp * (NPAGES / SA_NS) + (lane & 31)]; asm volatile("" : "+v"(ptv));
    f32x4 st[4]; f32x2_t kst;
    int woff[4], foff[4], koff, ksoff;
#pragma unroll
    for (int j = 0; j < 4; ++j) { const int f = tid + 512 * j, key = f >> 6, c4 = f & 63;
        woff[j] = key * 512 + (((c4 >> 1) ^ sa_g(key)) << 4) + 8 * (c4 & 1); foff[j] = key * 256 + (((c4 >> 2) ^ sa_g8(key)) << 4) + 4 * (c4 & 3);
        asm volatile("" : "+v"(woff[j]), "+v"(foff[j])); }
    { const int key = tid >> 4, c2 = tid & 15; koff = key * 64 + (((c2 >> 2) ^ sa_pi((key >> 2) & 3)) << 4) + 4 * (c2 & 3); ksoff = key * 4; asm volatile("" : "+v"(koff), "+v"(ksoff)); }
    unsigned goff = (unsigned)tid * 16u; asm volatile("" : "+v"(goff));
    int nbase[2];
#pragma unroll
    for (int kb = 0; kb < 2; ++kb) { const int key = 16 * kb + fr; nbase[kb] = key * 256 + (((2 * fq) ^ sa_g8(key)) << 4); asm volatile("" : "+v"(nbase[kb])); }
#define SA_LOAD(ii) do { const int i_ = (ii); const int page = __builtin_amdgcn_readlane(ptv, (i_ >> 2) & 31); const size_t k0 = (size_t)page * PAGE + (i_ & 3) * 32; \
        const GAS unsigned char* gl = (const GAS unsigned char*)((i_ < NCD) ? P.cache_lat + k0 * KVL : (const float*)(ws + WS_NEWLAT) + (size_t)b * 32 * KVL); \
        const GAS unsigned char* gk_ = (const GAS unsigned char*)((i_ < NCD) ? P.cache_kpe + k0 * QKR : (const float*)(ws + WS_NEWKPE) + (size_t)b * 32 * QKR); \
        _Pragma("unroll") \
        for (int j = 0; j < 4; ++j) st[j] = __builtin_nontemporal_load((const GAS f32x4*)(gl + (size_t)(goff + 8192u * j))); \
        kst = __builtin_nontemporal_load((const GAS f32x2_t*)(gk_ + (size_t)(goff >> 1))); \
    } while (0)
#define DPP_ADD(v, ctrl) ((v) + __builtin_bit_cast(float, __builtin_amdgcn_update_dpp(0, __builtin_bit_cast(int, (v)), (ctrl), 0xf, 0xf, true)))
#define SA_WRITE(q4, q2) do { const int lo_ = (q4) * SA_LTB, fo_ = (q2) * SA_F8B, ko_ = (q4) * SA_KPB, so_ = (q4) * SA_KSB; \
        _Pragma("unroll") \
        for (int j = 0; j < 4; ++j) { \
            v2u w; w.x = pk2(st[j].x, st[j].y); w.y = pk2(st[j].z, st[j].w); \
            *(LAS v2u*)(lds + SA_LT + lo_ + woff[j]) = w; \
            int f8 = (int)w.x; f8 = __builtin_amdgcn_cvt_pk_fp8_f32(st[j].x, st[j].y, f8, false); f8 = __builtin_amdgcn_cvt_pk_fp8_f32(st[j].z, st[j].w, f8, true); \
            *(LAS int*)(lds + SA_F8 + fo_ + foff[j]) = f8; } \
        { *(LAS unsigned*)(lds + SA_KP + ko_ + koff) = pk2(kst.x, kst.y); \
            float ss = kst.x * kst.x + kst.y * kst.y; \
            ss = DPP_ADD(ss, 0xB1); ss = DPP_ADD(ss, 0x4E); ss = DPP_ADD(ss, 0x141); ss = DPP_ADD(ss, 0x140);     \
            if ((tid & 15) == 0) *(LAS float*)(lds + SA_KSQ + so_ + ksoff) = ss; } \
    } while (0)
    float lsum[4] = {0.f, 0.f, 0.f, 0.f};
    f32x16 ol;
#pragma unroll
    for (int r = 0; r < 16; ++r) ol[r] = 0.f;
    const int blk = (lane >> 4) & 1, tq = (lane & 15) >> 2, tp = lane & 3;
    int tro[2][2], pro[2][2];
#pragma unroll
    for (int ks = 0; ks < 2; ++ks)
#pragma unroll
        for (int t2 = 0; t2 < 2; ++t2) { const int row = 16 * ks + 8 * hi + tq + 4 * t2, ch = 4 * wave + 2 * blk + (tp >> 1);
            tro[ks][t2] = row * 512 + ((ch ^ sa_g(row)) << 4) + 8 * (tp & 1); pro[ks][t2] = row * SA_PROW + (16 * blk + 4 * tp) * 2; asm volatile("" : "+v"(tro[ks][t2]), "+v"(pro[ks][t2])); }
    SA_LOAD(0); SA_WRITE(0, 0); SA_LOAD(1);
    asm volatile("s_waitcnt lgkmcnt(0)" ::: "memory"); __builtin_amdgcn_s_barrier(); asm volatile("" ::: "memory");
#define SA_PV(q4, q2) do { const int pb_ = (q4) * SA_LTB, pp_ = (q2) * SA_PLB; \
            const s16x4 t00 = tr_read(lds + SA_LT + pb_ + tro[0][0]), t01 = tr_read(lds + SA_LT + pb_ + tro[0][1]), p00 = tr_read(lds + SA_PL + pp_ + pro[0][0]), p01 = tr_read(lds + SA_PL + pp_ + pro[0][1]); \
            const s16x4 t10 = tr_read(lds + SA_LT + pb_ + tro[1][0]), t11 = tr_read(lds + SA_LT + pb_ + tro[1][1]), p10 = tr_read(lds + SA_PL + pp_ + pro[1][0]), p11 = tr_read(lds + SA_PL + pp_ + pro[1][1]); \
            __builtin_amdgcn_sched_barrier(0); \
            ol = MFMA32(((bf16x8){t00[0], t00[1], t00[2], t00[3], t01[0], t01[1], t01[2], t01[3]}), ((bf16x8){p00[0], p00[1], p00[2], p00[3], p01[0], p01[1], p01[2], p01[3]}), ol); \
            ol = MFMA32(((bf16x8){t10[0], t10[1], t10[2], t10[3], t11[0], t11[1], t11[2], t11[3]}), ((bf16x8){p10[0], p10[1], p10[2], p10[3], p11[0], p11[1], p11[2], p11[3]}), ol); } while (0)
#ifndef SA_STAGGER
#define SA_STAGGER 1
#endif
#define SA_NLOAD(kb, Q20, dst) do { int nb_ = nbase[kb]; asm volatile("" : "+v"(nb_));     \
        const LAS unsigned char* frow = lds + SA_F8 + (Q20) * SA_F8B; \
        _Pragma("unroll") \
        for (int st2 = 0; st2 < 2; ++st2) { const v4u lo = *(const LAS v4u*)(frow + (nb_ ^ ((8 * st2) << 4))), hi4 = *(const LAS v4u*)(frow + (nb_ ^ ((8 * st2 + 1) << 4))); \
            dst[st2] = (v8i){(int)lo.x, (int)lo.y, (int)lo.z, (int)lo.w, (int)hi4.x, (int)hi4.y, (int)hi4.z, (int)hi4.w}; } } while (0)
#define SA_NMMA(src, acc_) do { \
        _Pragma("unroll") \
        for (int a = 0; a < 4; ++a) acc_[a] = (f32x4){0.f, 0.f, 0.f, 0.f}; \
        _Pragma("unroll") \
        for (int st2 = 0; st2 < 2; ++st2) \
            _Pragma("unroll") \
            for (int db = 0; db < 4; ++db) acc_[db] = MFMA_F8(Wf[db][st2], src[st2], acc_[db]); } while (0)
#define SA_NTAIL(kb, Q20, acc_, ksq_) do { const int key_ = (kb) * 16 + fr; float ss = 0.f; \
        _Pragma("unroll") \
        for (int db = 0; db < 4; ++db) ss += (acc_[db][0] * acc_[db][0] + acc_[db][1] * acc_[db][1]) + (acc_[db][2] * acc_[db][2] + acc_[db][3] * acc_[db][3]); \
        ss *= (1.0f / 256.0f);                            \
        { auto r16 = __builtin_amdgcn_permlane16_swap(__float_as_uint(ss), __float_as_uint(ss), false, false); ss = __uint_as_float(r16[0]) + __uint_as_float(r16[1]); \
          auto r32_ = __builtin_amdgcn_permlane32_swap(__float_as_uint(ss), __float_as_uint(ss), false, false); ss = __uint_as_float(r32_[0]) + __uint_as_float(r32_[1]); } \
        ss += (ksq_); \
        const float rs = __builtin_amdgcn_rsqf(ss * (1.f / QKH) + EPS); \
        if (fq == 0) *(LAS float*)(lds + SA_RS + (Q20) * SA_RSB + h * 128 + key_ * 4) = rs; } while (0)
#define SA_NSTAGE(Q20, Q40) do { \
        const float ksq0 = *(const LAS float*)(lds + SA_KSQ + (Q40) * SA_KSB + fr * 4), ksq1 = *(const LAS float*)(lds + SA_KSQ + (Q40) * SA_KSB + (16 + fr) * 4); \
        v8i nb[2]; f32x4 na0[4], na1[4]; \
        SA_NLOAD(0, Q20, nb); __builtin_amdgcn_sched_barrier(0); \
        SA_NMMA(nb, na0); __builtin_amdgcn_sched_barrier(0); \
        SA_NLOAD(1, Q20, nb); __builtin_amdgcn_sched_barrier(0); \
        SA_NTAIL(0, Q20, na0, ksq0); __builtin_amdgcn_sched_barrier(0); \
        SA_NMMA(nb, na1); __builtin_amdgcn_sched_barrier(0); \
        SA_NTAIL(1, Q20, na1, ksq1); } while (0)
#define SA_BODY(I, FULL, Q4M2, Q4M1, Q40, Q4P1, Q2M2, Q2M1, Q20, Q2P1) do { const int i = (I); \
        if ((SA_STAGGER ? wave >= 4 : true) && ((FULL) || i >= 2)) SA_PV(Q4M2, Q2M2); \
          \
        if ((FULL) || i < NC) SA_NSTAGE(Q20, Q40); \
          \
        if (((FULL) || (i >= 1 && i <= NC)) && (Q2M1) == spar) { \
            const int key = skb * 16 + fr; const bool newc = (FULL) ? false : (i - 1 >= NCD); \
            const LAS unsigned char* lrow = lds + SA_LT + (Q4M1) * SA_LTB + key * 512; const int gk = sa_g(key); \
            const LAS unsigned char* krow = lds + SA_KP + (Q4M1) * SA_KPB + key * 64 + ((fq ^ sa_pi((key >> 2) & 3)) << 4); \
            const float rsv = *(const LAS float*)(lds + SA_RS + (Q2M1) * SA_RSB + (4 * sg + fq) * 128 + key * 4);        \
            f32x4 sacc = (f32x4){0.f, 0.f, 0.f, 0.f}; \
            _Pragma("unroll") \
            for (int s = 0; s < 9; ++s) { const bf16x8 bf = (s < 8) ? *(const LAS bf16x8*)(lrow + (((4 * s + fq) ^ gk) << 4)) : *(const LAS bf16x8*)(krow); const bf16x8 qa = *(const LAS bf16x8*)(qaf + 64 * s); sacc = MFMA16(qa, bf, sacc); } \
            float pv[4]; \
            _Pragma("unroll") \
            for (int i4 = 0; i4 < 4; ++i4) { float p = __builtin_amdgcn_exp2f(sacc[i4] * rsv); if (newc && (key >= DS || key > i4)) p = 0.f; lsum[i4] += p; pv[i4] = p; } \
            v2u w; w.x = pk2(pv[0], pv[1]); w.y = pk2(pv[2], pv[3]); \
            *(LAS v2u*)(lds + SA_PL + (Q2M1) * SA_PLB + key * SA_PROW + sg * 32 + fq * 8) = w;         \
        } \
        if (SA_STAGGER && wave < 4 && ((FULL) || i >= 2)) SA_PV(Q4M2, Q2M2); \
        if ((FULL) || i + 1 < NC) { SA_WRITE(Q4P1, Q2P1); if ((FULL) || i + 2 < NC) SA_LOAD(i + 2); } \
        asm volatile("s_waitcnt lgkmcnt(0)" ::: "memory"); __builtin_amdgcn_s_barrier(); asm volatile("" ::: "memory"); \
    } while (0)
#define SA_GEN(I) SA_BODY(I, false, ((I) - 2) & 3, ((I) - 1) & 3, (I) & 3, ((I) + 1) & 3, (I) & 1, ((I) - 1) & 1, (I) & 1, ((I) + 1) & 1)
    SA_GEN(0); SA_GEN(1);
    int ii = 2;
    for (; ii + 3 <= NC - 3; ii += 4) {
        SA_BODY(ii,     true, 0, 1, 2, 3, 0, 1, 0, 1);
        SA_BODY(ii + 1, true, 1, 2, 3, 0, 1, 0, 1, 0);
        SA_BODY(ii + 2, true, 2, 3, 0, 1, 0, 1, 0, 1);
        SA_BODY(ii + 3, true, 3, 0, 1, 2, 1, 0, 1, 0);
    }
    for (; ii <= NC + 1; ++ii) SA_GEN(ii);
    {
        int l2 = lane; asm volatile("" : "+v"(l2)); const int r32e = l2 & 31, hie = l2 >> 5; asm volatile("" : "+s"(ws));
        float* part = (float*)(ws + WS_PART) + ((size_t)(b * SA_NS + sp) * 32 + r32e) * KVL + 32 * wave;
#pragma unroll
        for (int g = 0; g < 4; ++g) *(GAS f32x4*)(part + 8 * g + 4 * hie) = (f32x4){ol[4 * g], ol[4 * g + 1], ol[4 * g + 2], ol[4 * g + 3]};
#pragma unroll
        for (int i4 = 0; i4 < 4; ++i4) { float v = lsum[i4]; v += __shfl_xor(v, 1); v += __shfl_xor(v, 2); v += __shfl_xor(v, 4); v += __shfl_xor(v, 8);
            if ((l2 & 15) == 0) *(LAS float*)(lds + SA_LRED + (wave * 16 + 4 * (l2 >> 4) + i4) * 4) = v; }
        __syncthreads();
        if (wave == 0 && l2 < 32) { const int g = l2 >> 4, idx = l2 & 15; float t = 0.f;
#pragma unroll
            for (int w4 = 0; w4 < 4; ++w4) t += *(const LAS float*)(lds + SA_LRED + ((2 * w4 + g) * 16 + idx) * 4);
            ((float*)(ws + WS_LPART))[(size_t)(b * SA_NS + sp) * 32 + l2] = t; }
    }
#undef SA_LOAD
#undef SA_WRITE
#undef SA_PV
#undef SA_BODY
#undef SA_GEN
#undef SA_NLOAD
#undef SA_NMMA
#undef SA_NTAIL
#undef SA_NSTAGE
}

__device__ __forceinline__ void p3_attention(const Params& P, Frame& F) {
    const int c = blockIdx.x, G = F.G;
#ifndef PA_REP
#define PA_REP 1
#endif
#ifndef SA_REP
#define SA_REP 1
#endif
#ifndef NO_PA
    for (int rep = 0; rep < PA_REP; ++rep)
    for (int u = c; u < 512; u += G) { const int i = u >> 8, cc = u & 255; const int k = cc >> 6, bh = cc & 63; const int qb = (i == 0) ? 7 - k : k; pattn_unit(P, F, bh >> 3, bh & 7, qb); }
#endif
#ifndef NO_SA
    for (int rep = 0; rep < SA_REP; ++rep)
    for (int u = c; u < DB * SA_NS; u += G) sattn_unit(P, F, u / SA_NS, u % SA_NS);
#endif
}

__device__ __forceinline__ void p4a_sample(const Params& P, Frame& F) {
    unsigned char* ws = P.ws; const int lane = F.lane, h = F.wave;
    LAS float* scr = (LAS float*)(F.lds + RING_OFF + F.wave * 2048);
    LAS float* ssb = (LAS float*)(F.lds + RING_OFF + 16384);
    const int r0 = MP + 2 * (int)blockIdx.x; if (r0 >= MR) return;
    const int b = (r0 - MP) >> 2, m0 = h * 4 + ((r0 - MP) & 3);
    {
        float l[2] = {0.f, 0.f}; f32x4 acc[2] = {(f32x4){0.f, 0.f, 0.f, 0.f}, (f32x4){0.f, 0.f, 0.f, 0.f}};
#pragma unroll
        for (int sp = 0; sp < SA_NS; ++sp)
#pragma unroll
            for (int q = 0; q < 2; ++q) { l[q] += ((const float*)(ws + WS_LPART))[(size_t)(b * SA_NS + sp) * 32 + m0 + q];
                acc[q] = acc[q] + *(const GAS f32x4*)((const float*)(ws + WS_PART) + ((size_t)(b * SA_NS + sp) * 32 + m0 + q) * KVL + 4 * lane); }
#pragma unroll
        for (int q = 0; q < 2; ++q) *(LAS f32x4*)(scr + 256 * q + 4 * lane) = acc[q] * (1.0f / l[q]);
    }
    LDS_WAIT(); asm volatile("" ::: "memory");
    const int cg = lane >> 3, dq = lane & 7;
    const GAS unsigned char* wp = (const GAS unsigned char*)((const bf16*)(ws + WS_WUKVB) + (size_t)cg * 1024 + h * 128 + 64 + 8 * dq);
    float o8[2][8];
#pragma unroll
    for (int i = 0; i < 8; ++i) { o8[0][i] = 0.f; o8[1][i] = 0.f; }
#pragma unroll 1
    for (int kb = 0; kb < 2; ++kb) {
        v4u w[16];
#pragma unroll
        for (int kk = 0; kk < 16; ++kk) w[kk] = *(const GAS v4u*)(wp + (size_t)(8 * (16 * kb + kk)) * 2048);
#pragma unroll
        for (int kk = 0; kk < 16; ++kk) { const float sc0 = scr[8 * (16 * kb + kk) + cg], sc1 = scr[256 + 8 * (16 * kb + kk) + cg]; float e[8]; unpack8(w[kk], e);
#pragma unroll
            for (int i = 0; i < 8; ++i) { o8[0][i] += sc0 * e[i]; o8[1][i] += sc1 * e[i]; } }
    }
    float ssw[2] = {0.f, 0.f};
#pragma unroll
    for (int q = 0; q < 2; ++q) {
#pragma unroll
        for (int i = 0; i < 8; ++i) { float v = o8[q][i]; v += __shfl_xor(v, 8); v += __shfl_xor(v, 16); v += __shfl_xor(v, 32); o8[q][i] = v; ssw[q] += v * v; }
        ssw[q] += __shfl_xor(ssw[q], 1); ssw[q] += __shfl_xor(ssw[q], 2); ssw[q] += __shfl_xor(ssw[q], 4);
    }
    if (lane == 0) { ssb[h] = ssw[0]; ssb[8 + h] = ssw[1]; }
    __syncthreads();
#pragma unroll
    for (int q = 0; q < 2; ++q) {
        float tot = 0.f;
#pragma unroll
        for (int j = 0; j < NH; ++j) tot += ssb[8 * q + j];
        const float rs = 1.0f / sqrtf(tot * (1.f / AW) + EPS);
        if (cg == 0) { float e[8];
#pragma unroll
            for (int i = 0; i < 8; ++i) e[i] = o8[q][i] * rs;
            *(GAS v4u*)((bf16*)(ws + WS_MIX) + (size_t)(r0 + q) * DM + h * VH + 8 * dq) = pack8(e); }
    }
    __syncthreads();
}

__device__ __forceinline__ f32x16 skinny_tile(LAS unsigned char* wl  , const bf16* A, int lda, const bf16* Bt, int ldb, int row0, int col0, int kbeg, int kend, int lane) {
    const int r32 = lane & 31, hi = lane >> 5, lr = lane >> 3, lc = lane & 7;
    const GAS unsigned char* ap = (const GAS unsigned char*)(A + (size_t)(row0 + lr) * lda + kbeg) + 16 * lc;
    const GAS unsigned char* bp = (const GAS unsigned char*)(Bt + (size_t)(col0 + lr) * ldb + kbeg) + 16 * lc;
    const size_t astep = (size_t)8 * lda * 2, bstep = (size_t)8 * ldb * 2;
    f32x16 acc;
#pragma unroll
    for (int r = 0; r < 16; ++r) acc[r] = 0.f;
    v4u ra[4], rb[4];
#pragma unroll
    for (int j = 0; j < 4; ++j) { ra[j] = *(const GAS v4u*)(ap + j * astep); rb[j] = *(const GAS v4u*)(bp + j * bstep); }
    const int nit = (kend - kbeg) >> 6;
    LAS unsigned char* wst = wl + lr * 144 + lc * 16;
    const LAS unsigned char* rfa = wl + r32 * 144 + hi * 16;
#pragma unroll 1
    for (int it = 0; it < nit; ++it) {
#pragma unroll
        for (int j = 0; j < 4; ++j) { *(LAS v4u*)(wst + j * (8 * 144)) = ra[j]; *(LAS v4u*)(wst + 4608 + j * (8 * 144)) = rb[j]; }
        if (it + 1 < nit) {
#pragma unroll
            for (int j = 0; j < 4; ++j) { ra[j] = *(const GAS v4u*)(ap + (size_t)(it + 1) * 128 + j * astep); rb[j] = *(const GAS v4u*)(bp + (size_t)(it + 1) * 128 + j * bstep); } }
        bf16x8 a[4], b[4];
#pragma unroll
        for (int s4 = 0; s4 < 4; ++s4) { a[s4] = *(const LAS bf16x8*)(rfa + 32 * s4); b[s4] = *(const LAS bf16x8*)(rfa + 4608 + 32 * s4); }
#pragma unroll
        for (int s4 = 0; s4 < 4; ++s4) acc = MFMA32(a[s4], b[s4], acc);
    }
    return acc;
}
__device__ __forceinline__ f32x16 coop_tile(LAS unsigned char* img  , const bf16* A, int lda, const bf16* Bt, int ldb, int row0, int col0, int K, int tid, int wave) {
    const int lane = tid & 63, r32 = lane & 31, hi = lane >> 5, lr = tid >> 3, lc = tid & 7;
    const GAS unsigned char* ap = (const GAS unsigned char*)(A + (size_t)(row0 + lr) * lda) + 16 * lc;
    const GAS unsigned char* bp = (const GAS unsigned char*)(Bt + (size_t)(col0 + lr) * ldb) + 16 * lc;
    const size_t bstep = (size_t)64 * ldb * 2;
    constexpr int STG = 192 * 144;
    LAS unsigned char* wst = img + lr * 144 + lc * 16;
    const LAS unsigned char* rfa = img + (32 * (wave >> 2) + r32) * 144 + hi * 16;
    const LAS unsigned char* rfb = img + 9216 + (32 * (wave & 3) + r32) * 144 + hi * 16;
    f32x16 acc;
#pragma unroll
    for (int r = 0; r < 16; ++r) acc[r] = 0.f;
    v4u r0[3], r1[3];
#define CT_LOAD(R, blk) do { const size_t ko_ = (size_t)(blk) * 128; R[0] = *(const GAS v4u*)(ap + ko_); R[1] = *(const GAS v4u*)(bp + ko_); R[2] = *(const GAS v4u*)(bp + bstep + ko_); } while (0)
#define CT_PUT(R, st) do { *(LAS v4u*)(wst + (st) * STG) = R[0]; *(LAS v4u*)(wst + (st) * STG + 9216) = R[1]; *(LAS v4u*)(wst + (st) * STG + 9216 + 64 * 144) = R[2]; } while (0)
#define CT_MMA(st) do { bf16x8 a[4], b[4]; \
        _Pragma("unroll") \
        for (int s4 = 0; s4 < 4; ++s4) { a[s4] = *(const LAS bf16x8*)(rfa + (st) * STG + 32 * s4); b[s4] = *(const LAS bf16x8*)(rfb + (st) * STG + 32 * s4); } \
        _Pragma("unroll") \
        for (int s4 = 0; s4 < 4; ++s4) acc = MFMA32(a[s4], b[s4], acc); } while (0)
    CT_LOAD(r0, 0); CT_LOAD(r1, 1);
    const int nit = K >> 6;
#pragma unroll 1
    for (int it = 0; it < nit; it += 2) {
        CT_PUT(r0, 0); if (it + 2 < nit) CT_LOAD(r0, it + 2);
        __syncthreads();
        CT_MMA(0);
        CT_PUT(r1, 1); if (it + 3 < nit) CT_LOAD(r1, it + 3);
        __syncthreads();
        CT_MMA(1);
    }
#undef CT_LOAD
#undef CT_PUT
#undef CT_MMA
    __syncthreads();
    return acc;
}
template <bool XCOPY> __device__ __forceinline__ void skinny_res_n1024(Frame& F, const bf16* A, int lda, const bf16* Bt, int K, const float* base, float* out, bf16* xb, float* rowss) {
    int tid_ = threadIdx.x; asm volatile("" : "+v"(tid_)); const int lane = tid_ & 63, wave = __builtin_amdgcn_readfirstlane(tid_ >> 6), r32 = lane & 31, hi = lane >> 5;
    const int t = 2 * blockIdx.x + (wave >> 2), kq = wave & 3; const int row0 = 32 * (t >> 5), col0 = 32 * (t & 31);
    LAS float* red = (LAS float*)(F.lds + RING_OFF);
    f32x16 acc;
#pragma unroll
    for (int r = 0; r < 16; ++r) acc[r] = 0.f;
    if (t < 512) acc = skinny_tile(F.lds + RING_OFF + 32768 + wave * 9216, A, lda, Bt, K, row0, col0, kq * (K >> 2), (kq + 1) * (K >> 2), lane);
    if (kq != 0) {
#pragma unroll
        for (int r = 0; r < 16; ++r) red[wave * 1024 + r * 64 + lane] = acc[r]; }
    __syncthreads();
    if (kq == 0 && t < 512) {
#pragma unroll
        for (int r = 0; r < 16; ++r) { const float v = acc[r] + red[(wave + 1) * 1024 + r * 64 + lane] + red[(wave + 2) * 1024 + r * 64 + lane] + red[(wave + 3) * 1024 + r * 64 + lane];
            const size_t o = (size_t)(row0 + crow(r, hi)) * DM + col0 + r32;
            if (!XCOPY) { out[o] = __uint_as_float((unsigned)xb[o] << 16) + v; }
            else { const float x1 = base[o] + v; xb[o] = (bf16)(pk2(x1, 0.f) & 0xffffu); float q = x1 * x1; q += __shfl_xor(q, 1); q += __shfl_xor(q, 2); q += __shfl_xor(q, 4); q += __shfl_xor(q, 8); q += __shfl_xor(q, 16);
                if (r32 == 0) atomicAdd(rowss + row0 + crow(r, hi), q); } }
    }
    __syncthreads();
}
__device__ __forceinline__ void skinny_up(Frame& F, const bf16* A, const bf16* Bt, bf16* H, const float* rowss) {
    int tid_ = threadIdx.x; asm volatile("" : "+v"(tid_)); const int lane = tid_ & 63, wave = __builtin_amdgcn_readfirstlane(tid_ >> 6), r32 = lane & 31, hi = lane >> 5;
    const int c = blockIdx.x; if (c >= 256) return;
    const int row0 = 64 * (c >> 5) + 32 * (wave >> 2), col0 = 128 * (c & 31) + 32 * (wave & 3);
    const f32x16 acc = coop_tile(F.lds + RING_OFF, A, DM, Bt, DM, 64 * (c >> 5), 128 * (c & 31), DM, tid_, wave);
#pragma unroll
    for (int r = 0; r < 16; ++r) { const float a = acc[r] * __builtin_amdgcn_rsqf(rowss[row0 + crow(r, hi)] * (1.0f / 1024.0f) + 1e-6f); const float v = a > 0.f ? a : 0.f; H[(size_t)(row0 + crow(r, hi)) * DFF + col0 + r32] = (bf16)(pk2(v * v, 0.f) & 0xffffu); }
}

__device__ __forceinline__ void p1_leftover(const Params& P, Frame& F) {
    unsigned char* ws = P.ws;
    int tid_ = threadIdx.x; asm volatile("" : "+v"(tid_)); const int lane = tid_ & 63, wave = __builtin_amdgcn_readfirstlane(tid_ >> 6), r32 = lane & 31, hi = lane >> 5;
    const bf16* XN = (const bf16*)(ws + WS_XN); const bf16* WIN = (const bf16*)(ws + WS_WIN); bf16* Z = (bf16*)(ws + WS_Z);
    for (int ta = blockIdx.x; ta < 256 + 9 * 18; ta += gridDim.x) {
        int R0, C0; if (ta < 256) { R0 = 64 * ta; C0 = 2048; } else { const int u = ta - 256; R0 = MP + 64 * (u / 18); C0 = 128 * (u % 18); }
        const f32x16 acc = coop_tile(F.lds + RING_OFF, XN, DM, WIN, DM, R0, C0, DM, tid_, wave);
        const int row0 = R0 + 32 * (wave >> 2), col0 = C0 + 32 * (wave & 3);
#pragma unroll
        for (int r = 0; r < 16; ++r) Z[(size_t)(row0 + crow(r, hi)) * INWP + col0 + r32] = (bf16)(pk2(acc[r], 0.f) & 0xffffu);
    }
    LAS float* red = (LAS float*)(F.lds + RING_OFF);
    for (int tc = blockIdx.x; tc < MP / 64; tc += gridDim.x) {
        const int row0 = 64 * tc + 32 * (wave >> 2), kq = wave & 3;
        const f32x16 acc = skinny_tile(F.lds + RING_OFF + 32768 + wave * 9216, XN, DM, WIN, DM, row0, 2176, 256 * kq, 256 * (kq + 1), lane);
        if (kq != 0) {
#pragma unroll
            for (int r = 0; r < 16; ++r) red[wave * 1024 + r * 64 + lane] = acc[r]; }
        __syncthreads();
        if (kq == 0) {
#pragma unroll
            for (int r = 0; r < 16; ++r) { const float v = acc[r] + red[(wave + 1) * 1024 + r * 64 + lane] + red[(wave + 2) * 1024 + r * 64 + lane] + red[(wave + 3) * 1024 + r * 64 + lane];
                Z[(size_t)(row0 + crow(r, hi)) * INWP + 2176 + r32] = (bf16)(pk2(v, 0.f) & 0xffffu); } }
        __syncthreads();
    }
}

struct EpiKV {
    static constexpr bool PERM = true, AFTER_DRAIN = false, HAS_MID = false;
    bf16* KV; bf16* K; const float* kper; const float* kss; const float* g; LAS float* ex;
    __device__ __forceinline__ void operator()(const pg8::f32x4 (&acc)[2][2][4][2], const pg8::Unit& u, int wr_in, int wc_in, int fr_in, int fq_in) const {
        int wr = wr_in, wc = wc_in, fr = fr_in, fq = fq_in; asm volatile("" : "+s"(wr), "+s"(wc), "+v"(fr), "+v"(fq));
        const bool kpart = wc < 2;
        const int rowb = u.pm * 256 + wr * 64 + fr;
        if (kpart) {
#pragma unroll
            for (int ai = 0; ai < 2; ++ai)
#pragma unroll
                for (int m = 0; m < 4; ++m)
#pragma unroll
                    for (int bj = 0; bj < 2; ++bj) { const pg8::f32x4 a0 = acc[ai][bj][m][0], a1 = acc[ai][bj][m][1];
                        float ss = ((a0[0] * a0[0] + a0[1] * a0[1]) + (a0[2] * a0[2] + a0[3] * a0[3])) + ((a1[0] * a1[0] + a1[1] * a1[1]) + (a1[2] * a1[2] + a1[3] * a1[3]));
                        { auto r16 = __builtin_amdgcn_permlane16_swap(__float_as_uint(ss), __float_as_uint(ss), false, false); ss = __uint_as_float(r16[0]) + __uint_as_float(r16[1]);
                          auto r32 = __builtin_amdgcn_permlane32_swap(__float_as_uint(ss), __float_as_uint(ss), false, false); ss = __uint_as_float(r32[0]) + __uint_as_float(r32[1]); }
                        if (fq == 0) ex[((((wr * 2 + wc) * 2 + ai) * 4 + m) * 2 + bj) * 16 + fr] = ss; }
        } else {
            const int col0 = u.pn * 256 + wc * 32 + 8 * fq;
#pragma unroll
            for (int ai = 0; ai < 2; ++ai)
#pragma unroll
                for (int m = 0; m < 4; ++m) { bf16* rowp = KV + (size_t)(rowb + ai * 128 + m * 16) * 1024 + col0;
#pragma unroll
                    for (int bj = 0; bj < 2; ++bj) { const pg8::f32x4 v0 = acc[ai][bj][m][0], v1 = acc[ai][bj][m][1];
                        v4u w; w.x = pk2(v0[0], v0[1]); w.y = pk2(v0[2], v0[3]); w.z = pk2(v1[0], v1[1]); w.w = pk2(v1[2], v1[3]);
                        pg8::st_wt16(rowp + bj * 128, w); } }
        }
        asm volatile("s_waitcnt lgkmcnt(0)" ::: "memory"); __builtin_amdgcn_s_barrier(); asm volatile("" ::: "memory");
        const bool prompt = u.pm < MP / 256;
        if (!prompt && u.pm != MR / 256) return;
        const int d0 = kpart ? 32 * wc + 8 * fq : 64 + 8 * fq;
        const int nrep = prompt ? 1 : NB;
        const int bjr = wc & 1;
        const LAS float* exr = ex + wr * 512 + fr;
        float ksv[2][4];
#pragma unroll
        for (int ai = 0; ai < 2; ++ai)
#pragma unroll
            for (int m = 0; m < 4; ++m) ksv[ai][m] = kss[rowb + ai * 128 + m * 16];
#pragma unroll
        for (int ai = 0; ai < 2; ++ai) {
            const pg8::f32x4 g0 = *(const GAS pg8::f32x4*)(g + d0), g1 = *(const GAS pg8::f32x4*)(g + d0 + 4);
            pg8::f32x4 kp[4][2];
            if (!kpart) {
#pragma unroll
                for (int m = 0; m < 4; ++m) { const float* kr = kper + (size_t)(rowb + ai * 128 + m * 16) * QKR + 8 * fq; kp[m][0] = *(const GAS pg8::f32x4*)kr; kp[m][1] = *(const GAS pg8::f32x4*)(kr + 4); }
            }
#pragma unroll
            for (int m = 0; m < 4; ++m) { const int row = rowb + ai * 128 + m * 16;
                const bool rv = prompt || row < MR + NMETA;
                const float ks = ksv[ai][m];
                const int kofs = (prompt ? ((row >> 11) * TPP + NMETA + (row & 2047)) : (row - MR)) * 768 + 2 * u.pn * QKH + d0;
                if (kpart) {
#pragma unroll
                    for (int bj = 0; bj < 2; ++bj) {
                        const float tot = exr[(ai * 4 + m) * 32 + bj * 16] + exr[256 + (ai * 4 + m) * 32 + bj * 16] + ks;
                        const float rs = __builtin_amdgcn_rsqf(tot * (1.f / QKH) + EPS);
                        const pg8::f32x4 v0 = acc[ai][bj][m][0] * rs * g0, v1 = acc[ai][bj][m][1] * rs * g1;
                        v4u w; w.x = pk2(v0[0], v0[1]); w.y = pk2(v0[2], v0[3]); w.z = pk2(v1[0], v1[1]); w.w = pk2(v1[2], v1[3]);
                        if (rv) for (int b = 0; b < nrep; ++b) *(GAS v4u*)(K + (size_t)(kofs + bj * QKH) + (size_t)b * (TPP * 768)) = w; }
                } else {
                    const float tot = exr[(ai * 4 + m) * 32 + bjr * 16] + exr[256 + (ai * 4 + m) * 32 + bjr * 16] + ks;
                    const float rs = __builtin_amdgcn_rsqf(tot * (1.f / QKH) + EPS);
                    const pg8::f32x4 v0 = kp[m][0] * rs * g0, v1 = kp[m][1] * rs * g1;
                    v4u w; w.x = pk2(v0[0], v0[1]); w.y = pk2(v0[2], v0[3]); w.z = pk2(v1[0], v1[1]); w.w = pk2(v1[2], v1[3]);
                    if (rv) for (int b = 0; b < nrep; ++b) *(GAS v4u*)(K + (size_t)(kofs + bjr * QKH) + (size_t)b * (TPP * 768)) = w;
                }
            }
            asm volatile("" ::: "memory");
        }
    }
};

__global__ void __launch_bounds__(NWAVES * 64, 2) hymba_fwd(Params P) {
    extern __shared__ __attribute__((aligned(16))) unsigned char lds_raw[];
    Frame F;
    F.lds = (LAS unsigned char*)lds_raw;
    F.MISC = (volatile LAS unsigned*)(F.lds + MISC_OFF);
    F.tid = threadIdx.x; F.lane = F.tid & 63; F.wave = __builtin_amdgcn_readfirstlane(F.tid >> 6);
    F.G = gridDim.x; F.gw = blockIdx.x * NWAVES + F.wave; F.NGW = F.G * NWAVES;
    unsigned char* ws = P.ws;
    F.ctl = (gu32*)(ws + WS_CTL);
    for (int u = F.tid; u < (LDS_BYTES - LDSCTL_OFF) / 4; u += NWAVES * 64) ((LAS unsigned*)(F.lds + LDSCTL_OFF))[u] = 0u;
    __syncthreads();
    const bool multi = (P.ph_hi - P.ph_lo) > 1;
    XcdBarrier bar; bar.bar = (unsigned*)(F.ctl + CW_BAR); bar.x = 0; bar.st = nullptr;
    if (multi) bar = xcd_barrier_post((unsigned*)(F.ctl + CW_BAR), F.MISC + 8);
    const int lo = P.ph_lo, hi = P.ph_hi;
#define REFRESH() do { int t_ = threadIdx.x; asm volatile("" : "+v"(t_)); F.tid = t_; F.lane = t_ & 63; F.wave = __builtin_amdgcn_readfirstlane(t_ >> 6); F.gw = blockIdx.x * NWAVES + F.wave; } while (0)
#ifndef PHM
#define PHM 0x7ff
#endif
#ifndef PROBE_REP
#define PROBE_REP 0
#endif
#define DUP(k) (IN(k) && ((PROBE_REP >> (k)) & 1))
#define IN(k) (((PHM >> (k)) & 1) && lo <= (k) && (k) < hi)
#define SEAM(k) do { if (IN(k) && IN((k) + 1)) xcd_barrier(bar); } while (0)

    if (IN(0)) { REFRESH(); p0_prologue(P, F); } if (DUP(0)) { REFRESH(); p0_prologue(P, F); } SEAM(0);
    if (IN(1)) {
        pg8::Gemm g{(const bf16*)(ws + WS_XN), (const bf16*)(ws + WS_WIN), MP, 2048, DM}; pg8::StaticOrder S; S.init(MP, 2048, F.G, (int)blockIdx.x);
        pg8::EpiBf16<0> E{(bf16*)(ws + WS_Z), INWP, nullptr, 4};
        const bool early = ((blockIdx.x >> 3) & 1) != 0;
        if (early) { p1_leftover(P, F); __syncthreads(); REFRESH(); p0_late(P, F, F.gw, F.NGW); __syncthreads(); }
        pg8::gemm_phase<pg8::EpiBf16<0>, pg8::StaticOrder, true, true>(F.lds + RING_OFF, g, S, E);
        __syncthreads();
        if (!early) {
        p1_leftover(P, F);
        __syncthreads(); REFRESH(); p0_late(P, F, F.gw, F.NGW);
        }
    }
    SEAM(1);
    if (IN(2)) { REFRESH(); for (int r = F.gw; r < MALL; r += F.NGW) p2a_row(P, F, r); } if (DUP(2)) { REFRESH(); for (int r = F.gw; r < MALL; r += F.NGW) p2a_row(P, F, r); } SEAM(2);
    if (IN(3)) {
        { pg8::Gemm g{(const bf16*)(ws + WS_CQN), (const bf16*)(ws + WS_WUQ), MR, 768, QL}; pg8::StaticOrder S; S.init(MR, 768, F.G, (int)blockIdx.x);
          pg8::EpiBf16<0> E{(bf16*)(ws + WS_QRAW), 768, nullptr, 0};
          pg8::gemm_phase<pg8::EpiBf16<0>, pg8::StaticOrder, true, true>(F.lds + RING_OFF, g, S, E); }
        __syncthreads();
        { pg8::Gemm g{(const bf16*)(ws + WS_LATB), (const bf16*)(ws + WS_WUKV), MPAD, 1024, KVL}; pg8::StaticOrder S; S.init(MPAD, 1024, F.G, (int)((blockIdx.x + 58) % F.G));
          EpiKV E{(bf16*)(ws + WS_KVRAW), (bf16*)(ws + WS_K), (const float*)(ws + WS_KPER), (const float*)(ws + WS_KSS), P.k_norm_g, (LAS float*)(F.lds + RING_OFF + RING_BYTES)};
          pg8::gemm_phase<EpiKV, pg8::StaticOrder, true, true>(F.lds + RING_OFF, g, S, E); }
    }
    SEAM(4);
    if (IN(5)) { REFRESH(); p3_attention(P, F); } SEAM(5);
    if (IN(6)) { REFRESH();
        { const int i = (int)blockIdx.x * 512 + F.tid; if (i < MP) { const f32x4 a = ((const GAS f32x4*)(ws + WS_SSQ))[2 * i], c = ((const GAS f32x4*)(ws + WS_SSQ))[2 * i + 1];
            ((float*)(ws + WS_RSA))[i] = 1.0f / sqrtf(((a.x + a.y) + (a.z + a.w) + (c.x + c.y) + (c.z + c.w)) * (1.f / AW) + EPS); } }
        p4a_sample(P, F); } SEAM(6);
    if (IN(7)) {
        pg8::Gemm g{(const bf16*)(ws + WS_MIX), (const bf16*)(ws + WS_WO), MP, DM, DM}; pg8::StaticOrder S; S.init(MP, DM, F.G, (int)blockIdx.x);
        pg8::EpiF32ResX E{P.x_prompt, (bf16*)(ws + WS_XN), (float*)(ws + WS_ROWSS), DM, (const float*)(ws + WS_RSA)};
        const bool early = ((blockIdx.x >> 3) & 1) != 0;
        if (early) skinny_res_n1024<true>(F, (const bf16*)(ws + WS_MIX) + (size_t)MP * DM, DM, (const bf16*)(ws + WS_WO), DM, P.x_sample, nullptr, (bf16*)(ws + WS_XN) + (size_t)MP * DM, (float*)(ws + WS_ROWSS) + MP);
        pg8::gemm_phase<pg8::EpiF32ResX, pg8::StaticOrder, true, true>(F.lds + RING_OFF, g, S, E);
        __syncthreads();
        if (!early) skinny_res_n1024<true>(F, (const bf16*)(ws + WS_MIX) + (size_t)MP * DM, DM, (const bf16*)(ws + WS_WO), DM, P.x_sample, nullptr, (bf16*)(ws + WS_XN) + (size_t)MP * DM, (float*)(ws + WS_ROWSS) + MP);
    }
    SEAM(7);
    if (IN(9)) {
        pg8::Gemm g{(const bf16*)(ws + WS_XN), (const bf16*)(ws + WS_WUP), MP, DFF, DM}; pg8::StaticOrder S; S.init(MP, DFF, F.G, (int)blockIdx.x);
        pg8::EpiBf16<2> E{(bf16*)(ws + WS_H), DFF, (const float*)(ws + WS_ROWSS), 12};
        const bool early = ((blockIdx.x >> 3) & 1) != 0;
        if (early) { skinny_up(F, (const bf16*)(ws + WS_XN) + (size_t)MP * DM, (const bf16*)(ws + WS_WUP), (bf16*)(ws + WS_H) + (size_t)MP * DFF, (const float*)(ws + WS_ROWSS) + MP); __syncthreads(); }
        pg8::gemm_phase<pg8::EpiBf16<2>, pg8::StaticOrder, true, true>(F.lds + RING_OFF, g, S, E);
        __syncthreads();
        if (!early) skinny_up(F, (const bf16*)(ws + WS_XN) + (size_t)MP * DM, (const bf16*)(ws + WS_WUP), (bf16*)(ws + WS_H) + (size_t)MP * DFF, (const float*)(ws + WS_ROWSS) + MP);
    }
    SEAM(9);
    if (IN(10)) {
        pg8::Gemm g{(const bf16*)(ws + WS_H), (const bf16*)(ws + WS_WDN), MP, DM, DFF}; pg8::StaticOrder S; S.init(MP, DM, F.G, (int)blockIdx.x);
        pg8::EpiF32ResB E{(const bf16*)(ws + WS_XN), P.out + O_YP, DM};
        const bool early = ((blockIdx.x >> 3) & 1) != 0;
        if (early) skinny_res_n1024<false>(F, (const bf16*)(ws + WS_H) + (size_t)MP * DFF, DFF, (const bf16*)(ws + WS_WDN), DFF, nullptr, P.out + O_YS, (bf16*)(ws + WS_XN) + (size_t)MP * DM, nullptr);
        pg8::gemm_phase<pg8::EpiF32ResB, pg8::StaticOrder, true, true>(F.lds + RING_OFF, g, S, E);
        __syncthreads();
        if (!early) skinny_res_n1024<false>(F, (const bf16*)(ws + WS_H) + (size_t)MP * DFF, DFF, (const bf16*)(ws + WS_WDN), DFF, nullptr, P.out + O_YS, (bf16*)(ws + WS_XN) + (size_t)MP * DM, nullptr);
    }
#undef IN
#undef SEAM
}

extern "C" void kernel_launch(void* const* d_in, const int* in_sizes, int n_in, void* d_out, int out_size, void* d_ws, size_t ws_size, hipStream_t stream) {
    static int grid = 0;
    if (grid == 0) {
        if (n_in != 23 || (size_t)out_size != O_END || ws_size < WS_END) { fprintf(stderr, "kernel_launch: unexpected shapes (n_in %d out %d ws %zu)\n", n_in, out_size, ws_size); grid = -1; return; }
        int dev = 0, cus = 0, per_cu = 0;
        if (hipGetDevice(&dev) != hipSuccess || hipDeviceGetAttribute(&cus, hipDeviceAttributeMultiprocessorCount, dev) != hipSuccess) { grid = -1; return; }
        if (hipFuncSetAttribute((const void*)hymba_fwd, hipFuncAttributeMaxDynamicSharedMemorySize, LDS_BYTES) != hipSuccess) { fprintf(stderr, "kernel_launch: hipFuncSetAttribute failed\n"); grid = -1; return; }
        if (hipOccupancyMaxActiveBlocksPerMultiprocessor(&per_cu, (const void*)hymba_fwd, NWAVES * 64, LDS_BYTES) != hipSuccess || per_cu < 1) fprintf(stderr, "kernel_launch: occupancy query reports %d\n", per_cu);
        (void)hipGetLastError();
        grid = cus;
    }
    if (grid < 0) return;
    if (hipMemsetAsync((char*)d_ws + WS_CTL, 0, CTL_ZERO_BYTES, stream) != hipSuccess) return;
    Params p{};
    p.x_prompt = (const float*)d_in[0]; p.x_sample = (const float*)d_in[1]; p.cache_lat = (const float*)d_in[2]; p.cache_kpe = (const float*)d_in[3]; p.state_conv = (const float*)d_in[4];
    p.page_table = (const int*)d_in[5]; p.meta = (const float*)d_in[6]; p.norm_mix_g = (const float*)d_in[7]; p.w_in = (const float*)d_in[8]; p.q_lora_g = (const float*)d_in[9];
    p.kv_lora_g = (const float*)d_in[10]; p.w_uq = (const float*)d_in[11]; p.w_ukv = (const float*)d_in[12]; p.q_norm_g = (const float*)d_in[13]; p.k_norm_g = (const float*)d_in[14];
    p.conv_w = (const float*)d_in[15]; p.conv_b = (const float*)d_in[16]; p.attn_out_g = (const float*)d_in[17]; p.conv_out_g = (const float*)d_in[18]; p.w_o = (const float*)d_in[19];
    p.norm_ffn_g = (const float*)d_in[20]; p.w_up = (const float*)d_in[21]; p.w_down = (const float*)d_in[22];
    p.out = (float*)d_out; p.ws = (unsigned char*)d_ws;
#if MK_N_LAUNCHES == 1
    p.ph_lo = 0; p.ph_hi = N_PHASES; p.li = 0; p.pad = 0;
    hipLaunchKernelGGL(hymba_fwd, dim3(grid), dim3(NWAVES * 64), LDS_BYTES, stream, p);
#else
    for (int li = 0; li < N_PHASES; ++li) { p.ph_lo = li; p.ph_hi = li + 1; p.li = li; p.pad = 0;
        hipLaunchKernelGGL(hymba_fwd, dim3(grid), dim3(NWAVES * 64), LDS_BYTES, stream, p); }
#endif
}
```

```cpp
#include <hip/hip_runtime.h>
#include <cstdio>
#include <cstdint>
namespace pg8 {
#define PG8_LAS __attribute__((address_space(3)))
typedef unsigned short bf16_t;
typedef short bf16x8 __attribute__((ext_vector_type(8)));
typedef float f32x4 __attribute__((ext_vector_type(4)));
typedef unsigned u32x4 __attribute__((ext_vector_type(4)));
constexpr int BM = 256, BK = 64, HALF = 128, HTB = HALF * BK * 2  , STAGE_BYTES = 8 * HTB, NXCD = 8, WGM = 8;

__host__ __device__ __forceinline__ int lds_byte(int r, int c) { const int st = (r >> 4) * 2 + (c >> 5), rr = r & 15, cc = c & 31, ob = rr * 64 + cc * 2; return st * 1024 + (ob ^ (((ob >> 9) & 1) << 5)); }
__host__ __device__ __forceinline__ void stage_rc(int b, int& R, int& C) { const int st = b / 1024, sb = b % 1024, swz = sb ^ (((sb >> 9) & 1) << 5); R = (st >> 1) * 16 + swz / 64; C = (st & 1) * 32 + (swz % 64) / 2; }
__host__ __device__ __forceinline__ int perm32(int rho) { const int n = rho >> 4, i = rho & 15; return 8 * (i >> 2) + 4 * n + (i & 3); }

struct Unit { int pm, pn; };
struct Gemm { const bf16_t* A; const bf16_t* Bt; int M, N, K; };

struct StaticOrder {
    int nM, nN, nwg, G, c;
    __host__ __device__ void init(int M, int N, int G_, int c_) { nM = M / BM; nN = N / BM; nwg = nM * nN; G = G_; c = c_; }
    __host__ __device__ bool next(int i, Unit& u) const {
        const long L = (long)i * G + c; if (L >= nwg) return false;
        int wgid = (int)L; { const int q = nwg / NXCD, r = nwg % NXCD, xcd = wgid % NXCD, off = wgid / NXCD; wgid = (xcd < r ? xcd * (q + 1) : r * (q + 1) + (xcd - r) * q) + off; }
        const int nig = WGM * nN, gid = wgid / nig, fm = gid * WGM, gsz = (nM - fm) < WGM ? (nM - fm) : WGM;
        u.pm = fm + ((wgid % nig) % gsz); u.pn = (wgid % nig) / gsz; return true;
    }
    __device__ __forceinline__ void a_ready(const Unit&) const {}
    __device__ __forceinline__ void done(const Unit&) const {}
};


__device__ __forceinline__ unsigned cvt_pk_bf16(float lo, float hi) { unsigned r; asm volatile("v_cvt_pk_bf16_f32 %0, %1, %2" : "=v"(r) : "v"(lo), "v"(hi)); return r; }

__device__ __forceinline__ void st_wt16(void* p, u32x4 v) { asm volatile("global_store_dwordx4 %0, %1, off sc1\n\ts_nop 1" :: "v"(p), "v"(v) : "memory"); }
template <int ACT  > struct EpiBf16 {
    static constexpr bool PERM = true, AFTER_DRAIN = false, HAS_MID = false;
    bf16_t* O; int ldc; const float* rowss; int wt_pn;
    __device__ __forceinline__ void operator()(const f32x4 (&acc)[2][2][4][2], const Unit& u, int wr, int wc, int fr, int fq) const {
        const int row0 = u.pm * BM + wr * 64 + fr; const int col0 = u.pn * BM + wc * 32 + 8 * fq;
        float rs8[2][4];
#pragma unroll
        for (int ai = 0; ai < 2; ++ai)
#pragma unroll
            for (int m = 0; m < 4; ++m) rs8[ai][m] = rowss ? rowss[row0 + ai * HALF + m * 16] : 0.f;
#pragma unroll
        for (int ai = 0; ai < 2; ++ai)
#pragma unroll
            for (int m = 0; m < 4; ++m) { bf16_t* rowp = O + (size_t)(row0 + ai * HALF + m * 16) * ldc + col0;
                const float rsc = rowss ? __builtin_amdgcn_rsqf(rs8[ai][m] * (1.0f / 1024.0f) + 1e-6f) : 1.0f;
#pragma unroll
                for (int bj = 0; bj < 2; ++bj) { f32x4 v0 = acc[ai][bj][m][0] * rsc, v1 = acc[ai][bj][m][1] * rsc;
                    if (ACT == 2) {
#pragma unroll
                        for (int e = 0; e < 4; ++e) { const float a = v0[e] > 0.f ? v0[e] : 0.f, b = v1[e] > 0.f ? v1[e] : 0.f; v0[e] = a * a; v1[e] = b * b; } }
                    u32x4 w; w.x = cvt_pk_bf16(v0[0], v0[1]); w.y = cvt_pk_bf16(v0[2], v0[3]); w.z = cvt_pk_bf16(v1[0], v1[1]); w.w = cvt_pk_bf16(v1[2], v1[3]);
                    if (u.pn >= wt_pn) st_wt16(rowp + bj * HALF, w); else *(u32x4*)(rowp + bj * HALF) = w; } }
    }
};
struct EpiF32Res {
    static constexpr bool PERM = false, AFTER_DRAIN = false, HAS_MID = false;
    const float* base; const float* base2; int split_row; float* out; int ldc;
    __device__ __forceinline__ void operator()(const f32x4 (&acc)[2][2][4][2], const Unit& u, int wr, int wc, int fr, int fq) const {
        const int col0 = u.pn * BM + wc * 32 + 4 * fq;
#pragma unroll
        for (int ai = 0; ai < 2; ++ai) {
            f32x4 pre[4][2][2];
#pragma unroll
            for (int m = 0; m < 4; ++m) { const int r = u.pm * BM + ai * HALF + wr * 64 + m * 16 + fr;
                const float* bp = (r < split_row) ? base + (size_t)r * ldc : base2 + (size_t)(r - split_row) * ldc;
#pragma unroll
                for (int bj = 0; bj < 2; ++bj)
#pragma unroll
                    for (int n = 0; n < 2; ++n) pre[m][bj][n] = *(const f32x4*)(bp + col0 + bj * HALF + n * 16); }
            asm volatile("" ::: "memory");
#pragma unroll
            for (int m = 0; m < 4; ++m) { const int r = u.pm * BM + ai * HALF + wr * 64 + m * 16 + fr; float* op = out + (size_t)r * ldc;
#pragma unroll
                for (int bj = 0; bj < 2; ++bj)
#pragma unroll
                    for (int n = 0; n < 2; ++n) *(f32x4*)(op + col0 + bj * HALF + n * 16) = pre[m][bj][n] + acc[ai][bj][m][n]; }
            asm volatile("" ::: "memory");
        }
    }
};
struct EpiF32ResX {
    static constexpr bool PERM = false, AFTER_DRAIN = false, HAS_MID = true;
    const float* base; bf16_t* xb; float* rowss; int ldc; const float* rsa;
    __device__ __forceinline__ void mid(f32x4 (&acc)[2][2][4][2], const Unit& u, int t, int wr, int fr) const {
        if (t != 8) return;
        float rs[2][4];
#pragma unroll
        for (int ai = 0; ai < 2; ++ai)
#pragma unroll
            for (int m = 0; m < 4; ++m) rs[ai][m] = rsa[u.pm * BM + ai * HALF + wr * 64 + m * 16 + fr];
#pragma unroll
        for (int ai = 0; ai < 2; ++ai)
#pragma unroll
            for (int bj = 0; bj < 2; ++bj)
#pragma unroll
                for (int m = 0; m < 4; ++m)
#pragma unroll
                    for (int n = 0; n < 2; ++n) acc[ai][bj][m][n] = acc[ai][bj][m][n] * rs[ai][m];
    }
    __device__ __forceinline__ void operator()(const f32x4 (&acc)[2][2][4][2], const Unit& u, int wr, int wc, int fr, int fq) const {
        const int col0 = u.pn * BM + wc * 32 + 4 * fq;
        typedef unsigned u32x2 __attribute__((ext_vector_type(2)));
#pragma unroll
        for (int ai = 0; ai < 2; ++ai) {
            f32x4 pre[4][2][2];
#pragma unroll
            for (int m = 0; m < 4; ++m) { const int r = u.pm * BM + ai * HALF + wr * 64 + m * 16 + fr; const float* bp = base + (size_t)r * ldc;
#pragma unroll
                for (int bj = 0; bj < 2; ++bj)
#pragma unroll
                    for (int n = 0; n < 2; ++n) pre[m][bj][n] = __builtin_nontemporal_load((const f32x4*)(bp + col0 + bj * HALF + n * 16)); }
            asm volatile("" ::: "memory");
#pragma unroll
            for (int m = 0; m < 4; ++m) { const int r = u.pm * BM + ai * HALF + wr * 64 + m * 16 + fr;
                bf16_t* xp = xb + (size_t)r * ldc; float ss = 0.f;
#pragma unroll
                for (int bj = 0; bj < 2; ++bj)
#pragma unroll
                    for (int n = 0; n < 2; ++n) { const int c = col0 + bj * HALF + n * 16; const f32x4 x1 = pre[m][bj][n] + acc[ai][bj][m][n];
                        ss += (x1[0] * x1[0] + x1[1] * x1[1]) + (x1[2] * x1[2] + x1[3] * x1[3]);
                        u32x2 w; w.x = cvt_pk_bf16(x1[0], x1[1]); w.y = cvt_pk_bf16(x1[2], x1[3]); *(u32x2*)(xp + c) = w; }
                { auto r16 = __builtin_amdgcn_permlane16_swap(__float_as_uint(ss), __float_as_uint(ss), false, false); ss = __uint_as_float(r16[0]) + __uint_as_float(r16[1]);
                  auto r32 = __builtin_amdgcn_permlane32_swap(__float_as_uint(ss), __float_as_uint(ss), false, false); ss = __uint_as_float(r32[0]) + __uint_as_float(r32[1]); }
                if (fq == 0) atomicAdd(rowss + r, ss); }
            asm volatile("" ::: "memory");
        }
    }
};

struct EpiF32ResB {
    static constexpr bool PERM = false, AFTER_DRAIN = false, HAS_MID = false;
    const bf16_t* xb; float* out; int ldc;
    __device__ __forceinline__ void operator()(const f32x4 (&acc)[2][2][4][2], const Unit& u, int wr, int wc, int fr, int fq) const {
        const int col0 = u.pn * BM + wc * 32 + 4 * fq;
        typedef unsigned u32x2 __attribute__((ext_vector_type(2)));
#pragma unroll
        for (int ai = 0; ai < 2; ++ai) {
            u32x2 pre[4][2][2];
#pragma unroll
            for (int m = 0; m < 4; ++m) { const int r = u.pm * BM + ai * HALF + wr * 64 + m * 16 + fr; const bf16_t* bp = xb + (size_t)r * ldc;
#pragma unroll
                for (int bj = 0; bj < 2; ++bj)
#pragma unroll
                    for (int n = 0; n < 2; ++n) pre[m][bj][n] = __builtin_nontemporal_load((const u32x2*)(bp + col0 + bj * HALF + n * 16)); }
            asm volatile("" ::: "memory");
#pragma unroll
            for (int m = 0; m < 4; ++m) { const int r = u.pm * BM + ai * HALF + wr * 64 + m * 16 + fr; float* op = out + (size_t)r * ldc;
#pragma unroll
                for (int bj = 0; bj < 2; ++bj)
#pragma unroll
                    for (int n = 0; n < 2; ++n) { const u32x2 p = pre[m][bj][n];
                        const f32x4 x1 = (f32x4){__uint_as_float(p.x << 16), __uint_as_float(p.x & 0xffff0000u), __uint_as_float(p.y << 16), __uint_as_float(p.y & 0xffff0000u)};
                        __builtin_nontemporal_store(x1 + acc[ai][bj][m][n], (f32x4*)(op + col0 + bj * HALF + n * 16)); } }
            asm volatile("" ::: "memory");
        }
    }
};

template <class Epi, class Sched, bool ALIGN_EPI = false, bool SP2 = false>
__device__ __forceinline__ void gemm_phase(PG8_LAS unsigned char* lds, const Gemm g, const Sched& S, const Epi& E) {
    int tid_l = threadIdx.x; asm volatile("" : "+v"(tid_l));
    const int tid = tid_l, wid = __builtin_amdgcn_readfirstlane(tid >> 6), lane = tid & 63, wr = wid >> 2, wc = wid & 3, fr = lane & 15, fq = lane >> 4;
    const int K = g.K, nt = K / BK;
    unsigned voffA[2], voffB[2];
#pragma unroll
    for (int i = 0; i < 2; ++i) { int R, C; stage_rc(tid * 16 + i * 8192, R, C); const int Rb = Epi::PERM ? ((R & ~31) + perm32(R & 31)) : R;
        voffA[i] = (unsigned)(R * K + C) * 2u; voffB[i] = (unsigned)(Rb * K + C) * 2u; }
    const size_t kstep = (size_t)(BK * 2);
    const size_t hstep = (size_t)HALF * K * 2;
    const size_t tstep = 2 * hstep;
    const unsigned ldsw = (unsigned)wid * 1024u;
    const int aoff = lds_byte(wr * 64 + fr, fq * 8), boff = lds_byte(wc * 32 + fr, fq * 8);
#define PG8_SA(b, h) (((b) * 2 + (h)) * HTB)
#define PG8_SB(b, h) ((4 + (b) * 2 + (h)) * HTB)
#define PG8_STAGE(bufoff, gbase, voff) do { _Pragma("unroll") for (int _i = 0; _i < 2; ++_i) \
        __builtin_amdgcn_global_load_lds((const unsigned*)((const char*)(gbase) + (voff)[_i]), (PG8_LAS unsigned*)(lds + (bufoff) + ldsw + _i * 8192), 16, 0, 0); } while (0)
#define PG8_LDA(dst, b, h) do { _Pragma("unroll") for (int m = 0; m < 4; ++m) _Pragma("unroll") for (int k = 0; k < 2; ++k) dst[m][k] = *(const PG8_LAS bf16x8*)(lds + PG8_SA(b, h) + aoff + m * 2048 + k * 1024); } while (0)
#define PG8_LDB(dst, b, h) do { _Pragma("unroll") for (int n = 0; n < 2; ++n) _Pragma("unroll") for (int k = 0; k < 2; ++k) dst[n][k] = *(const PG8_LAS bf16x8*)(lds + PG8_SB(b, h) + boff + n * 2048 + k * 1024); } while (0)
#define PG8_MMA(ai, bj, At, Bt) do { __builtin_amdgcn_s_setprio(1); _Pragma("unroll") for (int m = 0; m < 4; ++m) _Pragma("unroll") for (int n = 0; n < 2; ++n) _Pragma("unroll") for (int k = 0; k < 2; ++k) \
        acc[ai][bj][m][n] = __builtin_amdgcn_mfma_f32_16x16x32_bf16(Bt[n][k], At[m][k], acc[ai][bj][m][n], 0, 0, 0); __builtin_amdgcn_s_setprio(0); } while (0)
#define PG8_WAIT_V(n) asm volatile("s_waitcnt vmcnt(" #n ")" ::: "memory")
#define PG8_WAIT_L(n) asm volatile("s_waitcnt lgkmcnt(" #n ")" ::: "memory")
#define PG8_BAR __builtin_amdgcn_s_barrier()
#define PG8_SCHED __builtin_amdgcn_sched_barrier(0)
    Unit cur, nxt; int ui = 0;
    if (!S.next(0, cur)) return;
    f32x4 acc[2][2][4][2];
#pragma unroll
    for (int a = 0; a < 2; ++a)
#pragma unroll
        for (int b = 0; b < 2; ++b)
#pragma unroll
            for (int m = 0; m < 4; ++m)
#pragma unroll
                for (int n = 0; n < 2; ++n) acc[a][b][m][n] = (f32x4){0.f, 0.f, 0.f, 0.f};
    bf16x8 At[4][2], B0[2][2], B1[2][2];
    const char* cA = (const char*)g.A + (size_t)cur.pm * tstep; const char* cB = (const char*)g.Bt + (size_t)cur.pn * tstep;
    S.a_ready(cur);
    if constexpr (SP2) {
        PG8_STAGE(PG8_SB(0, 0), cB, voffB); PG8_STAGE(PG8_SB(0, 1), cB + hstep, voffB); PG8_STAGE(PG8_SA(0, 0), cA, voffA); PG8_STAGE(PG8_SA(0, 1), cA + hstep, voffA);
        if (wr == 1) PG8_BAR;
        PG8_WAIT_V(2); PG8_BAR;
        PG8_STAGE(PG8_SB(1, 0), cB + kstep, voffB); PG8_STAGE(PG8_SA(1, 0), cA + kstep, voffA); PG8_STAGE(PG8_SB(1, 1), cB + hstep + kstep, voffB);
        PG8_WAIT_V(6); PG8_BAR;
    } else {
        PG8_STAGE(PG8_SB(0, 0), cB, voffB); PG8_STAGE(PG8_SA(0, 0), cA, voffA); PG8_STAGE(PG8_SB(0, 1), cB + hstep, voffB); PG8_STAGE(PG8_SA(0, 1), cA + hstep, voffA);
        if (wr == 1) PG8_BAR;
        PG8_WAIT_V(4); PG8_BAR;
        PG8_STAGE(PG8_SB(1, 0), cB + kstep, voffB); PG8_STAGE(PG8_SA(1, 0), cA + kstep, voffA); PG8_STAGE(PG8_SB(1, 1), cB + hstep + kstep, voffB);
        PG8_WAIT_V(6); PG8_BAR;
    }
    for (;;) {
        const bool has_next = S.next(ui + 1, nxt);
        const char* nA = has_next ? (const char*)g.A + (size_t)nxt.pm * tstep : cA; const char* nB = has_next ? (const char*)g.Bt + (size_t)nxt.pn * tstep : cB;
        for (int t = 0; t < nt; t += 2) {
            const bool last = (t == nt - 2);
            const char* a1 = cA + (size_t)(t + 1) * kstep;
            const char* a2 = last ? nA : cA + (size_t)(t + 2) * kstep; const char* b2 = last ? nB : cB + (size_t)(t + 2) * kstep;
            const char* a3 = a2 + kstep; const char* b3 = b2 + kstep;
            if (last && has_next) S.a_ready(nxt);
            if constexpr (Epi::HAS_MID) E.mid(acc, cur, t, wr, fr);
            if constexpr (SP2) {
            PG8_LDB(B0, 0, 0); PG8_LDB(B1, 0, 1); PG8_SCHED; PG8_LDA(At, 0, 0); PG8_STAGE(PG8_SA(1, 1), a1 + hstep, voffA);
            PG8_WAIT_V(8); PG8_WAIT_L(0); PG8_BAR; PG8_MMA(0, 0, At, B0); PG8_MMA(0, 1, At, B1); PG8_BAR; PG8_SCHED;
            PG8_LDA(At, 0, 1); PG8_STAGE(PG8_SB(0, 0), b2, voffB); PG8_STAGE(PG8_SB(0, 1), b2 + hstep, voffB); PG8_STAGE(PG8_SA(0, 0), a2, voffA);
            PG8_WAIT_V(8); PG8_WAIT_L(0); PG8_BAR; PG8_MMA(1, 0, At, B0); PG8_MMA(1, 1, At, B1); PG8_BAR; PG8_SCHED;
            PG8_LDB(B0, 1, 0); PG8_LDB(B1, 1, 1); PG8_SCHED; PG8_LDA(At, 1, 0); PG8_STAGE(PG8_SA(0, 1), a2 + hstep, voffA);
            PG8_WAIT_V(8); PG8_WAIT_L(0); PG8_BAR; PG8_MMA(0, 0, At, B0); PG8_MMA(0, 1, At, B1); PG8_BAR; PG8_SCHED;
            PG8_LDA(At, 1, 1); PG8_STAGE(PG8_SB(1, 0), b3, voffB); PG8_STAGE(PG8_SB(1, 1), b3 + hstep, voffB); PG8_STAGE(PG8_SA(1, 0), a3, voffA);
            PG8_WAIT_V(8); PG8_WAIT_L(0); PG8_BAR; PG8_MMA(1, 0, At, B0); PG8_MMA(1, 1, At, B1); PG8_BAR; PG8_SCHED;
            } else {
            PG8_LDB(B0, 0, 0); PG8_SCHED; PG8_LDA(At, 0, 0); PG8_STAGE(PG8_SA(1, 1), a1 + hstep, voffA);
            PG8_WAIT_L(8); PG8_BAR; PG8_WAIT_L(0); PG8_MMA(0, 0, At, B0); PG8_BAR; PG8_SCHED;
            PG8_LDB(B1, 0, 1); PG8_STAGE(PG8_SB(0, 0), b2, voffB);
            PG8_BAR; PG8_WAIT_L(0); PG8_MMA(0, 1, At, B1); PG8_BAR;
            PG8_LDA(At, 0, 1); PG8_STAGE(PG8_SA(0, 0), a2, voffA);
            PG8_BAR; PG8_WAIT_L(0); PG8_MMA(1, 0, At, B0); PG8_BAR; PG8_SCHED;
            PG8_STAGE(PG8_SB(0, 1), b2 + hstep, voffB);
            PG8_WAIT_V(6); PG8_BAR; PG8_MMA(1, 1, At, B1); PG8_BAR;
            PG8_LDB(B0, 1, 0); PG8_SCHED; PG8_LDA(At, 1, 0); PG8_STAGE(PG8_SA(0, 1), a2 + hstep, voffA);
            PG8_WAIT_L(8); PG8_BAR; PG8_WAIT_L(0); PG8_MMA(0, 0, At, B0); PG8_BAR; PG8_SCHED;
            PG8_LDB(B1, 1, 1); PG8_STAGE(PG8_SB(1, 0), b3, voffB);
            PG8_BAR; PG8_WAIT_L(0); PG8_MMA(0, 1, At, B1); PG8_BAR;
            PG8_LDA(At, 1, 1); PG8_STAGE(PG8_SA(1, 0), a3, voffA);
            PG8_BAR; PG8_WAIT_L(0); PG8_MMA(1, 0, At, B0); PG8_BAR; PG8_SCHED;
            PG8_STAGE(PG8_SB(1, 1), b3 + hstep, voffB);
            PG8_WAIT_V(6); PG8_BAR; PG8_MMA(1, 1, At, B1); PG8_BAR;
            }
        }
        if constexpr (ALIGN_EPI) { if (wr == 0) PG8_BAR; }
        if constexpr (!Epi::AFTER_DRAIN) { E(acc, cur, wr, wc, fr, fq); S.done(cur); }
        if (!has_next) break;
#pragma unroll
        for (int a = 0; a < 2; ++a)
#pragma unroll
            for (int b = 0; b < 2; ++b)
#pragma unroll
                for (int m = 0; m < 4; ++m)
#pragma unroll
                    for (int n = 0; n < 2; ++n) acc[a][b][m][n] = (f32x4){0.f, 0.f, 0.f, 0.f};
        cur = nxt; cA = nA; cB = nB; ++ui;
        if constexpr (ALIGN_EPI) { if (wr == 1) PG8_BAR; }
    }
    PG8_WAIT_V(0);
    if constexpr (!ALIGN_EPI) { if (wr == 0) PG8_BAR; }
    PG8_BAR;
    if constexpr (Epi::AFTER_DRAIN) { E.fused(acc, cur, wr, wc, fr, fq, lds, wid, lane); S.done(cur); }
#undef PG8_SA
#undef PG8_SB
#undef PG8_STAGE
#undef PG8_LDA
#undef PG8_LDB
#undef PG8_MMA
#undef PG8_WAIT_V
#undef PG8_WAIT_L
#undef PG8_BAR
#undef PG8_SCHED
}
}

#ifndef MK_N_LAUNCHES
#define MK_N_LAUNCHES 1
#endif
constexpr int N_PHASES = 11;
constexpr int NWAVES = 8;

constexpr int DM = 1024, NB = 8, SEQ = 2048, NMETA = 16, TP = SEQ + NMETA  , DB = 128, DS = 4, PAST = 8192, PAGE = 128, NPAGES = 64;
constexpr int NH = 8, QKN = 64, QKR = 32, VH = 64, QKH = 96, QL = 384, KVL = 256, AW = 512, CC = 512, DFF = 4096;
constexpr int INW = 2208, INWP = 2304;
constexpr int MP = NB * SEQ;
constexpr int MS = DB * DS;
constexpr int MR = MP + MS;
constexpr int MMETA0 = MR;
constexpr int MALL = MR + NMETA;
constexpr int MPAD = 17152;
constexpr int TPP = 2112;
constexpr float EPS = 1e-6f;
constexpr float QSCALE = 0.10206207261596577f * 1.4426950408889634f;
constexpr int SA_NS = 2;

constexpr size_t O_YP = 0, O_YS = O_YP + (size_t)MP * DM, O_LATP = O_YS + (size_t)MS * DM, O_KPEP = O_LATP + (size_t)NB * TP * KVL, O_CONVP = O_KPEP + (size_t)NB * TP * QKR,
                 O_LATS = O_CONVP + (size_t)NB * 2 * CC, O_KPES = O_LATS + (size_t)MS * KVL, O_CONVS = O_KPES + (size_t)MS * QKR, O_END = O_CONVS + (size_t)DB * 2 * CC;

constexpr size_t MiB = 1u << 20;
constexpr size_t WS_CTL = 0, CTL_ZERO_BYTES = 1 * MiB;
constexpr size_t WS_ROWSS = 512 * 1024;
constexpr size_t WS_WIN = 2 * MiB;
constexpr size_t WS_WUQ = 7 * MiB;
constexpr size_t WS_WUKV = 8 * MiB;
constexpr size_t WS_WUKVB = 9 * MiB;
constexpr size_t WS_WF8 = 9 * MiB + 512 * 1024;
constexpr size_t WS_WO = 10 * MiB;
constexpr size_t WS_WUP = 12 * MiB;
constexpr size_t WS_WDN = 20 * MiB;
constexpr size_t WS_ROPE = 28 * MiB;
constexpr size_t WS_XN = 32 * MiB;
constexpr size_t WS_Z = 68 * MiB;
constexpr size_t WS_CQN = 146 * MiB;
constexpr size_t WS_LATB = 160 * MiB;
constexpr size_t WS_KPER = 170 * MiB;
constexpr size_t WS_QRAW = 174 * MiB;
constexpr size_t WS_KVRAW = 200 * MiB;
constexpr size_t WS_Q = 236 * MiB;
constexpr size_t WS_SSQ = 236 * MiB;
constexpr size_t WS_KSS = 238 * MiB;
constexpr size_t WS_RSA = 237 * MiB;
constexpr size_t WS_K = 262 * MiB;
constexpr size_t WS_V = 288 * MiB;
constexpr size_t WS_MIX = 306 * MiB;
constexpr size_t WS_PART = 342 * MiB;
constexpr size_t WS_LPART = 360 * MiB;
constexpr size_t WS_NEWLAT = 352 * MiB;
constexpr size_t WS_NEWKPE = 357 * MiB;
constexpr size_t WS_H = WS_Z;
constexpr size_t WS_END = 500 * MiB;
constexpr int CW_BAR = 4096;

constexpr int RING_OFF = 0, RING_BYTES = 131072;
constexpr int LDS_BYTES = 163840;
constexpr int LDSCTL_OFF = LDS_BYTES - 512, MISC_OFF = LDSCTL_OFF + 320;

#define GAS __attribute__((address_space(1)))
#define LAS __attribute__((address_space(3)))
typedef unsigned short bf16;
typedef unsigned v4u __attribute__((ext_vector_type(4)));
typedef unsigned v2u __attribute__((ext_vector_type(2)));
typedef float f32x4 __attribute__((ext_vector_type(4)));
typedef float f32x16 __attribute__((ext_vector_type(16)));
typedef short bf16x8 __attribute__((ext_vector_type(8)));
typedef short s16x4 __attribute__((ext_vector_type(4)));
typedef GAS unsigned gu32;
#define RLX_AGENT __ATOMIC_RELAXED, __HIP_MEMORY_SCOPE_AGENT
#define LDS_WAIT() asm volatile("s_waitcnt lgkmcnt(0)" ::: "memory")
#define VM_WAIT() asm volatile("s_waitcnt vmcnt(0)" ::: "memory")
typedef float f32x2_t __attribute__((ext_vector_type(2))); typedef __bf16 bf16x2_t __attribute__((ext_vector_type(2)));
#define NTS(v, p) __builtin_nontemporal_store((v), (p))
#define NTL(p) __builtin_nontemporal_load(p)
__device__ __forceinline__ unsigned pk2(float lo, float hi) { f32x2_t v = {lo, hi}; bf16x2_t b = __builtin_convertvector(v, bf16x2_t); return __builtin_bit_cast(unsigned, b); }
__device__ __forceinline__ float bflo(unsigned w) { return __uint_as_float(w << 16); }
__device__ __forceinline__ float bfhi(unsigned w) { return __uint_as_float(w & 0xffff0000u); }
__device__ __forceinline__ void unpack8(const v4u x, float (&e)[8]) { e[0] = bflo(x.x); e[1] = bfhi(x.x); e[2] = bflo(x.y); e[3] = bfhi(x.y); e[4] = bflo(x.z); e[5] = bfhi(x.z); e[6] = bflo(x.w); e[7] = bfhi(x.w); }
__device__ __forceinline__ v4u pack8(const float (&e)[8]) { v4u o; o.x = pk2(e[0], e[1]); o.y = pk2(e[2], e[3]); o.z = pk2(e[4], e[5]); o.w = pk2(e[6], e[7]); return o; }
__device__ __forceinline__ float bf1(bf16 b) { return __uint_as_float((unsigned)b << 16); }
#define XB_TMO      128
#define XB_XCNT(j)  (256  + 64 * (j))
#define XB_XSUB(j)  (1280 + 64 * (j))
#define XB_XGEN(j)  (2304 + 64 * (j))
#define XB_TOP      3328
#define XB_TOPGEN   3392
#define XCD_BAR_WORDS 3456
#define XB_SPIN_CAP (1u << 18)

__device__ __forceinline__ unsigned xb_ld(unsigned* p)              { return __hip_atomic_load(p, __ATOMIC_RELAXED, __HIP_MEMORY_SCOPE_AGENT); }
__device__ __forceinline__ unsigned xb_add(unsigned* p, unsigned v) { return __hip_atomic_fetch_add(p, v, __ATOMIC_RELAXED, __HIP_MEMORY_SCOPE_AGENT); }
__device__ __forceinline__ unsigned xb_xcc_id() { return (unsigned)__builtin_amdgcn_s_getreg((3 << 11) | 20) & 0xFu; }
#define XB_SPIN(cond, bar) do { unsigned _sp = 0; while (cond) { __builtin_amdgcn_s_sleep(1); \
    if ((++_sp & 255u) == 0u) { if (xb_ld(&(bar)[XB_TMO])) break; if (_sp > XB_SPIN_CAP) { atomicAdd(&(bar)[XB_TMO], 1u); break; } } } } while (0)

struct XcdBarrier {
    unsigned* bar; unsigned x;
    volatile LAS unsigned* st;
};

__device__ __forceinline__ XcdBarrier xcd_barrier_post(unsigned* bar, volatile LAS unsigned* st) {
    XcdBarrier b; b.bar = bar; b.x = xb_xcc_id(); b.st = st;
    if (threadIdx.x == 0) (void)xb_add(&bar[XB_XCNT(b.x)], 1u);
    return b;
}
__device__ __forceinline__ void xcd_barrier_complete(unsigned* bar, unsigned x, unsigned& nloc, unsigned& nx) {
    const unsigned G = gridDim.x * gridDim.y * gridDim.z;
    unsigned sum, cnt, mine, sp = 0u;
    for (;;) {
        sum = 0u; cnt = 0u; mine = 0u;
#pragma unroll
        for (unsigned j = 0; j < 16; ++j) { const unsigned c = xb_ld(&bar[XB_XCNT(j)]); sum += c; cnt += (c > 0u) ? 1u : 0u; mine = (j == x) ? c : mine; }
        if (sum == G) break;
        __builtin_amdgcn_s_sleep(1);
        if ((++sp & 255u) == 0u) { if (xb_ld(&bar[XB_TMO])) break; if (sp > XB_SPIN_CAP) { atomicAdd(&bar[XB_TMO], 1u); break; } }
    }
    nloc = mine > 0u ? mine : 1u; nx = cnt > 0u ? cnt : 1u;
}

__device__ __forceinline__ void xcd_barrier(const XcdBarrier& b) {
    asm volatile("s_waitcnt vmcnt(0)" ::: "memory");
    __syncthreads();
    if (threadIdx.x == 0) {
        unsigned* bar = b.bar;
        __builtin_amdgcn_s_waitcnt(0);
        unsigned nloc = b.st[0], nx = b.st[1];
        if (nloc == 0u) { xcd_barrier_complete(bar, b.x, nloc, nx); b.st[0] = nloc; b.st[1] = nx; }
        const unsigned old = xb_add(&bar[XB_XSUB(b.x)], 1u);
        const unsigned gen = old / nloc;
        if (old + 1u == (gen + 1u) * nloc) {
            __builtin_amdgcn_fence(__ATOMIC_RELEASE, "agent");
            asm volatile("s_waitcnt vmcnt(0)" ::: "memory");
            const unsigned og = xb_add(&bar[XB_TOP], 1u);
            const unsigned tg = og / nx;
            if (og + 1u == (tg + 1u) * nx) xb_add(&bar[XB_TOPGEN], 1u);
            else XB_SPIN(xb_ld(&bar[XB_TOPGEN]) == tg, bar);
            __builtin_amdgcn_fence(__ATOMIC_ACQUIRE, "agent");
            xb_add(&bar[XB_XGEN(b.x)], 1u);
            asm volatile("s_waitcnt vmcnt(0)" ::: "memory");
        } else {
            XB_SPIN(xb_ld(&bar[XB_XGEN(b.x)]) == gen, bar);
            __builtin_amdgcn_fence(__ATOMIC_ACQUIRE, "agent");
            asm volatile("s_waitcnt vmcnt(0)" ::: "memory");
        }
    }
    __syncthreads();
}

struct Params {
    const float* x_prompt; const float* x_sample; const float* cache_lat; const float* cache_kpe; const float* state_conv; const int* page_table; const float* meta;
    const float* norm_mix_g; const float* w_in; const float* q_lora_g; const float* kv_lora_g; const float* w_uq; const float* w_ukv; const float* q_norm_g; const float* k_norm_g;
    const float* conv_w; const float* conv_b; const float* attn_out_g; const float* conv_out_g; const float* w_o; const float* norm_ffn_g; const float* w_up; const float* w_down;
    float* out; unsigned char* ws; int ph_lo, ph_hi, li, pad;
};
struct Frame {
    LAS unsigned char* lds;
    volatile LAS unsigned* MISC;
    gu32* ctl;
    int tid, lane, wave, G, gw, NGW;
};
__device__ __forceinline__ float wave_sum(float v) {
#pragma unroll
    for (int o = 1; o < 64; o <<= 1) v += __shfl_xor(v, o);
    return v;
}

__device__ __forceinline__ void p0_transpose_item(const float* W, int K, int N, bf16* WT, LAS float* scr, int item, int lane, const float* kscale = nullptr, int klim = 1 << 30) {
    const int nblk = N / 32, kb = item / nblk, nb = item % nblk, k0 = 64 * kb, n0 = 32 * nb;
#pragma unroll 16
    for (int i = 0; i < 32; ++i) { const int kk = 2 * i + (lane >> 5); scr[kk * 33 + (lane & 31)] = NTL(&W[(size_t)(k0 + kk) * N + n0 + (lane & 31)]) * ((kscale && k0 < klim) ? kscale[k0 + kk] : 1.0f); }
    LDS_WAIT(); asm volatile("" ::: "memory");
    const int c = lane & 7;
#pragma unroll
    for (int j = 0; j < 4; ++j) { const int n = (lane >> 3) + 8 * j; const LAS float* s = scr + (8 * c) * 33 + n;
        v4u o; o.x = pk2(s[0 * 33], s[1 * 33]); o.y = pk2(s[2 * 33], s[3 * 33]); o.z = pk2(s[4 * 33], s[5 * 33]); o.w = pk2(s[6 * 33], s[7 * 33]);
        *(GAS v4u*)(WT + (size_t)(n0 + n) * K + k0 + 8 * c) = o; }
    LDS_WAIT(); asm volatile("" ::: "memory");
}
__device__ __forceinline__ void rms_row_to_bf16(const float* xrow, const float* g, bf16* orow, int lane) {
    const GAS f32x4* xr = (const GAS f32x4*)xrow + lane; const GAS f32x4* gr = (const GAS f32x4*)g + lane;
    f32x4 v[4]; float s = 0.f;
#pragma unroll
    for (int j = 0; j < 4; ++j) { v[j] = NTL(xr + 64 * j); s += (v[j].x * v[j].x + v[j].y * v[j].y) + (v[j].z * v[j].z + v[j].w * v[j].w); }
    const float rs = 1.0f / sqrtf(wave_sum(s) * (1.f / DM) + EPS);
    GAS v2u* o8 = (GAS v2u*)orow + lane;
#pragma unroll
    for (int j = 0; j < 4; ++j) { const f32x4 gg = gr[64 * j]; v2u w; w.x = pk2(v[j].x * rs * gg.x, v[j].y * rs * gg.y); w.y = pk2(v[j].z * rs * gg.z, v[j].w * rs * gg.w); o8[64 * j] = w; }
}
__device__ __forceinline__ void p0_prologue(const Params& P, Frame& F) {
    unsigned char* ws = P.ws;
    LAS float* scr = (LAS float*)(F.lds + RING_OFF + F.wave * 16384);
    constexpr int I_IN = (DM / 64) * (INW / 32);
    for (int it = F.gw; it < I_IN; it += F.NGW) p0_transpose_item(P.w_in, DM, INW, (bf16*)(ws + WS_WIN), scr, it, F.lane);
    const int gt = F.gw * 64 + F.lane, NGT = F.NGW * 64;
    for (int i = gt; i < 96 * 128; i += NGT) ((GAS v4u*)(ws + WS_WIN + (size_t)INW * DM * 2))[i] = (v4u){0u, 0u, 0u, 0u};
    for (int i = gt; i < (MPAD - MALL) * DM / 8; i += NGT) ((GAS v4u*)(ws + WS_XN + (size_t)MALL * DM * 2))[i] = (v4u){0u, 0u, 0u, 0u};
    bf16* XN = (bf16*)(ws + WS_XN);
    {
        const int lane = F.lane;
        f32x4 gg[4];
#pragma unroll
        for (int j = 0; j < 4; ++j) gg[j] = ((const GAS f32x4*)P.norm_mix_g)[lane + 64 * j];
#define P0_SRC(m) (((m) < MP) ? P.x_prompt + (size_t)(m) * DM : ((m) < MR) ? P.x_sample + (size_t)((m) - MP) * DM : P.meta + (size_t)((m) - MR) * DM)
        int m = F.gw;
        f32x4 vn[4];
        if (m < MALL) { const GAS f32x4* xr = (const GAS f32x4*)P0_SRC(m) + lane;
#pragma unroll
            for (int j = 0; j < 4; ++j) vn[j] = NTL(xr + 64 * j); }
        while (m < MALL) {
            f32x4 v[4];
#pragma unroll
            for (int j = 0; j < 4; ++j) v[j] = vn[j];
            const int m2 = m + F.NGW;
            if (m2 < MALL) { const GAS f32x4* xr = (const GAS f32x4*)P0_SRC(m2) + lane;
#pragma unroll
                for (int j = 0; j < 4; ++j) vn[j] = NTL(xr + 64 * j); }
            float ss = 0.f;
#pragma unroll
            for (int j = 0; j < 4; ++j) ss += (v[j].x * v[j].x + v[j].y * v[j].y) + (v[j].z * v[j].z + v[j].w * v[j].w);
            const float rs = 1.0f / sqrtf(wave_sum(ss) * (1.f / DM) + EPS);
            GAS v2u* o8 = (GAS v2u*)(XN + (size_t)m * DM) + lane;
#pragma unroll
            for (int j = 0; j < 4; ++j) { v2u w; w.x = pk2(v[j].x * rs * gg[j].x, v[j].y * rs * gg[j].y); w.y = pk2(v[j].z * rs * gg[j].z, v[j].w * rs * gg[j].w); o8[64 * j] = w; }
            m = m2;
        }
#undef P0_SRC
    }
}
__device__ __forceinline__ void p0_late(const Params& P, Frame& F, int wv, int nwv) {
    unsigned char* ws = P.ws;
    LAS float* scr = (LAS float*)(F.lds + RING_OFF + F.wave * 16384);
    constexpr int I_UQ = (QL / 64) * (768 / 32), I_UKV = (KVL / 64) * (1024 / 32), I_O = (DM / 64) * (DM / 32), I_UP = (DM / 64) * (DFF / 32), I_DN = (DFF / 64) * (DM / 32);
    constexpr int NITEMS = I_UQ + I_UKV + I_O + I_UP + I_DN;
    for (int it = wv; it < NITEMS; it += nwv) {
        int r = it;
        if (r < I_UQ) { p0_transpose_item(P.w_uq, QL, 768, (bf16*)(ws + WS_WUQ), scr, r, F.lane); continue; } r -= I_UQ;
        if (r < I_UKV) { p0_transpose_item(P.w_ukv, KVL, 1024, (bf16*)(ws + WS_WUKV), scr, r, F.lane); continue; } r -= I_UKV;
        if (r < I_O) { p0_transpose_item(P.w_o, DM, DM, (bf16*)(ws + WS_WO), scr, r, F.lane, P.attn_out_g, AW); continue; } r -= I_O;
        if (r < I_UP) { p0_transpose_item(P.w_up, DM, DFF, (bf16*)(ws + WS_WUP), scr, r, F.lane, P.norm_ffn_g); continue; } r -= I_UP;
        p0_transpose_item(P.w_down, DFF, DM, (bf16*)(ws + WS_WDN), scr, r, F.lane);
    }
    const int gt = wv * 64 + F.lane, NGT = nwv * 64;
    for (int i = gt; i < KVL * 1024 / 8; i += NGT) { const f32x4 a = ((const GAS f32x4*)P.w_ukv)[2 * i], b = ((const GAS f32x4*)P.w_ukv)[2 * i + 1];
        v4u o; o.x = pk2(a.x, a.y); o.y = pk2(a.z, a.w); o.z = pk2(b.x, b.y); o.w = pk2(b.z, b.w); ((GAS v4u*)(ws + WS_WUKVB))[i] = o; }
    for (int i = gt; i < 512 * 64; i += NGT) { const int n = i >> 6, c4 = i & 63, col = (n >> 6) * 128 + (n & 63); const float* wp = P.w_ukv + (size_t)(4 * c4) * 1024 + col;
        int w = 0; w = __builtin_amdgcn_cvt_pk_fp8_f32(16.f * wp[0], 16.f * wp[1024], w, false); w = __builtin_amdgcn_cvt_pk_fp8_f32(16.f * wp[2048], 16.f * wp[3072], w, true);
        ((int*)(ws + WS_WF8))[i] = w; }
    for (int i = gt; i < 2068 * 16; i += NGT) { const int p = i >> 4, f = i & 15; const double pos = (p < TP) ? (double)p : (double)(PAST + (p - TP));
        const double f4 = (f & 3) == 0 ? 1.0 : (f & 3) == 1 ? 5.62341325190349072827e-01 : (f & 3) == 2 ? 3.16227766016837941176e-01 : 1.77827941003892292526e-01;
        const double dec = (f >> 2) == 0 ? 1.0 : (f >> 2) == 1 ? 1e-1 : (f >> 2) == 2 ? 1e-2 : 1e-3;
        const double ang = pos * (f4 * dec); const double kq = rint(ang * 0.15915494309189533577); const double rr = fma(-kq, 6.283185307179586232, ang) - kq * 2.4492935982947064e-16;
        const float rf = (float)rr;
        ((float*)(ws + WS_ROPE))[i] = cosf(rf); ((float*)(ws + WS_ROPE))[2068 * 16 + i] = sinf(rf); }
    for (int i = gt; i < NB * (TPP - TP) * 768 / 8; i += NGT) { const int b = i / ((TPP - TP) * 96), r = i % ((TPP - TP) * 96); ((GAS v4u*)(ws + WS_K + ((size_t)(b * TPP + TP) * 768) * 2))[r] = (v4u){0u, 0u, 0u, 0u}; }
    for (int i = gt; i < DB * 32 * KVL / 4; i += NGT) ((GAS f32x4*)(ws + WS_NEWLAT))[i] = (f32x4){0.f, 0.f, 0.f, 0.f};
    for (int i = gt; i < DB * 32 * QKR / 4; i += NGT) ((GAS f32x4*)(ws + WS_NEWKPE))[i] = (f32x4){0.f, 0.f, 0.f, 0.f};
}

__device__ __forceinline__ void conv_u(const bf16* zrow, int lane, float (&u)[8]) {
    float a[8], b[8]; unpack8(*(const GAS v4u*)(zrow + 1184 + 8 * lane), a); unpack8(*(const GAS v4u*)(zrow + 1696 + 8 * lane), b);
#pragma unroll
    for (int i = 0; i < 8; ++i) u[i] = a[i] * b[i];
}
__device__ __forceinline__ void p2a_row(const Params& P, Frame& F, int r) {
    unsigned char* ws = P.ws; const int lane = F.lane;
    const bf16* Z = (const bf16*)(ws + WS_Z); const bf16* z = Z + (size_t)r * INWP;
    int kind, b, t, pidx;
    if (r < MP) { kind = 0; b = r >> 11; t = r & 2047; pidx = t + NMETA; }
    else if (r < MR) { kind = 1; b = (r - MP) >> 2; t = (r - MP) & 3; pidx = TP + t; }
    else { kind = 2; b = 0; t = r - MR; pidx = t; }
    const int l48p = lane < 48 ? lane : 0, l32p = lane & 31;
    const v4u zq_ = *(const GAS v4u*)(z + 8 * l48p), zk_ = *(const GAS v4u*)(z + 384 + 8 * l32p);
    const bf16 zp_ = z[640 + l32p];
    const float* rope_ = (const float*)(ws + WS_ROPE); const float rc_ = rope_[pidx * 16 + (l32p & 15)], rsn_ = rope_[2068 * 16 + pidx * 16 + (l32p & 15)];
    const f32x4 qg0_ = *(const GAS f32x4*)(P.q_lora_g + 8 * l48p), qg1_ = *(const GAS f32x4*)(P.q_lora_g + 8 * l48p + 4);
    const f32x4 kg0_ = *(const GAS f32x4*)(P.kv_lora_g + 8 * l32p), kg1_ = *(const GAS f32x4*)(P.kv_lora_g + 8 * l32p + 4);
    v4u zb_ = {0u, 0u, 0u, 0u}, zg0_ = zb_, zh0_ = zb_, zg1_ = zb_, zh1_ = zb_, zg2_ = zb_, zh2_ = zb_;
    f32x4 cb_[2], cw_[3][2], og_[2];
#pragma unroll
    for (int q = 0; q < 2; ++q) { cb_[q] = (f32x4){0.f, 0.f, 0.f, 0.f}; og_[q] = cb_[q]; cw_[0][q] = cb_[q]; cw_[1][q] = cb_[q]; cw_[2][q] = cb_[q]; }
    if (kind != 2) {
        zb_ = *(const GAS v4u*)(z + 672 + 8 * lane); zg0_ = *(const GAS v4u*)(z + 1184 + 8 * lane); zh0_ = *(const GAS v4u*)(z + 1696 + 8 * lane);
#pragma unroll
        for (int q = 0; q < 2; ++q) { cb_[q] = *(const GAS f32x4*)(P.conv_b + 8 * lane + 4 * q); og_[q] = *(const GAS f32x4*)(P.conv_out_g + 8 * lane + 4 * q);
            cw_[0][q] = *(const GAS f32x4*)(P.conv_w + 8 * lane + 4 * q); cw_[1][q] = *(const GAS f32x4*)(P.conv_w + CC + 8 * lane + 4 * q); cw_[2][q] = *(const GAS f32x4*)(P.conv_w + 2 * CC + 8 * lane + 4 * q); }
        if (kind == 0) {
            const bf16* z1 = (t >= 1) ? z - INWP : Z + (size_t)(MMETA0 + 15) * INWP;
            const bf16* z2 = (t >= 2) ? z - 2 * INWP : Z + (size_t)(MMETA0 + 14 + t) * INWP;
            zg1_ = *(const GAS v4u*)(z1 + 1184 + 8 * lane); zh1_ = *(const GAS v4u*)(z1 + 1696 + 8 * lane); zg2_ = *(const GAS v4u*)(z2 + 1184 + 8 * lane); zh2_ = *(const GAS v4u*)(z2 + 1696 + 8 * lane);
        }
    }
    if (kind != 2) {
        float v[8]; unpack8(zq_, v);
        float ss = 0.f;
#pragma unroll
        for (int i = 0; i < 8; ++i) ss += v[i] * v[i];
        if (lane >= 48) ss = 0.f;
        const float rs = 1.0f / sqrtf(wave_sum(ss) * (1.f / QL) + EPS);
        if (lane < 48) { const f32x4 g0 = qg0_, g1 = qg1_;
            float o[8] = {v[0] * rs * g0.x, v[1] * rs * g0.y, v[2] * rs * g0.z, v[3] * rs * g0.w, v[4] * rs * g1.x, v[5] * rs * g1.y, v[6] * rs * g1.z, v[7] * rs * g1.w};
            *(GAS v4u*)((bf16*)(ws + WS_CQN) + (size_t)r * QL + 8 * lane) = pack8(o); }
    }
    {
        float v[8]; unpack8(zk_, v);
        float ss = 0.f;
#pragma unroll
        for (int i = 0; i < 8; ++i) ss += v[i] * v[i];
        if (lane >= 32) ss = 0.f;
        const float rs = 1.0f / sqrtf(wave_sum(ss) * (1.f / KVL) + EPS);
        if (lane < 32) { const f32x4 g0 = kg0_, g1 = kg1_;
            float o[8] = {v[0] * rs * g0.x, v[1] * rs * g0.y, v[2] * rs * g0.z, v[3] * rs * g0.w, v[4] * rs * g1.x, v[5] * rs * g1.y, v[6] * rs * g1.z, v[7] * rs * g1.w};
            *(GAS v4u*)((bf16*)(ws + WS_LATB) + (size_t)r * KVL + 8 * lane) = pack8(o);
            const f32x4 o0 = {o[0], o[1], o[2], o[3]}, o1 = {o[4], o[5], o[6], o[7]};
            if (kind == 0) { float* d = P.out + O_LATP + ((size_t)(b * TP + NMETA + t)) * KVL + 8 * lane; NTS(o0, (GAS f32x4*)d); NTS(o1, (GAS f32x4*)(d + 4)); }
            else if (kind == 1) { float* d = P.out + O_LATS + ((size_t)(b * DS + t)) * KVL + 8 * lane; NTS(o0, (GAS f32x4*)d); NTS(o1, (GAS f32x4*)(d + 4));
                float* d2 = (float*)(ws + WS_NEWLAT) + ((size_t)(b * 32 + t)) * KVL + 8 * lane; *(GAS f32x4*)d2 = o0; *(GAS f32x4*)(d2 + 4) = o1; }
            else { for (int bb = 0; bb < NB; ++bb) { float* d = P.out + O_LATP + ((size_t)(bb * TP + t)) * KVL + 8 * lane; NTS(o0, (GAS f32x4*)d); NTS(o1, (GAS f32x4*)(d + 4)); } }
        }
    }
    {
        const int l32 = lane & 31; const float x = bf1(zp_); const float xp = __shfl_xor(x, 16);
        const float c = rc_, s = rsn_;
        const float o = (l32 < 16) ? (x * c - xp * s) : (x * c + xp * s);
        { const float q2 = wave_sum(lane < 32 ? o * o : 0.f); if (lane == 0) ((float*)(ws + WS_KSS))[r] = q2; }
        if (lane < 32) {
            ((float*)(ws + WS_KPER))[(size_t)r * QKR + lane] = o;
            if (kind == 0) NTS(o, &P.out[O_KPEP + ((size_t)(b * TP + NMETA + t)) * QKR + lane]);
            else if (kind == 1) { P.out[O_KPES + ((size_t)(b * DS + t)) * QKR + lane] = o; ((float*)(ws + WS_NEWKPE))[((size_t)(b * 32 + t)) * QKR + lane] = o; }
            else { for (int bb = 0; bb < NB; ++bb) P.out[O_KPEP + ((size_t)(bb * TP + t)) * QKR + lane] = o; }
        }
    }
    if (kind != 2) {
        float u0[8], u1[8], u2[8];
        { float a_[8], b_[8]; unpack8(zg0_, a_); unpack8(zh0_, b_);
#pragma unroll
          for (int i = 0; i < 8; ++i) u0[i] = a_[i] * b_[i]; }
        if (kind == 0) { float a_[8], b_[8]; unpack8(zg1_, a_); unpack8(zh1_, b_);
#pragma unroll
            for (int i = 0; i < 8; ++i) u1[i] = a_[i] * b_[i];
            unpack8(zg2_, a_); unpack8(zh2_, b_);
#pragma unroll
            for (int i = 0; i < 8; ++i) u2[i] = a_[i] * b_[i];
        } else {
            const float* st = P.state_conv + (size_t)b * 2 * CC + 8 * lane;
            if (t >= 1) conv_u(z - INWP, lane, u1); else { const f32x4 a = *(const GAS f32x4*)(st + CC), c = *(const GAS f32x4*)(st + CC + 4); u1[0] = a.x; u1[1] = a.y; u1[2] = a.z; u1[3] = a.w; u1[4] = c.x; u1[5] = c.y; u1[6] = c.z; u1[7] = c.w; }
            if (t >= 2) conv_u(z - 2 * INWP, lane, u2); else { const float* s2 = st + (t == 1 ? CC : 0); const f32x4 a = *(const GAS f32x4*)(s2), c = *(const GAS f32x4*)(s2 + 4); u2[0] = a.x; u2[1] = a.y; u2[2] = a.z; u2[3] = a.w; u2[4] = c.x; u2[5] = c.y; u2[6] = c.z; u2[7] = c.w; }
        }
        float gb[8]; unpack8(zb_, gb);
        float co[8]; float ss = 0.f;
#pragma unroll
        for (int i = 0; i < 8; ++i) { const float y = cb_[i >> 2][i & 3] + cw_[0][i >> 2][i & 3] * u2[i] + cw_[1][i >> 2][i & 3] * u1[i] + cw_[2][i >> 2][i & 3] * u0[i]; co[i] = gb[i] * y; ss += co[i] * co[i]; }
        const float rs = 1.0f / sqrtf(wave_sum(ss) * (1.f / CC) + EPS);
#pragma unroll
        for (int i = 0; i < 8; ++i) co[i] = co[i] * rs * og_[i >> 2][i & 3];
        *(GAS v4u*)((bf16*)(ws + WS_MIX) + (size_t)r * DM + AW + 8 * lane) = pack8(co);
        const f32x4 o0 = {u0[0], u0[1], u0[2], u0[3]}, o1 = {u0[4], u0[5], u0[6], u0[7]};
        if (kind == 0 && t >= SEQ - 2) { float* d = P.out + O_CONVP + ((size_t)(b * 2 + (t - (SEQ - 2)))) * CC + 8 * lane; *(GAS f32x4*)d = o0; *(GAS f32x4*)(d + 4) = o1; }
        if (kind == 1 && t >= DS - 2) { float* d = P.out + O_CONVS + ((size_t)(b * 2 + (t - (DS - 2)))) * CC + 8 * lane; *(GAS f32x4*)d = o0; *(GAS f32x4*)(d + 4) = o1; }
    }
}

__device__ __forceinline__ void p2c_k_item8(const Params& P, LAS unsigned char* scr, int r0, int lane_in) {
    unsigned char* ws = P.ws; asm volatile("" : "+s"(ws)); int lane = lane_in; asm volatile("" : "+v"(lane));
    const GAS unsigned char* src = (const GAS unsigned char*)((const bf16*)(ws + WS_KVRAW) + (size_t)r0 * 1024);
    { v4u in[8];
#pragma unroll
      for (int j = 0; j < 8; ++j) { const int q = 64 * j + lane, bl = q >> 3, c = q & 7; in[j] = *(const GAS v4u*)(src + (size_t)bl * 256 + c * 16); }
#pragma unroll
      for (int j = 0; j < 8; ++j) { const int q = 64 * j + lane, bl = q >> 3, c = q & 7; *(LAS v4u*)(scr + bl * 128 + ((c ^ (bl & 7)) << 4)) = in[j]; } }
    const int r = r0 + (lane >> 3);
    f32x4 kr[8]; const float* kp = (const float*)(ws + WS_KPER) + (size_t)r * QKR;
#pragma unroll
    for (int c = 0; c < 8; ++c) kr[c] = *(const GAS f32x4*)(kp + 4 * c);
    LDS_WAIT(); asm volatile("" ::: "memory");
    v4u kw[8]; float ss = 0.f;
#pragma unroll
    for (int c = 0; c < 8; ++c) { kw[c] = *(const LAS v4u*)(scr + lane * 128 + ((c ^ (lane & 7)) << 4)); float e[8]; unpack8(kw[c], e);
#pragma unroll
        for (int i = 0; i < 8; ++i) ss += e[i] * e[i]; }
#pragma unroll
    for (int c = 0; c < 8; ++c) ss += (kr[c].x * kr[c].x + kr[c].y * kr[c].y) + (kr[c].z * kr[c].z + kr[c].w * kr[c].w);
    const float rs = 1.0f / sqrtf(ss * (1.f / QKH) + EPS);
    LAS unsigned char* kb = scr + lane * 192;
#pragma unroll
    for (int c = 0; c < 8; ++c) { float e[8]; unpack8(kw[c], e);
#pragma unroll
        for (int i = 0; i < 8; ++i) e[i] = e[i] * rs * P.k_norm_g[8 * c + i];
        *(LAS v4u*)(kb + 16 * c) = pack8(e); }
#pragma unroll
    for (int c = 0; c < 4; ++c) { float e[8] = {kr[2 * c].x, kr[2 * c].y, kr[2 * c].z, kr[2 * c].w, kr[2 * c + 1].x, kr[2 * c + 1].y, kr[2 * c + 1].z, kr[2 * c + 1].w};
#pragma unroll
        for (int i = 0; i < 8; ++i) e[i] = e[i] * rs * P.k_norm_g[64 + 8 * c + i];
        *(LAS v4u*)(kb + 128 + 16 * c) = pack8(e); }
    LDS_WAIT(); asm volatile("" ::: "memory");
    const bool meta = r0 >= MR; const int b0 = meta ? 0 : (r0 >> 11), b1 = meta ? NB : b0 + 1, tp0 = meta ? (r0 - MR) : (r0 & 2047) + NMETA;
    { v4u ko[12];
#pragma unroll
      for (int j = 0; j < 12; ++j) ko[j] = *(const LAS v4u*)(scr + (64 * j + lane) * 16);
      for (int b = b0; b < b1; ++b) { GAS v4u* kd = (GAS v4u*)((bf16*)(ws + WS_K) + ((size_t)(b * TPP + tp0)) * 768);
#pragma unroll
          for (int j = 0; j < 12; ++j) kd[64 * j + lane] = ko[j]; } }
    LDS_WAIT(); asm volatile("" ::: "memory");
}
__device__ __forceinline__ void p2c_phase(const Params& P, Frame& F) {
    LAS unsigned char* scr = F.lds + RING_OFF + F.wave * 16384;
    constexpr int NKV = (MP + NMETA) / 8;
    for (int it = F.gw; it < NKV; it += F.NGW) { int r0 = it * 8; if (r0 >= MP) r0 = MR + (r0 - MP); p2c_k_item8(P, scr, r0, F.lane); }
}

__device__ __forceinline__ void q_norm_frags(const Params& P, const bf16* qraw_head, int pidx, int hi, bf16x8 (&qf)[6]) {
    const float* rope = (const float*)(P.ws + WS_ROPE);
    float v[6][8];
#pragma unroll
    for (int s = 0; s < 6; ++s) unpack8(*(const GAS v4u*)(qraw_head + 16 * s + 8 * hi), v[s]);
    const f32x4 c0 = *(const GAS f32x4*)(rope + pidx * 16 + 8 * hi), c1 = *(const GAS f32x4*)(rope + pidx * 16 + 8 * hi + 4);
    const f32x4 s0 = *(const GAS f32x4*)(rope + 2068 * 16 + pidx * 16 + 8 * hi), s1 = *(const GAS f32x4*)(rope + 2068 * 16 + pidx * 16 + 8 * hi + 4);
    const float cs[8] = {c0.x, c0.y, c0.z, c0.w, c1.x, c1.y, c1.z, c1.w}, sn[8] = {s0.x, s0.y, s0.z, s0.w, s1.x, s1.y, s1.z, s1.w};
#pragma unroll
    for (int j = 0; j < 8; ++j) { const float x1 = v[4][j], x2 = v[5][j]; v[4][j] = x1 * cs[j] - x2 * sn[j]; v[5][j] = x2 * cs[j] + x1 * sn[j]; }
    float ss = 0.f;
#pragma unroll
    for (int s = 0; s < 6; ++s)
#pragma unroll
        for (int j = 0; j < 8; ++j) ss += v[s][j] * v[s][j];
    { auto rr = __builtin_amdgcn_permlane32_swap(__float_as_uint(ss), __float_as_uint(ss), false, false); ss = __uint_as_float(rr[0]) + __uint_as_float(rr[1]); }
    const float rs = QSCALE / sqrtf(ss * (1.f / QKH) + EPS);
#pragma unroll
    for (int s = 0; s < 6; ++s) { const f32x4 g0 = *(const GAS f32x4*)(P.q_norm_g + 16 * s + 8 * hi), g1 = *(const GAS f32x4*)(P.q_norm_g + 16 * s + 8 * hi + 4);
        float e[8] = {v[s][0] * rs * g0.x, v[s][1] * rs * g0.y, v[s][2] * rs * g0.z, v[s][3] * rs * g0.w, v[s][4] * rs * g1.x, v[s][5] * rs * g1.y, v[s][6] * rs * g1.z, v[s][7] * rs * g1.w};
        qf[s] = __builtin_bit_cast(bf16x8, pack8(e)); }
}
constexpr int PA_KS = 0, PA_KROW = 208, PA_VS = 64 * PA_KROW  , PA_VROW = 192, PA_BYTES = PA_VS + 64 * PA_VROW;
#define MFMA32(a, b, c) __builtin_amdgcn_mfma_f32_32x32x16_bf16((a), (b), (c), 0, 0, 0)
#define MFMA16(a, b, c) __builtin_amdgcn_mfma_f32_16x16x32_bf16((a), (b), (c), 0, 0, 0)
typedef short v4i16_t __attribute__((ext_vector_type(4)));
__device__ __forceinline__ s16x4 tr_read(const LAS unsigned char* p) { return __builtin_bit_cast(s16x4, __builtin_amdgcn_ds_read_tr16_b64_v4i16((LAS v4i16_t*)p)); }
__device__ __forceinline__ int crow(int r, int hi) { return (r & 3) + 8 * (r >> 2) + 4 * hi; }

__device__ __forceinline__ void pattn_unit(const Params& P, Frame& F, int b, int h, int qb) {
    unsigned char* ws = P.ws; LAS unsigned char* lds = F.lds;
    int tid_ = F.tid; asm volatile("" : "+v"(tid_));
    const int tid = tid_, lane = tid & 63, wave = F.wave, r32 = lane & 31, hi = lane >> 5;
    const int q0 = qb * 256 + wave * 32;
    const int qpos = NMETA + q0 + r32, wfirst = NMETA + q0, wlast = NMETA + q0 + 31;
    bf16x8 qf[6];
    q_norm_frags(P, (const bf16*)(ws + WS_QRAW) + (size_t)(b * SEQ + q0 + r32) * 768 + h * QKH, qpos, hi, qf);
    const int NT = 4 * qb + 5;
    f32x16 o0, o1;
#pragma unroll
    for (int r = 0; r < 16; ++r) { o0[r] = 0.f; o1[r] = 0.f; }
    float l = 0.f;
    const bf16* Kb = (const bf16*)(ws + WS_K) + (size_t)(b * TPP) * 768 + h * QKH;
    const bf16* Vraw = (const bf16*)(ws + WS_KVRAW) + h * 128 + 64;
#define PA_VROWP(tp_) (Vraw + (size_t)(((tp_) < NMETA) ? MR + (tp_) : b * SEQ + (tp_) - NMETA) * 1024)
    const int k0r = tid / 12, k0c = tid % 12, k1r = (tid + 512) / 12, k1c = (tid + 512) % 12, v0r = tid >> 3, v0c = tid & 7;
    v4u kr0, kr1 = (v4u){0u, 0u, 0u, 0u}, vr;
    {
        kr0 = *(const GAS v4u*)(Kb + (size_t)k0r * 768 + 8 * k0c); if (tid < 256) kr1 = *(const GAS v4u*)(Kb + (size_t)k1r * 768 + 8 * k1c); vr = *(const GAS v4u*)(PA_VROWP(v0r) + 8 * v0c);
    }
    const int blk = (lane >> 4) & 1, tq = (lane & 15) >> 2, tp = lane & 3;
    for (int j = 0; j < NT; ++j) {
        __syncthreads();
        *(LAS v4u*)(lds + PA_KS + k0r * PA_KROW + 16 * k0c) = kr0; if (tid < 256) *(LAS v4u*)(lds + PA_KS + k1r * PA_KROW + 16 * k1c) = kr1; *(LAS v4u*)(lds + PA_VS + v0r * PA_VROW + 16 * v0c) = vr;
        __syncthreads();
        if (j + 1 < NT) { const bf16* Kt = Kb + (size_t)(64 * (j + 1)) * 768;
            kr0 = *(const GAS v4u*)(Kt + (size_t)k0r * 768 + 8 * k0c); if (tid < 256) kr1 = *(const GAS v4u*)(Kt + (size_t)k1r * 768 + 8 * k1c); vr = *(const GAS v4u*)(PA_VROWP(64 * (j + 1) + v0r) + 8 * v0c); }
        if (64 * j <= wlast) {
            f32x16 p0, p1;
#pragma unroll
            for (int r = 0; r < 16; ++r) { p0[r] = 0.f; p1[r] = 0.f; }
#pragma unroll
            for (int s = 0; s < 6; ++s) {
                const bf16x8 a0 = *(const LAS bf16x8*)(lds + PA_KS + r32 * PA_KROW + 32 * s + 16 * hi);
                const bf16x8 a1 = *(const LAS bf16x8*)(lds + PA_KS + (r32 + 32) * PA_KROW + 32 * s + 16 * hi);
                p0 = MFMA32(a0, qf[s], p0); p1 = MFMA32(a1, qf[s], p1);
            }
            int need_mask = __builtin_amdgcn_readfirstlane((64 * j + 63 > wfirst) ? 1 : 0); asm volatile("" : "+s"(need_mask));
            float ls = 0.f;
#pragma unroll
            for (int r = 0; r < 16; ++r) { p0[r] = __builtin_amdgcn_exp2f(p0[r]); p1[r] = __builtin_amdgcn_exp2f(p1[r]); }
            if (need_mask) {
#pragma unroll
                for (int r = 0; r < 16; ++r) { const int kp = 64 * j + crow(r, hi); if (kp > qpos) p0[r] = 0.f; if (kp + 32 > qpos) p1[r] = 0.f; }
            }
#pragma unroll
            for (int r = 0; r < 16; ++r) ls += p0[r] + p1[r];
            l += ls;
            bf16x8 pf[4];
#pragma unroll
            for (int ks = 0; ks < 4; ++ks) { v4u w;
                if (ks < 2) { w.x = pk2(p0[8 * ks + 0], p0[8 * ks + 1]); w.y = pk2(p0[8 * ks + 2], p0[8 * ks + 3]); w.z = pk2(p0[8 * ks + 4], p0[8 * ks + 5]); w.w = pk2(p0[8 * ks + 6], p0[8 * ks + 7]); }
                else { const int k2 = ks - 2; w.x = pk2(p1[8 * k2 + 0], p1[8 * k2 + 1]); w.y = pk2(p1[8 * k2 + 2], p1[8 * k2 + 3]); w.z = pk2(p1[8 * k2 + 4], p1[8 * k2 + 5]); w.w = pk2(p1[8 * k2 + 6], p1[8 * k2 + 7]); }
                pf[ks] = __builtin_bit_cast(bf16x8, w); }
#pragma unroll
            for (int ks = 0; ks < 4; ++ks) {
#pragma unroll
                for (int db = 0; db < 2; ++db) {
                    const LAS unsigned char* base = lds + PA_VS + (16 * ks + 4 * hi + tq) * PA_VROW + (32 * db + 16 * blk + 4 * tp) * 2;
                    const s16x4 t0 = tr_read(base), t1 = tr_read(base + 8 * PA_VROW);
                    const bf16x8 a = (bf16x8){t0[0], t0[1], t0[2], t0[3], t1[0], t1[1], t1[2], t1[3]};
                    if (db == 0) o0 = MFMA32(a, pf[ks], o0); else o1 = MFMA32(a, pf[ks], o1);
                }
            }
        }
    }
    { auto rr = __builtin_amdgcn_permlane32_swap(__float_as_uint(l), __float_as_uint(l), false, false); l = __uint_as_float(rr[0]) + __uint_as_float(rr[1]); }
    const float inv = 1.0f / l;
    { float ss = 0.f;
#pragma unroll
      for (int r = 0; r < 16; ++r) { const float a = o0[r] * inv, c = o1[r] * inv; ss += a * a + c * c; }
      auto rr = __builtin_amdgcn_permlane32_swap(__float_as_uint(ss), __float_as_uint(ss), false, false); ss = __uint_as_float(rr[0]) + __uint_as_float(rr[1]);
      if (hi == 0) ((float*)(ws + WS_SSQ))[(size_t)(b * SEQ + q0 + r32) * NH + h] = ss; }
    bf16* Op = (bf16*)(ws + WS_MIX) + (size_t)(b * SEQ + q0 + r32) * DM + h * VH;
#pragma unroll
    for (int g = 0; g < 4; ++g) {
        v2u w0, w1; w0.x = pk2(o0[4 * g] * inv, o0[4 * g + 1] * inv); w0.y = pk2(o0[4 * g + 2] * inv, o0[4 * g + 3] * inv);
        w1.x = pk2(o1[4 * g] * inv, o1[4 * g + 1] * inv); w1.y = pk2(o1[4 * g + 2] * inv, o1[4 * g + 3] * inv);
        *(GAS v2u*)(Op + 8 * g + 4 * hi) = w0; *(GAS v2u*)(Op + 32 + 8 * g + 4 * hi) = w1;
    }
}

constexpr int SA_LT = 0, SA_LTB = 16384  , SA_KP = 65536, SA_KPB = 2048  , SA_KSQ = 73728, SA_KSB = 128,
              SA_F8 = 74240, SA_F8B = 8192  , SA_RS = 90624, SA_RSB = 1024  , SA_PL = 92672, SA_PLB = 2048, SA_PROW = 64  ,
              SA_QAL = 96768, SA_QROW = 576  , SA_LRED = 115200  , SA_BYTES = SA_LRED + 512;
static_assert(SA_BYTES <= LDSCTL_OFF, "sample attention LDS map");
__device__ __forceinline__ int sa_pi(int x) { return (0x1320 >> (4 * x)) & 3; }
__device__ __forceinline__ int sa_g(int key) { return ((key & 3) << 2) | sa_pi((key >> 2) & 3); }
__device__ __forceinline__ int sa_g8(int key) { return ((key & 3) << 2) | ((0x2310 >> (4 * ((key >> 2) & 3))) & 3); }
typedef int v8i __attribute__((ext_vector_type(8)));
#define MFMA_F8(a, b, c) __builtin_amdgcn_mfma_scale_f32_16x16x128_f8f6f4((a), (b), (c), 0, 0, 0, 0x7F7F7F7F, 0, 0x7F7F7F7F)

__device__ __forceinline__ void sattn_unit(const Params& P, Frame& F, int b, int sp) {
    unsigned char* ws = P.ws; asm volatile("" : "+s"(ws)); LAS unsigned char* lds = F.lds;
    int tid_ = F.tid; asm volatile("" : "+v"(tid_));
    int wave_ = F.wave; asm volatile("" : "+s"(wave_));
    const int tid = tid_, lane = tid & 63, wave = wave_, r32 = lane & 31, hi = lane >> 5, fr = lane & 15, fq = lane >> 4;
    const int h = wave, sg = wave & 1, skb = (wave >> 1) & 1, spar = wave >> 2;
    const int srow0 = MP + b * DS;
    __syncthreads();
    {
        bf16x8 qn[6];
        q_norm_frags(P, (const bf16*)(ws + WS_QRAW) + (size_t)(srow0 + (r32 & 3)) * 768 + h * QKH, TP + (r32 & 3), hi, qn);
        bf16x8 bq[4];
#pragma unroll
        for (int ks = 0; ks < 4; ++ks) {
            float e[8]; unpack8(__builtin_bit_cast(v4u, qn[ks]), e);
#pragma unroll
            for (int i = 0; i < 8; ++i) e[i] = (r32 < 4) ? e[i] * P.k_norm_g[16 * ks + 8 * hi + i] : 0.f;
            bq[ks] = __builtin_bit_cast(bf16x8, pack8(e));
        }
        const bf16* WB = (const bf16*)(ws + WS_WUKVB);
        const int lr = lane >> 3, lc = lane & 7;
        const GAS unsigned char* wp = (const GAS unsigned char*)(WB + (size_t)lr * 1024 + h * 128) + 16 * lc;
        LAS unsigned char* wimg = lds + SA_LT + wave * 4608;
#pragma unroll 1
        for (int half = 0; half < 2; ++half) {
        v4u ra[4][4];
#pragma unroll
        for (int q = 0; q < 4; ++q)
#pragma unroll
            for (int j = 0; j < 4; ++j) ra[q][j] = *(const GAS v4u*)(wp + (size_t)(32 * (4 * half + q) + 8 * j) * 2048);
#pragma unroll
        for (int q = 0; q < 4; ++q) { const int cb = 4 * half + q;
#pragma unroll
            for (int j = 0; j < 4; ++j) *(LAS v4u*)(wimg + (lr + 8 * j) * 144 + lc * 16) = ra[q][j];
            f32x16 acc;
#pragma unroll
            for (int r = 0; r < 16; ++r) acc[r] = 0.f;
#pragma unroll
            for (int ks = 0; ks < 4; ++ks) { const bf16x8 a = *(const LAS bf16x8*)(wimg + r32 * 144 + (2 * ks + hi) * 16); acc = MFMA32(a, bq[ks], acc); }
            if (r32 < 4) {
#pragma unroll
                for (int g = 0; g < 4; ++g) { v2u w; w.x = pk2(acc[4 * g], acc[4 * g + 1]); w.y = pk2(acc[4 * g + 2], acc[4 * g + 3]);
                    *(LAS v2u*)(lds + SA_QAL + (h * 4 + r32) * SA_QROW + (32 * cb + 8 * g + 4 * hi) * 2) = w; }
            }
        }
        }
        if (r32 < 4) {
            float e[8], f[8]; unpack8(__builtin_bit_cast(v4u, qn[4]), e); unpack8(__builtin_bit_cast(v4u, qn[5]), f);
#pragma unroll
            for (int i = 0; i < 8; ++i) { e[i] *= P.k_norm_g[64 + 8 * hi + i]; f[i] *= P.k_norm_g[80 + 8 * hi + i]; }
            *(LAS v4u*)(lds + SA_QAL + (h * 4 + r32) * SA_QROW + (256 + 8 * hi) * 2) = pack8(e);
            *(LAS v4u*)(lds + SA_QAL + (h * 4 + r32) * SA_QROW + (256 + 16 + 8 * hi) * 2) = pack8(f);
        }
    }
    __syncthreads();
    const LAS unsigned char* qaf = lds + SA_QAL + (16 * sg + fr) * SA_QROW + 16 * fq;
    v8i Wf[4][2];
    {
        const unsigned char* WF = (const unsigned char*)(ws + WS_WF8);
#pragma unroll
        for (int db = 0; db < 4; ++db)
#pragma unroll
            for (int st = 0; st < 2; ++st) { const GAS v4u* p = (const GAS v4u*)(WF + (size_t)(h * 64 + 16 * db + fr) * 256 + 128 * st + 32 * fq); const v4u lo = p[0], hi4 = p[1];
                Wf[db][st] = (v8i){(int)lo.x, (int)lo.y, (int)lo.z, (int)lo.w, (int)hi4.x, (int)hi4.y, (int)hi4.z, (int)hi4.w}; }
    }
#pragma unroll
    for (int db = 0; db < 4; ++db)
#pragma unroll
        for (int st = 0; st < 2; ++st) asm volatile("" : "+v"(Wf[db][st]));
    constexpr int NCD = (NPAGES / SA_NS) * 4;
    const int NC = NCD + ((sp == SA_NS - 1) ? 1 : 0);
    int ptv = P.page_table[b * NPAGES + sp * (NPAGES / SA_NS) + (lane & 31)]; asm volatile("" : "+v"(ptv));
    f32x4 st[4]; f32x2_t kst;
    int woff[4], foff[4], koff, ksoff;
#pragma unroll
    for (int j = 0; j < 4; ++j) { const int f = tid + 512 * j, key = f >> 6, c4 = f & 63;
        woff[j] = key * 512 + (((c4 >> 1) ^ sa_g(key)) << 4) + 8 * (c4 & 1); foff[j] = key * 256 + (((c4 >> 2) ^ sa_g8(key)) << 4) + 4 * (c4 & 3);
        asm volatile("" : "+v"(woff[j]), "+v"(foff[j])); }
    { const int key = tid >> 4, c2 = tid & 15; koff = key * 64 + (((c2 >> 2) ^ sa_pi((key >> 2) & 3)) << 4) + 4 * (c2 & 3); ksoff = key * 4; asm volatile("" : "+v"(koff), "+v"(ksoff)); }
    unsigned goff = (unsigned)tid * 16u; asm volatile("" : "+v"(goff));
    int nbase[2];
#pragma unroll
    for (int kb = 0; kb < 2; ++kb) { const int key = 16 * kb + fr; nbase[kb] = key * 256 + (((2 * fq) ^ sa_g8(key)) << 4); asm volatile("" : "+v"(nbase[kb])); }
#define SA_LOAD(ii) do { const int i_ = (ii); const int page = __builtin_amdgcn_readlane(ptv, (i_ >> 2) & 31); const size_t k0 = (size_t)page * PAGE + (i_ & 3) * 32; \
        const GAS unsigned char* gl = (const GAS unsigned char*)((i_ < NCD) ? P.cache_lat + k0 * KVL : (const float*)(ws + WS_NEWLAT) + (size_t)b * 32 * KVL); \
        const GAS unsigned char* gk_ = (const GAS unsigned char*)((i_ < NCD) ? P.cache_kpe + k0 * QKR : (const float*)(ws + WS_NEWKPE) + (size_t)b * 32 * QKR); \
        _Pragma("unroll") \
        for (int j = 0; j < 4; ++j) st[j] = __builtin_nontemporal_load((const GAS f32x4*)(gl + (size_t)(goff + 8192u * j))); \
        kst = __builtin_nontemporal_load((const GAS f32x2_t*)(gk_ + (size_t)(goff >> 1))); \
    } while (0)
#define DPP_ADD(v, ctrl) ((v) + __builtin_bit_cast(float, __builtin_amdgcn_update_dpp(0, __builtin_bit_cast(int, (v)), (ctrl), 0xf, 0xf, true)))
#define SA_WRITE(q4, q2) do { const int lo_ = (q4) * SA_LTB, fo_ = (q2) * SA_F8B, ko_ = (q4) * SA_KPB, so_ = (q4) * SA_KSB; \
        _Pragma("unroll") \
        for (int j = 0; j < 4; ++j) { \
            v2u w; w.x = pk2(st[j].x, st[j].y); w.y = pk2(st[j].z, st[j].w); \
            *(LAS v2u*)(lds + SA_LT + lo_ + woff[j]) = w; \
            int f8 = (int)w.x; f8 = __builtin_amdgcn_cvt_pk_fp8_f32(st[j].x, st[j].y, f8, false); f8 = __builtin_amdgcn_cvt_pk_fp8_f32(st[j].z, st[j].w, f8, true); \
            *(LAS int*)(lds + SA_F8 + fo_ + foff[j]) = f8; } \
        { *(LAS unsigned*)(lds + SA_KP + ko_ + koff) = pk2(kst.x, kst.y); \
            float ss = kst.x * kst.x + kst.y * kst.y; \
            ss = DPP_ADD(ss, 0xB1); ss = DPP_ADD(ss, 0x4E); ss = DPP_ADD(ss, 0x141); ss = DPP_ADD(ss, 0x140);     \
            if ((tid & 15) == 0) *(LAS float*)(lds + SA_KSQ + so_ + ksoff) = ss; } \
    } while (0)
    float lsum[4] = {0.f, 0.f, 0.f, 0.f};
    f32x16 ol;
#pragma unroll
    for (int r = 0; r < 16; ++r) ol[r] = 0.f;
    const int blk = (lane >> 4) & 1, tq = (lane & 15) >> 2, tp = lane & 3;
    int tro[2][2], pro[2][2];
#pragma unroll
    for (int ks = 0; ks < 2; ++ks)
#pragma unroll
        for (int t2 = 0; t2 < 2; ++t2) { const int row = 16 * ks + 8 * hi + tq + 4 * t2, ch = 4 * wave + 2 * blk + (tp >> 1);
            tro[ks][t2] = row * 512 + ((ch ^ sa_g(row)) << 4) + 8 * (tp & 1); pro[ks][t2] = row * SA_PROW + (16 * blk + 4 * tp) * 2; asm volatile("" : "+v"(tro[ks][t2]), "+v"(pro[ks][t2])); }
    SA_LOAD(0); SA_WRITE(0, 0); SA_LOAD(1);
    asm volatile("s_waitcnt lgkmcnt(0)" ::: "memory"); __builtin_amdgcn_s_barrier(); asm volatile("" ::: "memory");
#define SA_PV(q4, q2) do { const int pb_ = (q4) * SA_LTB, pp_ = (q2) * SA_PLB; \
            const s16x4 t00 = tr_read(lds + SA_LT + pb_ + tro[0][0]), t01 = tr_read(lds + SA_LT + pb_ + tro[0][1]), p00 = tr_read(lds + SA_PL + pp_ + pro[0][0]), p01 = tr_read(lds + SA_PL + pp_ + pro[0][1]); \
            const s16x4 t10 = tr_read(lds + SA_LT + pb_ + tro[1][0]), t11 = tr_read(lds + SA_LT + pb_ + tro[1][1]), p10 = tr_read(lds + SA_PL + pp_ + pro[1][0]), p11 = tr_read(lds + SA_PL + pp_ + pro[1][1]); \
            __builtin_amdgcn_sched_barrier(0); \
            ol = MFMA32(((bf16x8){t00[0], t00[1], t00[2], t00[3], t01[0], t01[1], t01[2], t01[3]}), ((bf16x8){p00[0], p00[1], p00[2], p00[3], p01[0], p01[1], p01[2], p01[3]}), ol); \
            ol = MFMA32(((bf16x8){t10[0], t10[1], t10[2], t10[3], t11[0], t11[1], t11[2], t11[3]}), ((bf16x8){p10[0], p10[1], p10[2], p10[3], p11[0], p11[1], p11[2], p11[3]}), ol); } while (0)
#ifndef SA_STAGGER
#define SA_STAGGER 1
#endif
#define SA_NLOAD(kb, Q20, dst) do { int nb_ = nbase[kb]; asm volatile("" : "+v"(nb_));     \
        const LAS unsigned char* frow = lds + SA_F8 + (Q20) * SA_F8B; \
        _Pragma("unroll") \
        for (int st2 = 0; st2 < 2; ++st2) { const v4u lo = *(const LAS v4u*)(frow + (nb_ ^ ((8 * st2) << 4))), hi4 = *(const LAS v4u*)(frow + (nb_ ^ ((8 * st2 + 1) << 4))); \
            dst[st2] = (v8i){(int)lo.x, (int)lo.y, (int)lo.z, (int)lo.w, (int)hi4.x, (int)hi4.y, (int)hi4.z, (int)hi4.w}; } } while (0)
#define SA_NMMA(src, acc_) do { \
        _Pragma("unroll") \
        for (int a = 0; a < 4; ++a) acc_[a] = (f32x4){0.f, 0.f, 0.f, 0.f}; \
        _Pragma("unroll") \
        for (int st2 = 0; st2 < 2; ++st2) \
            _Pragma("unroll") \
            for (int db = 0; db < 4; ++db) acc_[db] = MFMA_F8(Wf[db][st2], src[st2], acc_[db]); } while (0)
#define SA_NTAIL(kb, Q20, acc_, ksq_) do { const int key_ = (kb) * 16 + fr; float ss = 0.f; \
        _Pragma("unroll") \
        for (int db = 0; db < 4; ++db) ss += (acc_[db][0] * acc_[db][0] + acc_[db][1] * acc_[db][1]) + (acc_[db][2] * acc_[db][2] + acc_[db][3] * acc_[db][3]); \
        ss *= (1.0f / 256.0f);                            \
        { auto r16 = __builtin_amdgcn_permlane16_swap(__float_as_uint(ss), __float_as_uint(ss), false, false); ss = __uint_as_float(r16[0]) + __uint_as_float(r16[1]); \
          auto r32_ = __builtin_amdgcn_permlane32_swap(__float_as_uint(ss), __float_as_uint(ss), false, false); ss = __uint_as_float(r32_[0]) + __uint_as_float(r32_[1]); } \
        ss += (ksq_); \
        const float rs = __builtin_amdgcn_rsqf(ss * (1.f / QKH) + EPS); \
        if (fq == 0) *(LAS float*)(lds + SA_RS + (Q20) * SA_RSB + h * 128 + key_ * 4) = rs; } while (0)
#define SA_NSTAGE(Q20, Q40) do { \
        const float ksq0 = *(const LAS float*)(lds + SA_KSQ + (Q40) * SA_KSB + fr * 4), ksq1 = *(const LAS float*)(lds + SA_KSQ + (Q40) * SA_KSB + (16 + fr) * 4); \
        v8i nb[2]; f32x4 na0[4], na1[4]; \
        SA_NLOAD(0, Q20, nb); __builtin_amdgcn_sched_barrier(0); \
        SA_NMMA(nb, na0); __builtin_amdgcn_sched_barrier(0); \
        SA_NLOAD(1, Q20, nb); __builtin_amdgcn_sched_barrier(0); \
        SA_NTAIL(0, Q20, na0, ksq0); __builtin_amdgcn_sched_barrier(0); \
        SA_NMMA(nb, na1); __builtin_amdgcn_sched_barrier(0); \
        SA_NTAIL(1, Q20, na1, ksq1); } while (0)
#define SA_BODY(I, FULL, Q4M2, Q4M1, Q40, Q4P1, Q2M2, Q2M1, Q20, Q2P1) do { const int i = (I); \
        if ((SA_STAGGER ? wave >= 4 : true) && ((FULL) || i >= 2)) SA_PV(Q4M2, Q2M2); \
          \
        if ((FULL) || i < NC) SA_NSTAGE(Q20, Q40); \
          \
        if (((FULL) || (i >= 1 && i <= NC)) && (Q2M1) == spar) { \
            const int key = skb * 16 + fr; const bool newc = (FULL) ? false : (i - 1 >= NCD); \
            const LAS unsigned char* lrow = lds + SA_LT + (Q4M1) * SA_LTB + key * 512; const int gk = sa_g(key); \
            const LAS unsigned char* krow = lds + SA_KP + (Q4M1) * SA_KPB + key * 64 + ((fq ^ sa_pi((key >> 2) & 3)) << 4); \
            const float rsv = *(const LAS float*)(lds + SA_RS + (Q2M1) * SA_RSB + (4 * sg + fq) * 128 + key * 4);        \
            f32x4 sacc = (f32x4){0.f, 0.f, 0.f, 0.f}; \
            _Pragma("unroll") \
            for (int s = 0; s < 9; ++s) { const bf16x8 bf = (s < 8) ? *(const LAS bf16x8*)(lrow + (((4 * s + fq) ^ gk) << 4)) : *(const LAS bf16x8*)(krow); const bf16x8 qa = *(const LAS bf16x8*)(qaf + 64 * s); sacc = MFMA16(qa, bf, sacc); } \
            float pv[4]; \
            _Pragma("unroll") \
            for (int i4 = 0; i4 < 4; ++i4) { float p = __builtin_amdgcn_exp2f(sacc[i4] * rsv); if (newc && (key >= DS || key > i4)) p = 0.f; lsum[i4] += p; pv[i4] = p; } \
            v2u w; w.x = pk2(pv[0], pv[1]); w.y = pk2(pv[2], pv[3]); \
            *(LAS v2u*)(lds + SA_PL + (Q2M1) * SA_PLB + key * SA_PROW + sg * 32 + fq * 8) = w;         \
        } \
        if (SA_STAGGER && wave < 4 && ((FULL) || i >= 2)) SA_PV(Q4M2, Q2M2); \
        if ((FULL) || i + 1 < NC) { SA_WRITE(Q4P1, Q2P1); if ((FULL) || i + 2 < NC) SA_LOAD(i + 2); } \
        asm volatile("s_waitcnt lgkmcnt(0)" ::: "memory"); __builtin_amdgcn_s_barrier(); asm volatile("" ::: "memory"); \
    } while (0)
#define SA_GEN(I) SA_BODY(I, false, ((I) - 2) & 3, ((I) - 1) & 3, (I) & 3, ((I) + 1) & 3, (I) & 1, ((I) - 1) & 1, (I) & 1, ((I) + 1) & 1)
    SA_GEN(0); SA_GEN(1);
    int ii = 2;
    for (; ii + 3 <= NC - 3; ii += 4) {
        SA_BODY(ii,     true, 0, 1, 2, 3, 0, 1, 0, 1);
        SA_BODY(ii + 1, true, 1, 2, 3, 0, 1, 0, 1, 0);
        SA_BODY(ii + 2, true, 2, 3, 0, 1, 0, 1, 0, 1);
        SA_BODY(ii + 3, true, 3, 0, 1, 2, 1, 0, 1, 0);
    }
    for (; ii <= NC + 1; ++ii) SA_GEN(ii);
    {
        int l2 = lane; asm volatile("" : "+v"(l2)); const int r32e = l2 & 31, hie = l2 >> 5; asm volatile("" : "+s"(ws));
        float* part = (float*)(ws + WS_PART) + ((size_t)(b * SA_NS + sp) * 32 + r32e) * KVL + 32 * wave;
#pragma unroll
        for (int g = 0; g < 4; ++g) *(GAS f32x4*)(part + 8 * g + 4 * hie) = (f32x4){ol[4 * g], ol[4 * g + 1], ol[4 * g + 2], ol[4 * g + 3]};
#pragma unroll
        for (int i4 = 0; i4 < 4; ++i4) { float v = lsum[i4]; v += __shfl_xor(v, 1); v += __shfl_xor(v, 2); v += __shfl_xor(v, 4); v += __shfl_xor(v, 8);
            if ((l2 & 15) == 0) *(LAS float*)(lds + SA_LRED + (wave * 16 + 4 * (l2 >> 4) + i4) * 4) = v; }
        __syncthreads();
        if (wave == 0 && l2 < 32) { const int g = l2 >> 4, idx = l2 & 15; float t = 0.f;
#pragma unroll
            for (int w4 = 0; w4 < 4; ++w4) t += *(const LAS float*)(lds + SA_LRED + ((2 * w4 + g) * 16 + idx) * 4);
            ((float*)(ws + WS_LPART))[(size_t)(b * SA_NS + sp) * 32 + l2] = t; }
    }
#undef SA_LOAD
#undef SA_WRITE
#undef SA_PV
#undef SA_BODY
#undef SA_GEN
#undef SA_NLOAD
#undef SA_NMMA
#undef SA_NTAIL
#undef SA_NSTAGE
}

__device__ __forceinline__ void p3_attention(const Params& P, Frame& F) {
    const int c = blockIdx.x, G = F.G;
#ifndef PA_REP
#define PA_REP 1
#endif
#ifndef SA_REP
#define SA_REP 1
#endif
#ifndef NO_PA
    for (int rep = 0; rep < PA_REP; ++rep)
    for (int u = c; u < 512; u += G) { const int i = u >> 8, cc = u & 255; const int k = cc >> 6, bh = cc & 63; const int qb = (i == 0) ? 7 - k : k; pattn_unit(P, F, bh >> 3, bh & 7, qb); }
#endif
#ifndef NO_SA
    for (int rep = 0; rep < SA_REP; ++rep)
    for (int u = c; u < DB * SA_NS; u += G) sattn_unit(P, F, u / SA_NS, u % SA_NS);
#endif
}

__device__ __forceinline__ void p4a_sample(const Params& P, Frame& F) {
    unsigned char* ws = P.ws; const int lane = F.lane, h = F.wave;
    LAS float* scr = (LAS float*)(F.lds + RING_OFF + F.wave * 2048);
    LAS float* ssb = (LAS float*)(F.lds + RING_OFF + 16384);
    const int r0 = MP + 2 * (int)blockIdx.x; if (r0 >= MR) return;
    const int b = (r0 - MP) >> 2, m0 = h * 4 + ((r0 - MP) & 3);
    {
        float l[2] = {0.f, 0.f}; f32x4 acc[2] = {(f32x4){0.f, 0.f, 0.f, 0.f}, (f32x4){0.f, 0.f, 0.f, 0.f}};
#pragma unroll
        for (int sp = 0; sp < SA_NS; ++sp)
#pragma unroll
            for (int q = 0; q < 2; ++q) { l[q] += ((const float*)(ws + WS_LPART))[(size_t)(b * SA_NS + sp) * 32 + m0 + q];
                acc[q] = acc[q] + *(const GAS f32x4*)((const float*)(ws + WS_PART) + ((size_t)(b * SA_NS + sp) * 32 + m0 + q) * KVL + 4 * lane); }
#pragma unroll
        for (int q = 0; q < 2; ++q) *(LAS f32x4*)(scr + 256 * q + 4 * lane) = acc[q] * (1.0f / l[q]);
    }
    LDS_WAIT(); asm volatile("" ::: "memory");
    const int cg = lane >> 3, dq = lane & 7;
    const GAS unsigned char* wp = (const GAS unsigned char*)((const bf16*)(ws + WS_WUKVB) + (size_t)cg * 1024 + h * 128 + 64 + 8 * dq);
    float o8[2][8];
#pragma unroll
    for (int i = 0; i < 8; ++i) { o8[0][i] = 0.f; o8[1][i] = 0.f; }
#pragma unroll 1
    for (int kb = 0; kb < 2; ++kb) {
        v4u w[16];
#pragma unroll
        for (int kk = 0; kk < 16; ++kk) w[kk] = *(const GAS v4u*)(wp + (size_t)(8 * (16 * kb + kk)) * 2048);
#pragma unroll
        for (int kk = 0; kk < 16; ++kk) { const float sc0 = scr[8 * (16 * kb + kk) + cg], sc1 = scr[256 + 8 * (16 * kb + kk) + cg]; float e[8]; unpack8(w[kk], e);
#pragma unroll
            for (int i = 0; i < 8; ++i) { o8[0][i] += sc0 * e[i]; o8[1][i] += sc1 * e[i]; } }
    }
    float ssw[2] = {0.f, 0.f};
#pragma unroll
    for (int q = 0; q < 2; ++q) {
#pragma unroll
        for (int i = 0; i < 8; ++i) { float v = o8[q][i]; v += __shfl_xor(v, 8); v += __shfl_xor(v, 16); v += __shfl_xor(v, 32); o8[q][i] = v; ssw[q] += v * v; }
        ssw[q] += __shfl_xor(ssw[q], 1); ssw[q] += __shfl_xor(ssw[q], 2); ssw[q] += __shfl_xor(ssw[q], 4);
    }
    if (lane == 0) { ssb[h] = ssw[0]; ssb[8 + h] = ssw[1]; }
    __syncthreads();
#pragma unroll
    for (int q = 0; q < 2; ++q) {
        float tot = 0.f;
#pragma unroll
        for (int j = 0; j < NH; ++j) tot += ssb[8 * q + j];
        const float rs = 1.0f / sqrtf(tot * (1.f / AW) + EPS);
        if (cg == 0) { float e[8];
#pragma unroll
            for (int i = 0; i < 8; ++i) e[i] = o8[q][i] * rs;
            *(GAS v4u*)((bf16*)(ws + WS_MIX) + (size_t)(r0 + q) * DM + h * VH + 8 * dq) = pack8(e); }
    }
    __syncthreads();
}

__device__ __forceinline__ f32x16 skinny_tile(LAS unsigned char* wl  , const bf16* A, int lda, const bf16* Bt, int ldb, int row0, int col0, int kbeg, int kend, int lane) {
    const int r32 = lane & 31, hi = lane >> 5, lr = lane >> 3, lc = lane & 7;
    const GAS unsigned char* ap = (const GAS unsigned char*)(A + (size_t)(row0 + lr) * lda + kbeg) + 16 * lc;
    const GAS unsigned char* bp = (const GAS unsigned char*)(Bt + (size_t)(col0 + lr) * ldb + kbeg) + 16 * lc;
    const size_t astep = (size_t)8 * lda * 2, bstep = (size_t)8 * ldb * 2;
    f32x16 acc;
#pragma unroll
    for (int r = 0; r < 16; ++r) acc[r] = 0.f;
    v4u ra[4], rb[4];
#pragma unroll
    for (int j = 0; j < 4; ++j) { ra[j] = *(const GAS v4u*)(ap + j * astep); rb[j] = *(const GAS v4u*)(bp + j * bstep); }
    const int nit = (kend - kbeg) >> 6;
    LAS unsigned char* wst = wl + lr * 144 + lc * 16;
    const LAS unsigned char* rfa = wl + r32 * 144 + hi * 16;
#pragma unroll 1
    for (int it = 0; it < nit; ++it) {
#pragma unroll
        for (int j = 0; j < 4; ++j) { *(LAS v4u*)(wst + j * (8 * 144)) = ra[j]; *(LAS v4u*)(wst + 4608 + j * (8 * 144)) = rb[j]; }
        if (it + 1 < nit) {
#pragma unroll
            for (int j = 0; j < 4; ++j) { ra[j] = *(const GAS v4u*)(ap + (size_t)(it + 1) * 128 + j * astep); rb[j] = *(const GAS v4u*)(bp + (size_t)(it + 1) * 128 + j * bstep); } }
        bf16x8 a[4], b[4];
#pragma unroll
        for (int s4 = 0; s4 < 4; ++s4) { a[s4] = *(const LAS bf16x8*)(rfa + 32 * s4); b[s4] = *(const LAS bf16x8*)(rfa + 4608 + 32 * s4); }
#pragma unroll
        for (int s4 = 0; s4 < 4; ++s4) acc = MFMA32(a[s4], b[s4], acc);
    }
    return acc;
}
__device__ __forceinline__ f32x16 coop_tile(LAS unsigned char* img  , const bf16* A, int lda, const bf16* Bt, int ldb, int row0, int col0, int K, int tid, int wave) {
    const int lane = tid & 63, r32 = lane & 31, hi = lane >> 5, lr = tid >> 3, lc = tid & 7;
    const GAS unsigned char* ap = (const GAS unsigned char*)(A + (size_t)(row0 + lr) * lda) + 16 * lc;
    const GAS unsigned char* bp = (const GAS unsigned char*)(Bt + (size_t)(col0 + lr) * ldb) + 16 * lc;
    const size_t bstep = (size_t)64 * ldb * 2;
    constexpr int STG = 192 * 144;
    LAS unsigned char* wst = img + lr * 144 + lc * 16;
    const LAS unsigned char* rfa = img + (32 * (wave >> 2) + r32) * 144 + hi * 16;
    const LAS unsigned char* rfb = img + 9216 + (32 * (wave & 3) + r32) * 144 + hi * 16;
    f32x16 acc;
#pragma unroll
    for (int r = 0; r < 16; ++r) acc[r] = 0.f;
    v4u r0[3], r1[3];
#define CT_LOAD(R, blk) do { const size_t ko_ = (size_t)(blk) * 128; R[0] = *(const GAS v4u*)(ap + ko_); R[1] = *(const GAS v4u*)(bp + ko_); R[2] = *(const GAS v4u*)(bp + bstep + ko_); } while (0)
#define CT_PUT(R, st) do { *(LAS v4u*)(wst + (st) * STG) = R[0]; *(LAS v4u*)(wst + (st) * STG + 9216) = R[1]; *(LAS v4u*)(wst + (st) * STG + 9216 + 64 * 144) = R[2]; } while (0)
#define CT_MMA(st) do { bf16x8 a[4], b[4]; \
        _Pragma("unroll") \
        for (int s4 = 0; s4 < 4; ++s4) { a[s4] = *(const LAS bf16x8*)(rfa + (st) * STG + 32 * s4); b[s4] = *(const LAS bf16x8*)(rfb + (st) * STG + 32 * s4); } \
        _Pragma("unroll") \
        for (int s4 = 0; s4 < 4; ++s4) acc = MFMA32(a[s4], b[s4], acc); } while (0)
    CT_LOAD(r0, 0); CT_LOAD(r1, 1);
    const int nit = K >> 6;
#pragma unroll 1
    for (int it = 0; it < nit; it += 2) {
        CT_PUT(r0, 0); if (it + 2 < nit) CT_LOAD(r0, it + 2);
        __syncthreads();
        CT_MMA(0);
        CT_PUT(r1, 1); if (it + 3 < nit) CT_LOAD(r1, it + 3);
        __syncthreads();
        CT_MMA(1);
    }
#undef CT_LOAD
#undef CT_PUT
#undef CT_MMA
    __syncthreads();
    return acc;
}
template <bool XCOPY> __device__ __forceinline__ void skinny_res_n1024(Frame& F, const bf16* A, int lda, const bf16* Bt, int K, const float* base, float* out, bf16* xb, float* rowss) {
    int tid_ = threadIdx.x; asm volatile("" : "+v"(tid_)); const int lane = tid_ & 63, wave = __builtin_amdgcn_readfirstlane(tid_ >> 6), r32 = lane & 31, hi = lane >> 5;
    const int t = 2 * blockIdx.x + (wave >> 2), kq = wave & 3; const int row0 = 32 * (t >> 5), col0 = 32 * (t & 31);
    LAS float* red = (LAS float*)(F.lds + RING_OFF);
    f32x16 acc;
#pragma unroll
    for (int r = 0; r < 16; ++r) acc[r] = 0.f;
    if (t < 512) acc = skinny_tile(F.lds + RING_OFF + 32768 + wave * 9216, A, lda, Bt, K, row0, col0, kq * (K >> 2), (kq + 1) * (K >> 2), lane);
    if (kq != 0) {
#pragma unroll
        for (int r = 0; r < 16; ++r) red[wave * 1024 + r * 64 + lane] = acc[r]; }
    __syncthreads();
    if (kq == 0 && t < 512) {
#pragma unroll
        for (int r = 0; r < 16; ++r) { const float v = acc[r] + red[(wave + 1) * 1024 + r * 64 + lane] + red[(wave + 2) * 1024 + r * 64 + lane] + red[(wave + 3) * 1024 + r * 64 + lane];
            const size_t o = (size_t)(row0 + crow(r, hi)) * DM + col0 + r32;
            if (!XCOPY) { out[o] = __uint_as_float((unsigned)xb[o] << 16) + v; }
            else { const float x1 = base[o] + v; xb[o] = (bf16)(pk2(x1, 0.f) & 0xffffu); float q = x1 * x1; q += __shfl_xor(q, 1); q += __shfl_xor(q, 2); q += __shfl_xor(q, 4); q += __shfl_xor(q, 8); q += __shfl_xor(q, 16);
                if (r32 == 0) atomicAdd(rowss + row0 + crow(r, hi), q); } }
    }
    __syncthreads();
}
__device__ __forceinline__ void skinny_up(Frame& F, const bf16* A, const bf16* Bt, bf16* H, const float* rowss) {
    int tid_ = threadIdx.x; asm volatile("" : "+v"(tid_)); const int lane = tid_ & 63, wave = __builtin_amdgcn_readfirstlane(tid_ >> 6), r32 = lane & 31, hi = lane >> 5;
    const int c = blockIdx.x; if (c >= 256) return;
    const int row0 = 64 * (c >> 5) + 32 * (wave >> 2), col0 = 128 * (c & 31) + 32 * (wave & 3);
    const f32x16 acc = coop_tile(F.lds + RING_OFF, A, DM, Bt, DM, 64 * (c >> 5), 128 * (c & 31), DM, tid_, wave);
#pragma unroll
    for (int r = 0; r < 16; ++r) { const float a = acc[r] * __builtin_amdgcn_rsqf(rowss[row0 + crow(r, hi)] * (1.0f / 1024.0f) + 1e-6f); const float v = a > 0.f ? a : 0.f; H[(size_t)(row0 + crow(r, hi)) * DFF + col0 + r32] = (bf16)(pk2(v * v, 0.f) & 0xffffu); }
}

__device__ __forceinline__ void p1_leftover(const Params& P, Frame& F) {
    unsigned char* ws = P.ws;
    int tid_ = threadIdx.x; asm volatile("" : "+v"(tid_)); const int lane = tid_ & 63, wave = __builtin_amdgcn_readfirstlane(tid_ >> 6), r32 = lane & 31, hi = lane >> 5;
    const bf16* XN = (const bf16*)(ws + WS_XN); const bf16* WIN = (const bf16*)(ws + WS_WIN); bf16* Z = (bf16*)(ws + WS_Z);
    for (int ta = blockIdx.x; ta < 256 + 9 * 18; ta += gridDim.x) {
        int R0, C0; if (ta < 256) { R0 = 64 * ta; C0 = 2048; } else { const int u = ta - 256; R0 = MP + 64 * (u / 18); C0 = 128 * (u % 18); }
        const f32x16 acc = coop_tile(F.lds + RING_OFF, XN, DM, WIN, DM, R0, C0, DM, tid_, wave);
        const int row0 = R0 + 32 * (wave >> 2), col0 = C0 + 32 * (wave & 3);
#pragma unroll
        for (int r = 0; r < 16; ++r) Z[(size_t)(row0 + crow(r, hi)) * INWP + col0 + r32] = (bf16)(pk2(acc[r], 0.f) & 0xffffu);
    }
    LAS float* red = (LAS float*)(F.lds + RING_OFF);
    for (int tc = blockIdx.x; tc < MP / 64; tc += gridDim.x) {
        const int row0 = 64 * tc + 32 * (wave >> 2), kq = wave & 3;
        const f32x16 acc = skinny_tile(F.lds + RING_OFF + 32768 + wave * 9216, XN, DM, WIN, DM, row0, 2176, 256 * kq, 256 * (kq + 1), lane);
        if (kq != 0) {
#pragma unroll
            for (int r = 0; r < 16; ++r) red[wave * 1024 + r * 64 + lane] = acc[r]; }
        __syncthreads();
        if (kq == 0) {
#pragma unroll
            for (int r = 0; r < 16; ++r) { const float v = acc[r] + red[(wave + 1) * 1024 + r * 64 + lane] + red[(wave + 2) * 1024 + r * 64 + lane] + red[(wave + 3) * 1024 + r * 64 + lane];
                Z[(size_t)(row0 + crow(r, hi)) * INWP + 2176 + r32] = (bf16)(pk2(v, 0.f) & 0xffffu); } }
        __syncthreads();
    }
}

struct EpiKV {
    static constexpr bool PERM = true, AFTER_DRAIN = false, HAS_MID = false;
    bf16* KV; bf16* K; const float* kper; const float* kss; const float* g; LAS float* ex;
    __device__ __forceinline__ void operator()(const pg8::f32x4 (&acc)[2][2][4][2], const pg8::Unit& u, int wr_in, int wc_in, int fr_in, int fq_in) const {
        int wr = wr_in, wc = wc_in, fr = fr_in, fq = fq_in; asm volatile("" : "+s"(wr), "+s"(wc), "+v"(fr), "+v"(fq));
        const bool kpart = wc < 2;
        const int rowb = u.pm * 256 + wr * 64 + fr;
        if (kpart) {
#pragma unroll
            for (int ai = 0; ai < 2; ++ai)
#pragma unroll
                for (int m = 0; m < 4; ++m)
#pragma unroll
                    for (int bj = 0; bj < 2; ++bj) { const pg8::f32x4 a0 = acc[ai][bj][m][0], a1 = acc[ai][bj][m][1];
                        float ss = ((a0[0] * a0[0] + a0[1] * a0[1]) + (a0[2] * a0[2] + a0[3] * a0[3])) + ((a1[0] * a1[0] + a1[1] * a1[1]) + (a1[2] * a1[2] + a1[3] * a1[3]));
                        { auto r16 = __builtin_amdgcn_permlane16_swap(__float_as_uint(ss), __float_as_uint(ss), false, false); ss = __uint_as_float(r16[0]) + __uint_as_float(r16[1]);
                          auto r32 = __builtin_amdgcn_permlane32_swap(__float_as_uint(ss), __float_as_uint(ss), false, false); ss = __uint_as_float(r32[0]) + __uint_as_float(r32[1]); }
                        if (fq == 0) ex[((((wr * 2 + wc) * 2 + ai) * 4 + m) * 2 + bj) * 16 + fr] = ss; }
        } else {
            const int col0 = u.pn * 256 + wc * 32 + 8 * fq;
#pragma unroll
            for (int ai = 0; ai < 2; ++ai)
#pragma unroll
                for (int m = 0; m < 4; ++m) { bf16* rowp = KV + (size_t)(rowb + ai * 128 + m * 16) * 1024 + col0;
#pragma unroll
                    for (int bj = 0; bj < 2; ++bj) { const pg8::f32x4 v0 = acc[ai][bj][m][0], v1 = acc[ai][bj][m][1];
                        v4u w; w.x = pk2(v0[0], v0[1]); w.y = pk2(v0[2], v0[3]); w.z = pk2(v1[0], v1[1]); w.w = pk2(v1[2], v1[3]);
                        pg8::st_wt16(rowp + bj * 128, w); } }
        }
        asm volatile("s_waitcnt lgkmcnt(0)" ::: "memory"); __builtin_amdgcn_s_barrier(); asm volatile("" ::: "memory");
        const bool prompt = u.pm < MP / 256;
        if (!prompt && u.pm != MR / 256) return;
        const int d0 = kpart ? 32 * wc + 8 * fq : 64 + 8 * fq;
        const int nrep = prompt ? 1 : NB;
        const int bjr = wc & 1;
        const LAS float* exr = ex + wr * 512 + fr;
        float ksv[2][4];
#pragma unroll
        for (int ai = 0; ai < 2; ++ai)
#pragma unroll
            for (int m = 0; m < 4; ++m) ksv[ai][m] = kss[rowb + ai * 128 + m * 16];
#pragma unroll
        for (int ai = 0; ai < 2; ++ai) {
            const pg8::f32x4 g0 = *(const GAS pg8::f32x4*)(g + d0), g1 = *(const GAS pg8::f32x4*)(g + d0 + 4);
            pg8::f32x4 kp[4][2];
            if (!kpart) {
#pragma unroll
                for (int m = 0; m < 4; ++m) { const float* kr = kper + (size_t)(rowb + ai * 128 + m * 16) * QKR + 8 * fq; kp[m][0] = *(const GAS pg8::f32x4*)kr; kp[m][1] = *(const GAS pg8::f32x4*)(kr + 4); }
            }
#pragma unroll
            for (int m = 0; m < 4; ++m) { const int row = rowb + ai * 128 + m * 16;
                const bool rv = prompt || row < MR + NMETA;
                const float ks = ksv[ai][m];
                const int kofs = (prompt ? ((row >> 11) * TPP + NMETA + (row & 2047)) : (row - MR)) * 768 + 2 * u.pn * QKH + d0;
                if (kpart) {
#pragma unroll
                    for (int bj = 0; bj < 2; ++bj) {
                        const float tot = exr[(ai * 4 + m) * 32 + bj * 16] + exr[256 + (ai * 4 + m) * 32 + bj * 16] + ks;
                        const float rs = __builtin_amdgcn_rsqf(tot * (1.f / QKH) + EPS);
                        const pg8::f32x4 v0 = acc[ai][bj][m][0] * rs * g0, v1 = acc[ai][bj][m][1] * rs * g1;
                        v4u w; w.x = pk2(v0[0], v0[1]); w.y = pk2(v0[2], v0[3]); w.z = pk2(v1[0], v1[1]); w.w = pk2(v1[2], v1[3]);
                        if (rv) for (int b = 0; b < nrep; ++b) *(GAS v4u*)(K + (size_t)(kofs + bj * QKH) + (size_t)b * (TPP * 768)) = w; }
                } else {
                    const float tot = exr[(ai * 4 + m) * 32 + bjr * 16] + exr[256 + (ai * 4 + m) * 32 + bjr * 16] + ks;
                    const float rs = __builtin_amdgcn_rsqf(tot * (1.f / QKH) + EPS);
                    const pg8::f32x4 v0 = kp[m][0] * rs * g0, v1 = kp[m][1] * rs * g1;
                    v4u w; w.x = pk2(v0[0], v0[1]); w.y = pk2(v0[2], v0[3]); w.z = pk2(v1[0], v1[1]); w.w = pk2(v1[2], v1[3]);
                    if (rv) for (int b = 0; b < nrep; ++b) *(GAS v4u*)(K + (size_t)(kofs + bjr * QKH) + (size_t)b * (TPP * 768)) = w;
                }
            }
            asm volatile("" ::: "memory");
        }
    }
};

__global__ void __launch_bounds__(NWAVES * 64, 2) hymba_fwd(Params P) {
    extern __shared__ __attribute__((aligned(16))) unsigned char lds_raw[];
    Frame F;
    F.lds = (LAS unsigned char*)lds_raw;
    F.MISC = (volatile LAS unsigned*)(F.lds + MISC_OFF);
    F.tid = threadIdx.x; F.lane = F.tid & 63; F.wave = __builtin_amdgcn_readfirstlane(F.tid >> 6);
    F.G = gridDim.x; F.gw = blockIdx.x * NWAVES + F.wave; F.NGW = F.G * NWAVES;
    unsigned char* ws = P.ws;
    F.ctl = (gu32*)(ws + WS_CTL);
    for (int u = F.tid; u < (LDS_BYTES - LDSCTL_OFF) / 4; u += NWAVES * 64) ((LAS unsigned*)(F.lds + LDSCTL_OFF))[u] = 0u;
    __syncthreads();
    const bool multi = (P.ph_hi - P.ph_lo) > 1;
    XcdBarrier bar; bar.bar = (unsigned*)(F.ctl + CW_BAR); bar.x = 0; bar.st = nullptr;
    if (multi) bar = xcd_barrier_post((unsigned*)(F.ctl + CW_BAR), F.MISC + 8);
    const int lo = P.ph_lo, hi = P.ph_hi;
#define REFRESH() do { int t_ = threadIdx.x; asm volatile("" : "+v"(t_)); F.tid = t_; F.lane = t_ & 63; F.wave = __builtin_amdgcn_readfirstlane(t_ >> 6); F.gw = blockIdx.x * NWAVES + F.wave; } while (0)
#ifndef PHM
#define PHM 0x7ff
#endif
#ifndef PROBE_REP
#define PROBE_REP 0
#endif
#define DUP(k) (IN(k) && ((PROBE_REP >> (k)) & 1))
#define IN(k) (((PHM >> (k)) & 1) && lo <= (k) && (k) < hi)
#define SEAM(k) do { if (IN(k) && IN((k) + 1)) xcd_barrier(bar); } while (0)

    if (IN(0)) { REFRESH(); p0_prologue(P, F); } if (DUP(0)) { REFRESH(); p0_prologue(P, F); } SEAM(0);
    if (IN(1)) {
        pg8::Gemm g{(const bf16*)(ws + WS_XN), (const bf16*)(ws + WS_WIN), MP, 2048, DM}; pg8::StaticOrder S; S.init(MP, 2048, F.G, (int)blockIdx.x);
        pg8::EpiBf16<0> E{(bf16*)(ws + WS_Z), INWP, nullptr, 4};
        const bool early = ((blockIdx.x >> 3) & 1) != 0;
        if (early) { p1_leftover(P, F); __syncthreads(); REFRESH(); p0_late(P, F, F.gw, F.NGW); __syncthreads(); }
        pg8::gemm_phase<pg8::EpiBf16<0>, pg8::StaticOrder, true, true>(F.lds + RING_OFF, g, S, E);
        __syncthreads();
        if (!early) {
        p1_leftover(P, F);
        __syncthreads(); REFRESH(); p0_late(P, F, F.gw, F.NGW);
        }
    }
    SEAM(1);
    if (IN(2)) { REFRESH(); for (int r = F.gw; r < MALL; r += F.NGW) p2a_row(P, F, r); } if (DUP(2)) { REFRESH(); for (int r = F.gw; r < MALL; r += F.NGW) p2a_row(P, F, r); } SEAM(2);
    if (IN(3)) {
        { pg8::Gemm g{(const bf16*)(ws + WS_CQN), (const bf16*)(ws + WS_WUQ), MR, 768, QL}; pg8::StaticOrder S; S.init(MR, 768, F.G, (int)blockIdx.x);
          pg8::EpiBf16<0> E{(bf16*)(ws + WS_QRAW), 768, nullptr, 0};
          pg8::gemm_phase<pg8::EpiBf16<0>, pg8::StaticOrder, true, true>(F.lds + RING_OFF, g, S, E); }
        __syncthreads();
        { pg8::Gemm g{(const bf16*)(ws + WS_LATB), (const bf16*)(ws + WS_WUKV), MPAD, 1024, KVL}; pg8::StaticOrder S; S.init(MPAD, 1024, F.G, (int)((blockIdx.x + 58) % F.G));
          EpiKV E{(bf16*)(ws + WS_KVRAW), (bf16*)(ws + WS_K), (const float*)(ws + WS_KPER), (const float*)(ws + WS_KSS), P.k_norm_g, (LAS float*)(F.lds + RING_OFF + RING_BYTES)};
          pg8::gemm_phase<EpiKV, pg8::StaticOrder, true, true>(F.lds + RING_OFF, g, S, E); }
    }
    SEAM(4);
    if (IN(5)) { REFRESH(); p3_attention(P, F); } SEAM(5);
    if (IN(6)) { REFRESH();
        { const int i = (int)blockIdx.x * 512 + F.tid; if (i < MP) { const f32x4 a = ((const GAS f32x4*)(ws + WS_SSQ))[2 * i], c = ((const GAS f32x4*)(ws + WS_SSQ))[2 * i + 1];
            ((float*)(ws + WS_RSA))[i] = 1.0f / sqrtf(((a.x + a.y) + (a.z + a.w) + (c.x + c.y) + (c.z + c.w)) * (1.f / AW) + EPS); } }
        p4a_sample(P, F); } SEAM(6);
    if (IN(7)) {
        pg8::Gemm g{(const bf16*)(ws + WS_MIX), (const bf16*)(ws + WS_WO), MP, DM, DM}; pg8::StaticOrder S; S.init(MP, DM, F.G, (int)blockIdx.x);
        pg8::EpiF32ResX E{P.x_prompt, (bf16*)(ws + WS_XN), (float*)(ws + WS_ROWSS), DM, (const float*)(ws + WS_RSA)};
        const bool early = ((blockIdx.x >> 3) & 1) != 0;
        if (early) skinny_res_n1024<true>(F, (const bf16*)(ws + WS_MIX) + (size_t)MP * DM, DM, (const bf16*)(ws + WS_WO), DM, P.x_sample, nullptr, (bf16*)(ws + WS_XN) + (size_t)MP * DM, (float*)(ws + WS_ROWSS) + MP);
        pg8::gemm_phase<pg8::EpiF32ResX, pg8::StaticOrder, true, true>(F.lds + RING_OFF, g, S, E);
        __syncthreads();
        if (!early) skinny_res_n1024<true>(F, (const bf16*)(ws + WS_MIX) + (size_t)MP * DM, DM, (const bf16*)(ws + WS_WO), DM, P.x_sample, nullptr, (bf16*)(ws + WS_XN) + (size_t)MP * DM, (float*)(ws + WS_ROWSS) + MP);
    }
    SEAM(7);
    if (IN(9)) {
        pg8::Gemm g{(const bf16*)(ws + WS_XN), (const bf16*)(ws + WS_WUP), MP, DFF, DM}; pg8::StaticOrder S; S.init(MP, DFF, F.G, (int)blockIdx.x);
        pg8::EpiBf16<2> E{(bf16*)(ws + WS_H), DFF, (const float*)(ws + WS_ROWSS), 12};
        const bool early = ((blockIdx.x >> 3) & 1) != 0;
        if (early) { skinny_up(F, (const bf16*)(ws + WS_XN) + (size_t)MP * DM, (const bf16*)(ws + WS_WUP), (bf16*)(ws + WS_H) + (size_t)MP * DFF, (const float*)(ws + WS_ROWSS) + MP); __syncthreads(); }
        pg8::gemm_phase<pg8::EpiBf16<2>, pg8::StaticOrder, true, true>(F.lds + RING_OFF, g, S, E);
        __syncthreads();
        if (!early) skinny_up(F, (const bf16*)(ws + WS_XN) + (size_t)MP * DM, (const bf16*)(ws + WS_WUP), (bf16*)(ws + WS_H) + (size_t)MP * DFF, (const float*)(ws + WS_ROWSS) + MP);
    }
    SEAM(9);
    if (IN(10)) {
        pg8::Gemm g{(const bf16*)(ws + WS_H), (const bf16*)(ws + WS_WDN), MP, DM, DFF}; pg8::StaticOrder S; S.init(MP, DM, F.G, (int)blockIdx.x);
        pg8::EpiF32ResB E{(const bf16*)(ws + WS_XN), P.out + O_YP, DM};
        const bool early = ((blockIdx.x >> 3) & 1) != 0;
        if (early) skinny_res_n1024<false>(F, (const bf16*)(ws + WS_H) + (size_t)MP * DFF, DFF, (const bf16*)(ws + WS_WDN), DFF, nullptr, P.out + O_YS, (bf16*)(ws + WS_XN) + (size_t)MP * DM, nullptr);
        pg8::gemm_phase<pg8::EpiF32ResB, pg8::StaticOrder, true, true>(F.lds + RING_OFF, g, S, E);
        __syncthreads();
        if (!early) skinny_res_n1024<false>(F, (const bf16*)(ws + WS_H) + (size_t)MP * DFF, DFF, (const bf16*)(ws + WS_WDN), DFF, nullptr, P.out + O_YS, (bf16*)(ws + WS_XN) + (size_t)MP * DM, nullptr);
    }
#undef IN
#undef SEAM
}

extern "C" void kernel_launch(void* const* d_in, const int* in_sizes, int n_in, void* d_out, int out_size, void* d_ws, size_t ws_size, hipStream_t stream) {
    static int grid = 0;
    if (grid == 0) {
        if (n_in != 23 || (size_t)out_size != O_END || ws_size < WS_END) { fprintf(stderr, "kernel_launch: unexpected shapes (n_in %d out %d ws %zu)\n", n_in, out_size, ws_size); grid = -1; return; }
        int dev = 0, cus = 0, per_cu = 0;
        if (hipGetDevice(&dev) != hipSuccess || hipDeviceGetAttribute(&cus, hipDeviceAttributeMultiprocessorCount, dev) != hipSuccess) { grid = -1; return; }
        if (hipFuncSetAttribute((const void*)hymba_fwd, hipFuncAttributeMaxDynamicSharedMemorySize, LDS_BYTES) != hipSuccess) { fprintf(stderr, "kernel_launch: hipFuncSetAttribute failed\n"); grid = -1; return; }
        if (hipOccupancyMaxActiveBlocksPerMultiprocessor(&per_cu, (const void*)hymba_fwd, NWAVES * 64, LDS_BYTES) != hipSuccess || per_cu < 1) fprintf(stderr, "kernel_launch: occupancy query reports %d\n", per_cu);
        (void)hipGetLastError();
        grid = cus;
    }
    if (grid < 0) return;
    if (hipMemsetAsync((char*)d_ws + WS_CTL, 0, CTL_ZERO_BYTES, stream) != hipSuccess) return;
    Params p{};
    p.x_prompt = (const float*)d_in[0]; p.x_sample = (const float*)d_in[1]; p.cache_lat = (const float*)d_in[2]; p.cache_kpe = (const float*)d_in[3]; p.state_conv = (const float*)d_in[4];
    p.page_table = (const int*)d_in[5]; p.meta = (const float*)d_in[6]; p.norm_mix_g = (const float*)d_in[7]; p.w_in = (const float*)d_in[8]; p.q_lora_g = (const float*)d_in[9];
    p.kv_lora_g = (const float*)d_in[10]; p.w_uq = (const float*)d_in[11]; p.w_ukv = (const float*)d_in[12]; p.q_norm_g = (const float*)d_in[13]; p.k_norm_g = (const float*)d_in[14];
    p.conv_w = (const float*)d_in[15]; p.conv_b = (const float*)d_in[16]; p.attn_out_g = (const float*)d_in[17]; p.conv_out_g = (const float*)d_in[18]; p.w_o = (const float*)d_in[19];
    p.norm_ffn_g = (const float*)d_in[20]; p.w_up = (const float*)d_in[21]; p.w_down = (const float*)d_in[22];
    p.out = (float*)d_out; p.ws = (unsigned char*)d_ws;
#if MK_N_LAUNCHES == 1
    p.ph_lo = 0; p.ph_hi = N_PHASES; p.li = 0; p.pad = 0;
    hipLaunchKernelGGL(hymba_fwd, dim3(grid), dim3(NWAVES * 64), LDS_BYTES, stream, p);
#else
    for (int li = 0; li < N_PHASES; ++li) { p.ph_lo = li; p.ph_hi = li + 1; p.li = li; p.pad = 0;
        hipLaunchKernelGGL(hymba_fwd, dim3(grid), dim3(NWAVES * 64), LDS_BYTES, stream, p); }
#endif
}
```

```cpp
#include <hip/hip_runtime.h>
#include <cstdio>
#include <cstdint>
namespace pg8 {
#define PG8_LAS __attribute__((address_space(3)))
typedef unsigned short bf16_t;
typedef short bf16x8 __attribute__((ext_vector_type(8)));
typedef float f32x4 __attribute__((ext_vector_type(4)));
typedef unsigned u32x4 __attribute__((ext_vector_type(4)));
constexpr int BM = 256, BK = 64, HALF = 128, HTB = HALF * BK * 2  , STAGE_BYTES = 8 * HTB, NXCD = 8, WGM = 8;

__host__ __device__ __forceinline__ int lds_byte(int r, int c) { const int st = (r >> 4) * 2 + (c >> 5), rr = r & 15, cc = c & 31, ob = rr * 64 + cc * 2; return st * 1024 + (ob ^ (((ob >> 9) & 1) << 5)); }
__host__ __device__ __forceinline__ void stage_rc(int b, int& R, int& C) { const int st = b / 1024, sb = b % 1024, swz = sb ^ (((sb >> 9) & 1) << 5); R = (st >> 1) * 16 + swz / 64; C = (st & 1) * 32 + (swz % 64) / 2; }
__host__ __device__ __forceinline__ int perm32(int rho) { const int n = rho >> 4, i = rho & 15; return 8 * (i >> 2) + 4 * n + (i & 3); }

struct Unit { int pm, pn; };
struct Gemm { const bf16_t* A; const bf16_t* Bt; int M, N, K; };

struct StaticOrder {
    int nM, nN, nwg, G, c;
    __host__ __device__ void init(int M, int N, int G_, int c_) { nM = M / BM; nN = N / BM; nwg = nM * nN; G = G_; c = c_; }
    __host__ __device__ bool next(int i, Unit& u) const {
        const long L = (long)i * G + c; if (L >= nwg) return false;
        int wgid = (int)L; { const int q = nwg / NXCD, r = nwg % NXCD, xcd = wgid % NXCD, off = wgid / NXCD; wgid = (xcd < r ? xcd * (q + 1) : r * (q + 1) + (xcd - r) * q) + off; }
        const int nig = WGM * nN, gid = wgid / nig, fm = gid * WGM, gsz = (nM - fm) < WGM ? (nM - fm) : WGM;
        u.pm = fm + ((wgid % nig) % gsz); u.pn = (wgid % nig) / gsz; return true;
    }
    __device__ __forceinline__ void a_ready(const Unit&) const {}
    __device__ __forceinline__ void done(const Unit&) const {}
};


__device__ __forceinline__ unsigned cvt_pk_bf16(float lo, float hi) { unsigned r; asm volatile("v_cvt_pk_bf16_f32 %0, %1, %2" : "=v"(r) : "v"(lo), "v"(hi)); return r; }

__device__ __forceinline__ void st_wt16(void* p, u32x4 v) { asm volatile("global_store_dwordx4 %0, %1, off sc1\n\ts_nop 1" :: "v"(p), "v"(v) : "memory"); }
template <int ACT  > struct EpiBf16 {
    static constexpr bool PERM = true, AFTER_DRAIN = false, HAS_MID = false;
    bf16_t* O; int ldc; const float* rowss; int wt_pn;
    __device__ __forceinline__ void operator()(const f32x4 (&acc)[2][2][4][2], const Unit& u, int wr, int wc, int fr, int fq) const {
        const int row0 = u.pm * BM + wr * 64 + fr; const int col0 = u.pn * BM + wc * 32 + 8 * fq;
        float rs8[2][4];
#pragma unroll
        for (int ai = 0; ai < 2; ++ai)
#pragma unroll
            for (int m = 0; m < 4; ++m) rs8[ai][m] = rowss ? rowss[row0 + ai * HALF + m * 16] : 0.f;
#pragma unroll
        for (int ai = 0; ai < 2; ++ai)
#pragma unroll
            for (int m = 0; m < 4; ++m) { bf16_t* rowp = O + (size_t)(row0 + ai * HALF + m * 16) * ldc + col0;
                const float rsc = rowss ? __builtin_amdgcn_rsqf(rs8[ai][m] * (1.0f / 1024.0f) + 1e-6f) : 1.0f;
#pragma unroll
                for (int bj = 0; bj < 2; ++bj) { f32x4 v0 = acc[ai][bj][m][0] * rsc, v1 = acc[ai][bj][m][1] * rsc;
                    if (ACT == 2) {
#pragma unroll
                        for (int e = 0; e < 4; ++e) { const float a = v0[e] > 0.f ? v0[e] : 0.f, b = v1[e] > 0.f ? v1[e] : 0.f; v0[e] = a * a; v1[e] = b * b; } }
                    u32x4 w; w.x = cvt_pk_bf16(v0[0], v0[1]); w.y = cvt_pk_bf16(v0[2], v0[3]); w.z = cvt_pk_bf16(v1[0], v1[1]); w.w = cvt_pk_bf16(v1[2], v1[3]);
                    if (u.pn >= wt_pn) st_wt16(rowp + bj * HALF, w); else *(u32x4*)(rowp + bj * HALF) = w; } }
    }
};
struct EpiF32Res {
    static constexpr bool PERM = false, AFTER_DRAIN = false, HAS_MID = false;
    const float* base; const float* base2; int split_row; float* out; int ldc;
    __device__ __forceinline__ void operator()(const f32x4 (&acc)[2][2][4][2], const Unit& u, int wr, int wc, int fr, int fq) const {
        const int col0 = u.pn * BM + wc * 32 + 4 * fq;
#pragma unroll
        for (int ai = 0; ai < 2; ++ai) {
            f32x4 pre[4][2][2];
#pragma unroll
            for (int m = 0; m < 4; ++m) { const int r = u.pm * BM + ai * HALF + wr * 64 + m * 16 + fr;
                const float* bp = (r < split_row) ? base + (size_t)r * ldc : base2 + (size_t)(r - split_row) * ldc;
#pragma unroll
                for (int bj = 0; bj < 2; ++bj)
#pragma unroll
                    for (int n = 0; n < 2; ++n) pre[m][bj][n] = *(const f32x4*)(bp + col0 + bj * HALF + n * 16); }
            asm volatile("" ::: "memory");
#pragma unroll
            for (int m = 0; m < 4; ++m) { const int r = u.pm * BM + ai * HALF + wr * 64 + m * 16 + fr; float* op = out + (size_t)r * ldc;
#pragma unroll
                for (int bj = 0; bj < 2; ++bj)
#pragma unroll
                    for (int n = 0; n < 2; ++n) *(f32x4*)(op + col0 + bj * HALF + n * 16) = pre[m][bj][n] + acc[ai][bj][m][n]; }
            asm volatile("" ::: "memory");
        }
    }
};
struct EpiF32ResX {
    static constexpr bool PERM = false, AFTER_DRAIN = false, HAS_MID = true;
    const float* base; bf16_t* xb; float* rowss; int ldc; const float* rsa;
    __device__ __forceinline__ void mid(f32x4 (&acc)[2][2][4][2], const Unit& u, int t, int wr, int fr) const {
        if (t != 8) return;
        float rs[2][4];
#pragma unroll
        for (int ai = 0; ai < 2; ++ai)
#pragma unroll
            for (int m = 0; m < 4; ++m) rs[ai][m] = rsa[u.pm * BM + ai * HALF + wr * 64 + m * 16 + fr];
#pragma unroll
        for (int ai = 0; ai < 2; ++ai)
#pragma unroll
            for (int bj = 0; bj < 2; ++bj)
#pragma unroll
                for (int m = 0; m < 4; ++m)
#pragma unroll
                    for (int n = 0; n < 2; ++n) acc[ai][bj][m][n] = acc[ai][bj][m][n] * rs[ai][m];
    }
    __device__ __forceinline__ void operator()(const f32x4 (&acc)[2][2][4][2], const Unit& u, int wr, int wc, int fr, int fq) const {
        const int col0 = u.pn * BM + wc * 32 + 4 * fq;
        typedef unsigned u32x2 __attribute__((ext_vector_type(2)));
#pragma unroll
        for (int ai = 0; ai < 2; ++ai) {
            f32x4 pre[4][2][2];
#pragma unroll
            for (int m = 0; m < 4; ++m) { const int r = u.pm * BM + ai * HALF + wr * 64 + m * 16 + fr; const float* bp = base + (size_t)r * ldc;
#pragma unroll
                for (int bj = 0; bj < 2; ++bj)
#pragma unroll
                    for (int n = 0; n < 2; ++n) pre[m][bj][n] = __builtin_nontemporal_load((const f32x4*)(bp + col0 + bj * HALF + n * 16)); }
            asm volatile("" ::: "memory");
#pragma unroll
            for (int m = 0; m < 4; ++m) { const int r = u.pm * BM + ai * HALF + wr * 64 + m * 16 + fr;
                bf16_t* xp = xb + (size_t)r * ldc; float ss = 0.f;
#pragma unroll
                for (int bj = 0; bj < 2; ++bj)
#pragma unroll
                    for (int n = 0; n < 2; ++n) { const int c = col0 + bj * HALF + n * 16; const f32x4 x1 = pre[m][bj][n] + acc[ai][bj][m][n];
                        ss += (x1[0] * x1[0] + x1[1] * x1[1]) + (x1[2] * x1[2] + x1[3] * x1[3]);
                        u32x2 w; w.x = cvt_pk_bf16(x1[0], x1[1]); w.y = cvt_pk_bf16(x1[2], x1[3]); *(u32x2*)(xp + c) = w; }
                { auto r16 = __builtin_amdgcn_permlane16_swap(__float_as_uint(ss), __float_as_uint(ss), false, false); ss = __uint_as_float(r16[0]) + __uint_as_float(r16[1]);
                  auto r32 = __builtin_amdgcn_permlane32_swap(__float_as_uint(ss), __float_as_uint(ss), false, false); ss = __uint_as_float(r32[0]) + __uint_as_float(r32[1]); }
                if (fq == 0) atomicAdd(rowss + r, ss); }
            asm volatile("" ::: "memory");
        }
    }
};

struct EpiF32ResB {
    static constexpr bool PERM = false, AFTER_DRAIN = false, HAS_MID = false;
    const bf16_t* xb; float* out; int ldc;
    __device__ __forceinline__ void operator()(const f32x4 (&acc)[2][2][4][2], const Unit& u, int wr, int wc, int fr, int fq) const {
        const int col0 = u.pn * BM + wc * 32 + 4 * fq;
        typedef unsigned u32x2 __attribute__((ext_vector_type(2)));
#pragma unroll
        for (int ai = 0; ai < 2; ++ai) {
            u32x2 pre[4][2][2];
#pragma unroll
            for (int m = 0; m < 4; ++m) { const int r = u.pm * BM + ai * HALF + wr * 64 + m * 16 + fr; const bf16_t* bp = xb + (size_t)r * ldc;
#pragma unroll
                for (int bj = 0; bj < 2; ++bj)
#pragma unroll
                    for (int n = 0; n < 2; ++n) pre[m][bj][n] = __builtin_nontemporal_load((const u32x2*)(bp + col0 + bj * HALF + n * 16)); }
            asm volatile("" ::: "memory");
#pragma unroll
            for (int m = 0; m < 4; ++m) { const int r = u.pm * BM + ai * HALF + wr * 64 + m * 16 + fr; float* op = out + (size_t)r * ldc;
#pragma unroll
                for (int bj = 0; bj < 2; ++bj)
#pragma unroll
                    for (int n = 0; n < 2; ++n) { const u32x2 p = pre[m][bj][n];
                        const f32x4 x1 = (f32x4){__uint_as_float(p.x << 16), __uint_as_float(p.x & 0xffff0000u), __uint_as_float(p.y << 16), __uint_as_float(p.y & 0xffff0000u)};
                        __builtin_nontemporal_store(x1 + acc[ai][bj][m][n], (f32x4*)(op + col0 + bj * HALF + n * 16)); } }
            asm volatile("" ::: "memory");
        }
    }
};

template <class Epi, class Sched, bool ALIGN_EPI = false, bool SP2 = false>
__device__ __forceinline__ void gemm_phase(PG8_LAS unsigned char* lds, const Gemm g, const Sched& S, const Epi& E) {
    int tid_l = threadIdx.x; asm volatile("" : "+v"(tid_l));
    const int tid = tid_l, wid = __builtin_amdgcn_readfirstlane(tid >> 6), lane = tid & 63, wr = wid >> 2, wc = wid & 3, fr = lane & 15, fq = lane >> 4;
    const int K = g.K, nt = K / BK;
    unsigned voffA[2], voffB[2];
#pragma unroll
    for (int i = 0; i < 2; ++i) { int R, C; stage_rc(tid * 16 + i * 8192, R, C); const int Rb = Epi::PERM ? ((R & ~31) + perm32(R & 31)) : R;
        voffA[i] = (unsigned)(R * K + C) * 2u; voffB[i] = (unsigned)(Rb * K + C) * 2u; }
    const size_t kstep = (size_t)(BK * 2);
    const size_t hstep = (size_t)HALF * K * 2;
    const size_t tstep = 2 * hstep;
    const unsigned ldsw = (unsigned)wid * 1024u;
    const int aoff = lds_byte(wr * 64 + fr, fq * 8), boff = lds_byte(wc * 32 + fr, fq * 8);
#define PG8_SA(b, h) (((b) * 2 + (h)) * HTB)
#define PG8_SB(b, h) ((4 + (b) * 2 + (h)) * HTB)
#define PG8_STAGE(bufoff, gbase, voff) do { _Pragma("unroll") for (int _i = 0; _i < 2; ++_i) \
        __builtin_amdgcn_global_load_lds((const unsigned*)((const char*)(gbase) + (voff)[_i]), (PG8_LAS unsigned*)(lds + (bufoff) + ldsw + _i * 8192), 16, 0, 0); } while (0)
#define PG8_LDA(dst, b, h) do { _Pragma("unroll") for (int m = 0; m < 4; ++m) _Pragma("unroll") for (int k = 0; k < 2; ++k) dst[m][k] = *(const PG8_LAS bf16x8*)(lds + PG8_SA(b, h) + aoff + m * 2048 + k * 1024); } while (0)
#define PG8_LDB(dst, b, h) do { _Pragma("unroll") for (int n = 0; n < 2; ++n) _Pragma("unroll") for (int k = 0; k < 2; ++k) dst[n][k] = *(const PG8_LAS bf16x8*)(lds + PG8_SB(b, h) + boff + n * 2048 + k * 1024); } while (0)
#define PG8_MMA(ai, bj, At, Bt) do { __builtin_amdgcn_s_setprio(1); _Pragma("unroll") for (int m = 0; m < 4; ++m) _Pragma("unroll") for (int n = 0; n < 2; ++n) _Pragma("unroll") for (int k = 0; k < 2; ++k) \
        acc[ai][bj][m][n] = __builtin_amdgcn_mfma_f32_16x16x32_bf16(Bt[n][k], At[m][k], acc[ai][bj][m][n], 0, 0, 0); __builtin_amdgcn_s_setprio(0); } while (0)
#define PG8_WAIT_V(n) asm volatile("s_waitcnt vmcnt(" #n ")" ::: "memory")
#define PG8_WAIT_L(n) asm volatile("s_waitcnt lgkmcnt(" #n ")" ::: "memory")
#define PG8_BAR __builtin_amdgcn_s_barrier()
#define PG8_SCHED __builtin_amdgcn_sched_barrier(0)
    Unit cur, nxt; int ui = 0;
    if (!S.next(0, cur)) return;
    f32x4 acc[2][2][4][2];
#pragma unroll
    for (int a = 0; a < 2; ++a)
#pragma unroll
        for (int b = 0; b < 2; ++b)
#pragma unroll
            for (int m = 0; m < 4; ++m)
#pragma unroll
                for (int n = 0; n < 2; ++n) acc[a][b][m][n] = (f32x4){0.f, 0.f, 0.f, 0.f};
    bf16x8 At[4][2], B0[2][2], B1[2][2];
    const char* cA = (const char*)g.A + (size_t)cur.pm * tstep; const char* cB = (const char*)g.Bt + (size_t)cur.pn * tstep;
    S.a_ready(cur);
    if constexpr (SP2) {
        PG8_STAGE(PG8_SB(0, 0), cB, voffB); PG8_STAGE(PG8_SB(0, 1), cB + hstep, voffB); PG8_STAGE(PG8_SA(0, 0), cA, voffA); PG8_STAGE(PG8_SA(0, 1), cA + hstep, voffA);
        if (wr == 1) PG8_BAR;
        PG8_WAIT_V(2); PG8_BAR;
        PG8_STAGE(PG8_SB(1, 0), cB + kstep, voffB); PG8_STAGE(PG8_SA(1, 0), cA + kstep, voffA); PG8_STAGE(PG8_SB(1, 1), cB + hstep + kstep, voffB);
        PG8_WAIT_V(6); PG8_BAR;
    } else {
        PG8_STAGE(PG8_SB(0, 0), cB, voffB); PG8_STAGE(PG8_SA(0, 0), cA, voffA); PG8_STAGE(PG8_SB(0, 1), cB + hstep, voffB); PG8_STAGE(PG8_SA(0, 1), cA + hstep, voffA);
        if (wr == 1) PG8_BAR;
        PG8_WAIT_V(4); PG8_BAR;
        PG8_STAGE(PG8_SB(1, 0), cB + kstep, voffB); PG8_STAGE(PG8_SA(1, 0), cA + kstep, voffA); PG8_STAGE(PG8_SB(1, 1), cB + hstep + kstep, voffB);
        PG8_WAIT_V(6); PG8_BAR;
    }
    for (;;) {
        const bool has_next = S.next(ui + 1, nxt);
        const char* nA = has_next ? (const char*)g.A + (size_t)nxt.pm * tstep : cA; const char* nB = has_next ? (const char*)g.Bt + (size_t)nxt.pn * tstep : cB;
        for (int t = 0; t < nt; t += 2) {
            const bool last = (t == nt - 2);
            const char* a1 = cA + (size_t)(t + 1) * kstep;
            const char* a2 = last ? nA : cA + (size_t)(t + 2) * kstep; const char* b2 = last ? nB : cB + (size_t)(t + 2) * kstep;
            const char* a3 = a2 + kstep; const char* b3 = b2 + kstep;
            if (last && has_next) S.a_ready(nxt);
            if constexpr (Epi::HAS_MID) E.mid(acc, cur, t, wr, fr);
            if constexpr (SP2) {
            PG8_LDB(B0, 0, 0); PG8_LDB(B1, 0, 1); PG8_SCHED; PG8_LDA(At, 0, 0); PG8_STAGE(PG8_SA(1, 1), a1 + hstep, voffA);
            PG8_WAIT_V(8); PG8_WAIT_L(0); PG8_BAR; PG8_MMA(0, 0, At, B0); PG8_MMA(0, 1, At, B1); PG8_BAR; PG8_SCHED;
            PG8_LDA(At, 0, 1); PG8_STAGE(PG8_SB(0, 0), b2, voffB); PG8_STAGE(PG8_SB(0, 1), b2 + hstep, voffB); PG8_STAGE(PG8_SA(0, 0), a2, voffA);
            PG8_WAIT_V(8); PG8_WAIT_L(0); PG8_BAR; PG8_MMA(1, 0, At, B0); PG8_MMA(1, 1, At, B1); PG8_BAR; PG8_SCHED;
            PG8_LDB(B0, 1, 0); PG8_LDB(B1, 1, 1); PG8_SCHED; PG8_LDA(At, 1, 0); PG8_STAGE(PG8_SA(0, 1), a2 + hstep, voffA);
            PG8_WAIT_V(8); PG8_WAIT_L(0); PG8_BAR; PG8_MMA(0, 0, At, B0); PG8_MMA(0, 1, At, B1); PG8_BAR; PG8_SCHED;
            PG8_LDA(At, 1, 1); PG8_STAGE(PG8_SB(1, 0), b3, voffB); PG8_STAGE(PG8_SB(1, 1), b3 + hstep, voffB); PG8_STAGE(PG8_SA(1, 0), a3, voffA);
            PG8_WAIT_V(8); PG8_WAIT_L(0); PG8_BAR; PG8_MMA(1, 0, At, B0); PG8_MMA(1, 1, At, B1); PG8_BAR; PG8_SCHED;
            } else {
            PG8_LDB(B0, 0, 0); PG8_SCHED; PG8_LDA(At, 0, 0); PG8_STAGE(PG8_SA(1, 1), a1 + hstep, voffA);
            PG8_WAIT_L(8); PG8_BAR; PG8_WAIT_L(0); PG8_MMA(0, 0, At, B0); PG8_BAR; PG8_SCHED;
            PG8_LDB(B1, 0, 1); PG8_STAGE(PG8_SB(0, 0), b2, voffB);
            PG8_BAR; PG8_WAIT_L(0); PG8_MMA(0, 1, At, B1); PG8_BAR;
            PG8_LDA(At, 0, 1); PG8_STAGE(PG8_SA(0, 0), a2, voffA);
            PG8_BAR; PG8_WAIT_L(0); PG8_MMA(1, 0, At, B0); PG8_BAR; PG8_SCHED;
            PG8_STAGE(PG8_SB(0, 1), b2 + hstep, voffB);
            PG8_WAIT_V(6); PG8_BAR; PG8_MMA(1, 1, At, B1); PG8_BAR;
            PG8_LDB(B0, 1, 0); PG8_SCHED; PG8_LDA(At, 1, 0); PG8_STAGE(PG8_SA(0, 1), a2 + hstep, voffA);
            PG8_WAIT_L(8); PG8_BAR; PG8_WAIT_L(0); PG8_MMA(0, 0, At, B0); PG8_BAR; PG8_SCHED;
            PG8_LDB(B1, 1, 1); PG8_STAGE(PG8_SB(1, 0), b3, voffB);
            PG8_BAR; PG8_WAIT_L(0); PG8_MMA(0, 1, At, B1); PG8_BAR;
            PG8_LDA(At, 1, 1); PG8_STAGE(PG8_SA(1, 0), a3, voffA);
            PG8_BAR; PG8_WAIT_L(0); PG8_MMA(1, 0, At, B0); PG8_BAR; PG8_SCHED;
            PG8_STAGE(PG8_SB(1, 1), b3 + hstep, voffB);
            PG8_WAIT_V(6); PG8_BAR; PG8_MMA(1, 1, At, B1); PG8_BAR;
            }
        }
        if constexpr (ALIGN_EPI) { if (wr == 0) PG8_BAR; }
        if constexpr (!Epi::AFTER_DRAIN) { E(acc, cur, wr, wc, fr, fq); S.done(cur); }
        if (!has_next) break;
#pragma unroll
        for (int a = 0; a < 2; ++a)
#pragma unroll
            for (int b = 0; b < 2; ++b)
#pragma unroll
                for (int m = 0; m < 4; ++m)
#pragma unroll
                    for (int n = 0; n < 2; ++n) acc[a][b][m][n] = (f32x4){0.f, 0.f, 0.f, 0.f};
        cur = nxt; cA = nA; cB = nB; ++ui;
        if constexpr (ALIGN_EPI) { if (wr == 1) PG8_BAR; }
    }
    PG8_WAIT_V(0);
    if constexpr (!ALIGN_EPI) { if (wr == 0) PG8_BAR; }
    PG8_BAR;
    if constexpr (Epi::AFTER_DRAIN) { E.fused(acc, cur, wr, wc, fr, fq, lds, wid, lane); S.done(cur); }
#undef PG8_SA
#undef PG8_SB
#undef PG8_STAGE
#undef PG8_LDA
#undef PG8_LDB
#undef PG8_MMA
#undef PG8_WAIT_V
#undef PG8_WAIT_L
#undef PG8_BAR
#undef PG8_SCHED
}
}

#ifndef MK_N_LAUNCHES
#define MK_N_LAUNCHES 1
#endif
constexpr int N_PHASES = 11;
constexpr int NWAVES = 8;

constexpr int DM = 1024, NB = 8, SEQ = 2048, NMETA = 16, TP = SEQ + NMETA  , DB = 128, DS = 4, PAST = 8192, PAGE = 128, NPAGES = 64;
constexpr int NH = 8, QKN = 64, QKR = 32, VH = 64, QKH = 96, QL = 384, KVL = 256, AW = 512, CC = 512, DFF = 4096;
constexpr int INW = 2208, INWP = 2304;
constexpr int MP = NB * SEQ;
constexpr int MS = DB * DS;
constexpr int MR = MP + MS;
constexpr int MMETA0 = MR;
constexpr int MALL = MR + NMETA;
constexpr int MPAD = 17152;
constexpr int TPP = 2112;
constexpr float EPS = 1e-6f;
constexpr float QSCALE = 0.10206207261596577f * 1.4426950408889634f;
constexpr int SA_NS = 2;

constexpr size_t O_YP = 0, O_YS = O_YP + (size_t)MP * DM, O_LATP = O_YS + (size_t)MS * DM, O_KPEP = O_LATP + (size_t)NB * TP * KVL, O_CONVP = O_KPEP + (size_t)NB * TP * QKR,
                 O_LATS = O_CONVP + (size_t)NB * 2 * CC, O_KPES = O_LATS + (size_t)MS * KVL, O_CONVS = O_KPES + (size_t)MS * QKR, O_END = O_CONVS + (size_t)DB * 2 * CC;

constexpr size_t MiB = 1u << 20;
constexpr size_t WS_CTL = 0, CTL_ZERO_BYTES = 1 * MiB;
constexpr size_t WS_ROWSS = 512 * 1024;
constexpr size_t WS_WIN = 2 * MiB;
constexpr size_t WS_WUQ = 7 * MiB;
constexpr size_t WS_WUKV = 8 * MiB;
constexpr size_t WS_WUKVB = 9 * MiB;
constexpr size_t WS_WF8 = 9 * MiB + 512 * 1024;
constexpr size_t WS_WO = 10 * MiB;
constexpr size_t WS_WUP = 12 * MiB;
constexpr size_t WS_WDN = 20 * MiB;
constexpr size_t WS_ROPE = 28 * MiB;
constexpr size_t WS_XN = 32 * MiB;
constexpr size_t WS_Z = 68 * MiB;
constexpr size_t WS_CQN = 146 * MiB;
constexpr size_t WS_LATB = 160 * MiB;
constexpr size_t WS_KPER = 170 * MiB;
constexpr size_t WS_QRAW = 174 * MiB;
constexpr size_t WS_KVRAW = 200 * MiB;
constexpr size_t WS_Q = 236 * MiB;
constexpr size_t WS_SSQ = 236 * MiB;
constexpr size_t WS_KSS = 238 * MiB;
constexpr size_t WS_RSA = 237 * MiB;
constexpr size_t WS_K = 262 * MiB;
constexpr size_t WS_V = 288 * MiB;
constexpr size_t WS_MIX = 306 * MiB;
constexpr size_t WS_PART = 342 * MiB;
constexpr size_t WS_LPART = 360 * MiB;
constexpr size_t WS_NEWLAT = 352 * MiB;
constexpr size_t WS_NEWKPE = 357 * MiB;
constexpr size_t WS_H = WS_Z;
constexpr size_t WS_END = 500 * MiB;
constexpr int CW_BAR = 4096;

constexpr int RING_OFF = 0, RING_BYTES = 131072;
constexpr int LDS_BYTES = 163840;
constexpr int LDSCTL_OFF = LDS_BYTES - 512, MISC_OFF = LDSCTL_OFF + 320;

#define GAS __attribute__((address_space(1)))
#define LAS __attribute__((address_space(3)))
typedef unsigned short bf16;
typedef unsigned v4u __attribute__((ext_vector_type(4)));
typedef unsigned v2u __attribute__((ext_vector_type(2)));
typedef float f32x4 __attribute__((ext_vector_type(4)));
typedef float f32x16 __attribute__((ext_vector_type(16)));
typedef short bf16x8 __attribute__((ext_vector_type(8)));
typedef short s16x4 __attribute__((ext_vector_type(4)));
typedef GAS unsigned gu32;
#define RLX_AGENT __ATOMIC_RELAXED, __HIP_MEMORY_SCOPE_AGENT
#define LDS_WAIT() asm volatile("s_waitcnt lgkmcnt(0)" ::: "memory")
#define VM_WAIT() asm volatile("s_waitcnt vmcnt(0)" ::: "memory")
typedef float f32x2_t __attribute__((ext_vector_type(2))); typedef __bf16 bf16x2_t __attribute__((ext_vector_type(2)));
#define NTS(v, p) __builtin_nontemporal_store((v), (p))
#define NTL(p) __builtin_nontemporal_load(p)
__device__ __forceinline__ unsigned pk2(float lo, float hi) { f32x2_t v = {lo, hi}; bf16x2_t b = __builtin_convertvector(v, bf16x2_t); return __builtin_bit_cast(unsigned, b); }
__device__ __forceinline__ float bflo(unsigned w) { return __uint_as_float(w << 16); }
__device__ __forceinline__ float bfhi(unsigned w) { return __uint_as_float(w & 0xffff0000u); }
__device__ __forceinline__ void unpack8(const v4u x, float (&e)[8]) { e[0] = bflo(x.x); e[1] = bfhi(x.x); e[2] = bflo(x.y); e[3] = bfhi(x.y); e[4] = bflo(x.z); e[5] = bfhi(x.z); e[6] = bflo(x.w); e[7] = bfhi(x.w); }
__device__ __forceinline__ v4u pack8(const float (&e)[8]) { v4u o; o.x = pk2(e[0], e[1]); o.y = pk2(e[2], e[3]); o.z = pk2(e[4], e[5]); o.w = pk2(e[6], e[7]); return o; }
__device__ __forceinline__ float bf1(bf16 b) { return __uint_as_float((unsigned)b << 16); }
#define XB_TMO      128
#define XB_XCNT(j)  (256  + 64 * (j))
#define XB_XSUB(j)  (1280 + 64 * (j))
#define XB_XGEN(j)  (2304 + 64 * (j))
#define XB_TOP      3328
#define XB_TOPGEN   3392
#define XCD_BAR_WORDS 3456
#define XB_SPIN_CAP (1u << 18)

__device__ __forceinline__ unsigned xb_ld(unsigned* p)              { return __hip_atomic_load(p, __ATOMIC_RELAXED, __HIP_MEMORY_SCOPE_AGENT); }
__device__ __forceinline__ unsigned xb_add(unsigned* p, unsigned v) { return __hip_atomic_fetch_add(p, v, __ATOMIC_RELAXED, __HIP_MEMORY_SCOPE_AGENT); }
__device__ __forceinline__ unsigned xb_xcc_id() { return (unsigned)__builtin_amdgcn_s_getreg((3 << 11) | 20) & 0xFu; }
#define XB_SPIN(cond, bar) do { unsigned _sp = 0; while (cond) { __builtin_amdgcn_s_sleep(1); \
    if ((++_sp & 255u) == 0u) { if (xb_ld(&(bar)[XB_TMO])) break; if (_sp > XB_SPIN_CAP) { atomicAdd(&(bar)[XB_TMO], 1u); break; } } } } while (0)

struct XcdBarrier {
    unsigned* bar; unsigned x;
    volatile LAS unsigned* st;
};

__device__ __forceinline__ XcdBarrier xcd_barrier_post(unsigned* bar, volatile LAS unsigned* st) {
    XcdBarrier b; b.bar = bar; b.x = xb_xcc_id(); b.st = st;
    if (threadIdx.x == 0) (void)xb_add(&bar[XB_XCNT(b.x)], 1u);
    return b;
}
__device__ __forceinline__ void xcd_barrier_complete(unsigned* bar, unsigned x, unsigned& nloc, unsigned& nx) {
    const unsigned G = gridDim.x * gridDim.y * gridDim.z;
    unsigned sum, cnt, mine, sp = 0u;
    for (;;) {
        sum = 0u; cnt = 0u; mine = 0u;
#pragma unroll
        for (unsigned j = 0; j < 16; ++j) { const unsigned c = xb_ld(&bar[XB_XCNT(j)]); sum += c; cnt += (c > 0u) ? 1u : 0u; mine = (j == x) ? c : mine; }
        if (sum == G) break;
        __builtin_amdgcn_s_sleep(1);
        if ((++sp & 255u) == 0u) { if (xb_ld(&bar[XB_TMO])) break; if (sp > XB_SPIN_CAP) { atomicAdd(&bar[XB_TMO], 1u); break; } }
    }
    nloc = mine > 0u ? mine : 1u; nx = cnt > 0u ? cnt : 1u;
}

__device__ __forceinline__ void xcd_barrier(const XcdBarrier& b) {
    asm volatile("s_waitcnt vmcnt(0)" ::: "memory");
    __syncthreads();
    if (threadIdx.x == 0) {
        unsigned* bar = b.bar;
        __builtin_amdgcn_s_waitcnt(0);
        unsigned nloc = b.st[0], nx = b.st[1];
        if (nloc == 0u) { xcd_barrier_complete(bar, b.x, nloc, nx); b.st[0] = nloc; b.st[1] = nx; }
        const unsigned old = xb_add(&bar[XB_XSUB(b.x)], 1u);
        const unsigned gen = old / nloc;
        if (old + 1u == (gen + 1u) * nloc) {
            __builtin_amdgcn_fence(__ATOMIC_RELEASE, "agent");
            asm volatile("s_waitcnt vmcnt(0)" ::: "memory");
            const unsigned og = xb_add(&bar[XB_TOP], 1u);
            const unsigned tg = og / nx;
            if (og + 1u == (tg + 1u) * nx) xb_add(&bar[XB_TOPGEN], 1u);
            else XB_SPIN(xb_ld(&bar[XB_TOPGEN]) == tg, bar);
            __builtin_amdgcn_fence(__ATOMIC_ACQUIRE, "agent");
            xb_add(&bar[XB_XGEN(b.x)], 1u);
            asm volatile("s_waitcnt vmcnt(0)" ::: "memory");
        } else {
            XB_SPIN(xb_ld(&bar[XB_XGEN(b.x)]) == gen, bar);
            __builtin_amdgcn_fence(__ATOMIC_ACQUIRE, "agent");
            asm volatile("s_waitcnt vmcnt(0)" ::: "memory");
        }
    }
    __syncthreads();
}

struct Params {
    const float* x_prompt; const float* x_sample; const float* cache_lat; const float* cache_kpe; const float* state_conv; const int* page_table; const float* meta;
    const float* norm_mix_g; const float* w_in; const float* q_lora_g; const float* kv_lora_g; const float* w_uq; const float* w_ukv; const float* q_norm_g; const float* k_norm_g;
    const float* conv_w; const float* conv_b; const float* attn_out_g; const float* conv_out_g; const float* w_o; const float* norm_ffn_g; const float* w_up; const float* w_down;
    float* out; unsigned char* ws; int ph_lo, ph_hi, li, pad;
};
struct Frame {
    LAS unsigned char* lds;
    volatile LAS unsigned* MISC;
    gu32* ctl;
    int tid, lane, wave, G, gw, NGW;
};
__device__ __forceinline__ float wave_sum(float v) {
#pragma unroll
    for (int o = 1; o < 64; o <<= 1) v += __shfl_xor(v, o);
    return v;
}

__device__ __forceinline__ void p0_transpose_item(const float* W, int K, int N, bf16* WT, LAS float* scr, int item, int lane, const float* kscale = nullptr, int klim = 1 << 30) {
    const int nblk = N / 32, kb = item / nblk, nb = item % nblk, k0 = 64 * kb, n0 = 32 * nb;
#pragma unroll 16
    for (int i = 0; i < 32; ++i) { const int kk = 2 * i + (lane >> 5); scr[kk * 33 + (lane & 31)] = NTL(&W[(size_t)(k0 + kk) * N + n0 + (lane & 31)]) * ((kscale && k0 < klim) ? kscale[k0 + kk] : 1.0f); }
    LDS_WAIT(); asm volatile("" ::: "memory");
    const int c = lane & 7;
#pragma unroll
    for (int j = 0; j < 4; ++j) { const int n = (lane >> 3) + 8 * j; const LAS float* s = scr + (8 * c) * 33 + n;
        v4u o; o.x = pk2(s[0 * 33], s[1 * 33]); o.y = pk2(s[2 * 33], s[3 * 33]); o.z = pk2(s[4 * 33], s[5 * 33]); o.w = pk2(s[6 * 33], s[7 * 33]);
        *(GAS v4u*)(WT + (size_t)(n0 + n) * K + k0 + 8 * c) = o; }
    LDS_WAIT(); asm volatile("" ::: "memory");
}
__device__ __forceinline__ void rms_row_to_bf16(const float* xrow, const float* g, bf16* orow, int lane) {
    const GAS f32x4* xr = (const GAS f32x4*)xrow + lane; const GAS f32x4* gr = (const GAS f32x4*)g + lane;
    f32x4 v[4]; float s = 0.f;
#pragma unroll
    for (int j = 0; j < 4; ++j) { v[j] = NTL(xr + 64 * j); s += (v[j].x * v[j].x + v[j].y * v[j].y) + (v[j].z * v[j].z + v[j].w * v[j].w); }
    const float rs = 1.0f / sqrtf(wave_sum(s) * (1.f / DM) + EPS);
    GAS v2u* o8 = (GAS v2u*)orow + lane;
#pragma unroll
    for (int j = 0; j < 4; ++j) { const f32x4 gg = gr[64 * j]; v2u w; w.x = pk2(v[j].x * rs * gg.x, v[j].y * rs * gg.y); w.y = pk2(v[j].z * rs * gg.z, v[j].w * rs * gg.w); o8[64 * j] = w; }
}
__device__ __forceinline__ void p0_prologue(const Params& P, Frame& F) {
    unsigned char* ws = P.ws;
    LAS float* scr = (LAS float*)(F.lds + RING_OFF + F.wave * 16384);
    constexpr int I_IN = (DM / 64) * (INW / 32);
    for (int it = F.gw; it < I_IN; it += F.NGW) p0_transpose_item(P.w_in, DM, INW, (bf16*)(ws + WS_WIN), scr, it, F.lane);
    const int gt = F.gw * 64 + F.lane, NGT = F.NGW * 64;
    for (int i = gt; i < 96 * 128; i += NGT) ((GAS v4u*)(ws + WS_WIN + (size_t)INW * DM * 2))[i] = (v4u){0u, 0u, 0u, 0u};
    for (int i = gt; i < (MPAD - MALL) * DM / 8; i += NGT) ((GAS v4u*)(ws + WS_XN + (size_t)MALL * DM * 2))[i] = (v4u){0u, 0u, 0u, 0u};
    bf16* XN = (bf16*)(ws + WS_XN);
    {
        const int lane = F.lane;
        f32x4 gg[4];
#pragma unroll
        for (int j = 0; j < 4; ++j) gg[j] = ((const GAS f32x4*)P.norm_mix_g)[lane + 64 * j];
#define P0_SRC(m) (((m) < MP) ? P.x_prompt + (size_t)(m) * DM : ((m) < MR) ? P.x_sample + (size_t)((m) - MP) * DM : P.meta + (size_t)((m) - MR) * DM)
        int m = F.gw;
        f32x4 vn[4];
        if (m < MALL) { const GAS f32x4* xr = (const GAS f32x4*)P0_SRC(m) + lane;
#pragma unroll
            for (int j = 0; j < 4; ++j) vn[j] = NTL(xr + 64 * j); }
        while (m < MALL) {
            f32x4 v[4];
#pragma unroll
            for (int j = 0; j < 4; ++j) v[j] = vn[j];
            const int m2 = m + F.NGW;
            if (m2 < MALL) { const GAS f32x4* xr = (const GAS f32x4*)P0_SRC(m2) + lane;
#pragma unroll
                for (int j = 0; j < 4; ++j) vn[j] = NTL(xr + 64 * j); }
            float ss = 0.f;
#pragma unroll
            for (int j = 0; j < 4; ++j) ss += (v[j].x * v[j].x + v[j].y * v[j].y) + (v[j].z * v[j].z + v[j].w * v[j].w);
            const float rs = 1.0f / sqrtf(wave_sum(ss) * (1.f / DM) + EPS);
            GAS v2u* o8 = (GAS v2u*)(XN + (size_t)m * DM) + lane;
#pragma unroll
            for (int j = 0; j < 4; ++j) { v2u w; w.x = pk2(v[j].x * rs * gg[j].x, v[j].y * rs * gg[j].y); w.y = pk2(v[j].z * rs * gg[j].z, v[j].w * rs * gg[j].w); o8[64 * j] = w; }
            m = m2;
        }
#undef P0_SRC
    }
}
__device__ __forceinline__ void p0_late(const Params& P, Frame& F, int wv, int nwv) {
    unsigned char* ws = P.ws;
    LAS float* scr = (LAS float*)(F.lds + RING_OFF + F.wave * 16384);
    constexpr int I_UQ = (QL / 64) * (768 / 32), I_UKV = (KVL / 64) * (1024 / 32), I_O = (DM / 64) * (DM / 32), I_UP = (DM / 64) * (DFF / 32), I_DN = (DFF / 64) * (DM / 32);
    constexpr int NITEMS = I_UQ + I_UKV + I_O + I_UP + I_DN;
    for (int it = wv; it < NITEMS; it += nwv) {
        int r = it;
        if (r < I_UQ) { p0_transpose_item(P.w_uq, QL, 768, (bf16*)(ws + WS_WUQ), scr, r, F.lane); continue; } r -= I_UQ;
        if (r < I_UKV) { p0_transpose_item(P.w_ukv, KVL, 1024, (bf16*)(ws + WS_WUKV), scr, r, F.lane); continue; } r -= I_UKV;
        if (r < I_O) { p0_transpose_item(P.w_o, DM, DM, (bf16*)(ws + WS_WO), scr, r, F.lane, P.attn_out_g, AW); continue; } r -= I_O;
        if (r < I_UP) { p0_transpose_item(P.w_up, DM, DFF, (bf16*)(ws + WS_WUP), scr, r, F.lane, P.norm_ffn_g); continue; } r -= I_UP;
        p0_transpose_item(P.w_down, DFF, DM, (bf16*)(ws + WS_WDN), scr, r, F.lane);
    }
    const int gt = wv * 64 + F.lane, NGT = nwv * 64;
    for (int i = gt; i < KVL * 1024 / 8; i += NGT) { const f32x4 a = ((const GAS f32x4*)P.w_ukv)[2 * i], b = ((const GAS f32x4*)P.w_ukv)[2 * i + 1];
        v4u o; o.x = pk2(a.x, a.y); o.y = pk2(a.z, a.w); o.z = pk2(b.x, b.y); o.w = pk2(b.z, b.w); ((GAS v4u*)(ws + WS_WUKVB))[i] = o; }
    for (int i = gt; i < 512 * 64; i += NGT) { const int n = i >> 6, c4 = i & 63, col = (n >> 6) * 128 + (n & 63); const float* wp = P.w_ukv + (size_t)(4 * c4) * 1024 + col;
        int w = 0; w = __builtin_amdgcn_cvt_pk_fp8_f32(16.f * wp[0], 16.f * wp[1024], w, false); w = __builtin_amdgcn_cvt_pk_fp8_f32(16.f * wp[2048], 16.f * wp[3072], w, true);
        ((int*)(ws + WS_WF8))[i] = w; }
    for (int i = gt; i < 2068 * 16; i += NGT) { const int p = i >> 4, f = i & 15; const double pos = (p < TP) ? (double)p : (double)(PAST + (p - TP));
        const double f4 = (f & 3) == 0 ? 1.0 : (f & 3) == 1 ? 5.62341325190349072827e-01 : (f & 3) == 2 ? 3.16227766016837941176e-01 : 1.77827941003892292526e-01;
        const double dec = (f >> 2) == 0 ? 1.0 : (f >> 2) == 1 ? 1e-1 : (f >> 2) == 2 ? 1e-2 : 1e-3;
        const double ang = pos * (f4 * dec); const double kq = rint(ang * 0.15915494309189533577); const double rr = fma(-kq, 6.283185307179586232, ang) - kq * 2.4492935982947064e-16;
        const float rf = (float)rr;
        ((float*)(ws + WS_ROPE))[i] = cosf(rf); ((float*)(ws + WS_ROPE))[2068 * 16 + i] = sinf(rf); }
    for (int i = gt; i < NB * (TPP - TP) * 768 / 8; i += NGT) { const int b = i / ((TPP - TP) * 96), r = i % ((TPP - TP) * 96); ((GAS v4u*)(ws + WS_K + ((size_t)(b * TPP + TP) * 768) * 2))[r] = (v4u){0u, 0u, 0u, 0u}; }
    for (int i = gt; i < DB * 32 * KVL / 4; i += NGT) ((GAS f32x4*)(ws + WS_NEWLAT))[i] = (f32x4){0.f, 0.f, 0.f, 0.f};
    for (int i = gt; i < DB * 32 * QKR / 4; i += NGT) ((GAS f32x4*)(ws + WS_NEWKPE))[i] = (f32x4){0.f, 0.f, 0.f, 0.f};
}

__device__ __forceinline__ void conv_u(const bf16* zrow, int lane, float (&u)[8]) {
    float a[8], b[8]; unpack8(*(const GAS v4u*)(zrow + 1184 + 8 * lane), a); unpack8(*(const GAS v4u*)(zrow + 1696 + 8 * lane), b);
#pragma unroll
    for (int i = 0; i < 8; ++i) u[i] = a[i] * b[i];
}
__device__ __forceinline__ void p2a_row(const Params& P, Frame& F, int r) {
    unsigned char* ws = P.ws; const int lane = F.lane;
    const bf16* Z = (const bf16*)(ws + WS_Z); const bf16* z = Z + (size_t)r * INWP;
    int kind, b, t, pidx;
    if (r < MP) { kind = 0; b = r >> 11; t = r & 2047; pidx = t + NMETA; }
    else if (r < MR) { kind = 1; b = (r - MP) >> 2; t = (r - MP) & 3; pidx = TP + t; }
    else { kind = 2; b = 0; t = r - MR; pidx = t; }
    const int l48p = lane < 48 ? lane : 0, l32p = lane & 31;
    const v4u zq_ = *(const GAS v4u*)(z + 8 * l48p), zk_ = *(const GAS v4u*)(z + 384 + 8 * l32p);
    const bf16 zp_ = z[640 + l32p];
    const float* rope_ = (const float*)(ws + WS_ROPE); const float rc_ = rope_[pidx * 16 + (l32p & 15)], rsn_ = rope_[2068 * 16 + pidx * 16 + (l32p & 15)];
    const f32x4 qg0_ = *(const GAS f32x4*)(P.q_lora_g + 8 * l48p), qg1_ = *(const GAS f32x4*)(P.q_lora_g + 8 * l48p + 4);
    const f32x4 kg0_ = *(const GAS f32x4*)(P.kv_lora_g + 8 * l32p), kg1_ = *(const GAS f32x4*)(P.kv_lora_g + 8 * l32p + 4);
    v4u zb_ = {0u, 0u, 0u, 0u}, zg0_ = zb_, zh0_ = zb_, zg1_ = zb_, zh1_ = zb_, zg2_ = zb_, zh2_ = zb_;
    f32x4 cb_[2], cw_[3][2], og_[2];
#pragma unroll
    for (int q = 0; q < 2; ++q) { cb_[q] = (f32x4){0.f, 0.f, 0.f, 0.f}; og_[q] = cb_[q]; cw_[0][q] = cb_[q]; cw_[1][q] = cb_[q]; cw_[2][q] = cb_[q]; }
    if (kind != 2) {
        zb_ = *(const GAS v4u*)(z + 672 + 8 * lane); zg0_ = *(const GAS v4u*)(z + 1184 + 8 * lane); zh0_ = *(const GAS v4u*)(z + 1696 + 8 * lane);
#pragma unroll
        for (int q = 0; q < 2; ++q) { cb_[q] = *(const GAS f32x4*)(P.conv_b + 8 * lane + 4 * q); og_[q] = *(const GAS f32x4*)(P.conv_out_g + 8 * lane + 4 * q);
            cw_[0][q] = *(const GAS f32x4*)(P.conv_w + 8 * lane + 4 * q); cw_[1][q] = *(const GAS f32x4*)(P.conv_w + CC + 8 * lane + 4 * q); cw_[2][q] = *(const GAS f32x4*)(P.conv_w + 2 * CC + 8 * lane + 4 * q); }
        if (kind == 0) {
            const bf16* z1 = (t >= 1) ? z - INWP : Z + (size_t)(MMETA0 + 15) * INWP;
            const bf16* z2 = (t >= 2) ? z - 2 * INWP : Z + (size_t)(MMETA0 + 14 + t) * INWP;
            zg1_ = *(const GAS v4u*)(z1 + 1184 + 8 * lane); zh1_ = *(const GAS v4u*)(z1 + 1696 + 8 * lane); zg2_ = *(const GAS v4u*)(z2 + 1184 + 8 * lane); zh2_ = *(const GAS v4u*)(z2 + 1696 + 8 * lane);
        }
    }
    if (kind != 2) {
        float v[8]; unpack8(zq_, v);
        float ss = 0.f;
#pragma unroll
        for (int i = 0; i < 8; ++i) ss += v[i] * v[i];
        if (lane >= 48) ss = 0.f;
        const float rs = 1.0f / sqrtf(wave_sum(ss) * (1.f / QL) + EPS);
        if (lane < 48) { const f32x4 g0 = qg0_, g1 = qg1_;
            float o[8] = {v[0] * rs * g0.x, v[1] * rs * g0.y, v[2] * rs * g0.z, v[3] * rs * g0.w, v[4] * rs * g1.x, v[5] * rs * g1.y, v[6] * rs * g1.z, v[7] * rs * g1.w};
            *(GAS v4u*)((bf16*)(ws + WS_CQN) + (size_t)r * QL + 8 * lane) = pack8(o); }
    }
    {
        float v[8]; unpack8(zk_, v);
        float ss = 0.f;
#pragma unroll
        for (int i = 0; i < 8; ++i) ss += v[i] * v[i];
        if (lane >= 32) ss = 0.f;
        const float rs = 1.0f / sqrtf(wave_sum(ss) * (1.f / KVL) + EPS);
        if (lane < 32) { const f32x4 g0 = kg0_, g1 = kg1_;
            float o[8] = {v[0] * rs * g0.x, v[1] * rs * g0.y, v[2] * rs * g0.z, v[3] * rs * g0.w, v[4] * rs * g1.x, v[5] * rs * g1.y, v[6] * rs * g1.z, v[7] * rs * g1.w};
            *(GAS v4u*)((bf16*)(ws + WS_LATB) + (size_t)r * KVL + 8 * lane) = pack8(o);
            const f32x4 o0 = {o[0], o[1], o[2], o[3]}, o1 = {o[4], o[5], o[6], o[7]};
            if (kind == 0) { float* d = P.out + O_LATP + ((size_t)(b * TP + NMETA + t)) * KVL + 8 * lane; NTS(o0, (GAS f32x4*)d); NTS(o1, (GAS f32x4*)(d + 4)); }
            else if (kind == 1) { float* d = P.out + O_LATS + ((size_t)(b * DS + t)) * KVL + 8 * lane; NTS(o0, (GAS f32x4*)d); NTS(o1, (GAS f32x4*)(d + 4));
                float* d2 = (float*)(ws + WS_NEWLAT) + ((size_t)(b * 32 + t)) * KVL + 8 * lane; *(GAS f32x4*)d2 = o0; *(GAS f32x4*)(d2 + 4) = o1; }
            else { for (int bb = 0; bb < NB; ++bb) { float* d = P.out + O_LATP + ((size_t)(bb * TP + t)) * KVL + 8 * lane; NTS(o0, (GAS f32x4*)d); NTS(o1, (GAS f32x4*)(d + 4)); } }
        }
    }
    {
        const int l32 = lane & 31; const float x = bf1(zp_); const float xp = __shfl_xor(x, 16);
        const float c = rc_, s = rsn_;
        const float o = (l32 < 16) ? (x * c - xp * s) : (x * c + xp * s);
        { const float q2 = wave_sum(lane < 32 ? o * o : 0.f); if (lane == 0) ((float*)(ws + WS_KSS))[r] = q2; }
        if (lane < 32) {
            ((float*)(ws + WS_KPER))[(size_t)r * QKR + lane] = o;
            if (kind == 0) NTS(o, &P.out[O_KPEP + ((size_t)(b * TP + NMETA + t)) * QKR + lane]);
            else if (kind == 1) { P.out[O_KPES + ((size_t)(b * DS + t)) * QKR + lane] = o; ((float*)(ws + WS_NEWKPE))[((size_t)(b * 32 + t)) * QKR + lane] = o; }
            else { for (int bb = 0; bb < NB; ++bb) P.out[O_KPEP + ((size_t)(bb * TP + t)) * QKR + lane] = o; }
        }
    }
    if (kind != 2) {
        float u0[8], u1[8], u2[8];
        { float a_[8], b_[8]; unpack8(zg0_, a_); unpack8(zh0_, b_);
#pragma unroll
          for (int i = 0; i < 8; ++i) u0[i] = a_[i] * b_[i]; }
        if (kind == 0) { float a_[8], b_[8]; unpack8(zg1_, a_); unpack8(zh1_, b_);
#pragma unroll
            for (int i = 0; i < 8; ++i) u1[i] = a_[i] * b_[i];
            unpack8(zg2_, a_); unpack8(zh2_, b_);
#pragma unroll
            for (int i = 0; i < 8; ++i) u2[i] = a_[i] * b_[i];
        } else {
            const float* st = P.state_conv + (size_t)b * 2 * CC + 8 * lane;
            if (t >= 1) conv_u(z - INWP, lane, u1); else { const f32x4 a = *(const GAS f32x4*)(st + CC), c = *(const GAS f32x4*)(st + CC + 4); u1[0] = a.x; u1[1] = a.y; u1[2] = a.z; u1[3] = a.w; u1[4] = c.x; u1[5] = c.y; u1[6] = c.z; u1[7] = c.w; }
            if (t >= 2) conv_u(z - 2 * INWP, lane, u2); else { const float* s2 = st + (t == 1 ? CC : 0); const f32x4 a = *(const GAS f32x4*)(s2), c = *(const GAS f32x4*)(s2 + 4); u2[0] = a.x; u2[1] = a.y; u2[2] = a.z; u2[3] = a.w; u2[4] = c.x; u2[5] = c.y; u2[6] = c.z; u2[7] = c.w; }
        }
        float gb[8]; unpack8(zb_, gb);
        float co[8]; float ss = 0.f;
#pragma unroll
        for (int i = 0; i < 8; ++i) { const float y = cb_[i >> 2][i & 3] + cw_[0][i >> 2][i & 3] * u2[i] + cw_[1][i >> 2][i & 3] * u1[i] + cw_[2][i >> 2][i & 3] * u0[i]; co[i] = gb[i] * y; ss += co[i] * co[i]; }
        const float rs = 1.0f / sqrtf(wave_sum(ss) * (1.f / CC) + EPS);
#pragma unroll
        for (int i = 0; i < 8; ++i) co[i] = co[i] * rs * og_[i >> 2][i & 3];
        *(GAS v4u*)((bf16*)(ws + WS_MIX) + (size_t)r * DM + AW + 8 * lane) = pack8(co);
        const f32x4 o0 = {u0[0], u0[1], u0[2], u0[3]}, o1 = {u0[4], u0[5], u0[6], u0[7]};
        if (kind == 0 && t >= SEQ - 2) { float* d = P.out + O_CONVP + ((size_t)(b * 2 + (t - (SEQ - 2)))) * CC + 8 * lane; *(GAS f32x4*)d = o0; *(GAS f32x4*)(d + 4) = o1; }
        if (kind == 1 && t >= DS - 2) { float* d = P.out + O_CONVS + ((size_t)(b * 2 + (t - (DS - 2)))) * CC + 8 * lane; *(GAS f32x4*)d = o0; *(GAS f32x4*)(d + 4) = o1; }
    }
}

__device__ __forceinline__ void p2c_k_item8(const Params& P, LAS unsigned char* scr, int r0, int lane_in) {
    unsigned char* ws = P.ws; asm volatile("" : "+s"(ws)); int lane = lane_in; asm volatile("" : "+v"(lane));
    const GAS unsigned char* src = (const GAS unsigned char*)((const bf16*)(ws + WS_KVRAW) + (size_t)r0 * 1024);
    { v4u in[8];
#pragma unroll
      for (int j = 0; j < 8; ++j) { const int q = 64 * j + lane, bl = q >> 3, c = q & 7; in[j] = *(const GAS v4u*)(src + (size_t)bl * 256 + c * 16); }
#pragma unroll
      for (int j = 0; j < 8; ++j) { const int q = 64 * j + lane, bl = q >> 3, c = q & 7; *(LAS v4u*)(scr + bl * 128 + ((c ^ (bl & 7)) << 4)) = in[j]; } }
    const int r = r0 + (lane >> 3);
    f32x4 kr[8]; const float* kp = (const float*)(ws + WS_KPER) + (size_t)r * QKR;
#pragma unroll
    for (int c = 0; c < 8; ++c) kr[c] = *(const GAS f32x4*)(kp + 4 * c);
    LDS_WAIT(); asm volatile("" ::: "memory");
    v4u kw[8]; float ss = 0.f;
#pragma unroll
    for (int c = 0; c < 8; ++c) { kw[c] = *(const LAS v4u*)(scr + lane * 128 + ((c ^ (lane & 7)) << 4)); float e[8]; unpack8(kw[c], e);
#pragma unroll
        for (int i = 0; i < 8; ++i) ss += e[i] * e[i]; }
#pragma unroll
    for (int c = 0; c < 8; ++c) ss += (kr[c].x * kr[c].x + kr[c].y * kr[c].y) + (kr[c].z * kr[c].z + kr[c].w * kr[c].w);
    const float rs = 1.0f / sqrtf(ss * (1.f / QKH) + EPS);
    LAS unsigned char* kb = scr + lane * 192;
#pragma unroll
    for (int c = 0; c < 8; ++c) { float e[8]; unpack8(kw[c], e);
#pragma unroll
        for (int i = 0; i < 8; ++i) e[i] = e[i] * rs * P.k_norm_g[8 * c + i];
        *(LAS v4u*)(kb + 16 * c) = pack8(e); }
#pragma unroll
    for (int c = 0; c < 4; ++c) { float e[8] = {kr[2 * c].x, kr[2 * c].y, kr[2 * c].z, kr[2 * c].w, kr[2 * c + 1].x, kr[2 * c + 1].y, kr[2 * c + 1].z, kr[2 * c + 1].w};
#pragma unroll
        for (int i = 0; i < 8; ++i) e[i] = e[i] * rs * P.k_norm_g[64 + 8 * c + i];
        *(LAS v4u*)(kb + 128 + 16 * c) = pack8(e); }
    LDS_WAIT(); asm volatile("" ::: "memory");
    const bool meta = r0 >= MR; const int b0 = meta ? 0 : (r0 >> 11), b1 = meta ? NB : b0 + 1, tp0 = meta ? (r0 - MR) : (r0 & 2047) + NMETA;
    { v4u ko[12];
#pragma unroll
      for (int j = 0; j < 12; ++j) ko[j] = *(const LAS v4u*)(scr + (64 * j + lane) * 16);
      for (int b = b0; b < b1; ++b) { GAS v4u* kd = (GAS v4u*)((bf16*)(ws + WS_K) + ((size_t)(b * TPP + tp0)) * 768);
#pragma unroll
          for (int j = 0; j < 12; ++j) kd[64 * j + lane] = ko[j]; } }
    LDS_WAIT(); asm volatile("" ::: "memory");
}
__device__ __forceinline__ void p2c_phase(const Params& P, Frame& F) {
    LAS unsigned char* scr = F.lds + RING_OFF + F.wave * 16384;
    constexpr int NKV = (MP + NMETA) / 8;
    for (int it = F.gw; it < NKV; it += F.NGW) { int r0 = it * 8; if (r0 >= MP) r0 = MR + (r0 - MP); p2c_k_item8(P, scr, r0, F.lane); }
}

__device__ __forceinline__ void q_norm_frags(const Params& P, const bf16* qraw_head, int pidx, int hi, bf16x8 (&qf)[6]) {
    const float* rope = (const float*)(P.ws + WS_ROPE);
    float v[6][8];
#pragma unroll
    for (int s = 0; s < 6; ++s) unpack8(*(const GAS v4u*)(qraw_head + 16 * s + 8 * hi), v[s]);
    const f32x4 c0 = *(const GAS f32x4*)(rope + pidx * 16 + 8 * hi), c1 = *(const GAS f32x4*)(rope + pidx * 16 + 8 * hi + 4);
    const f32x4 s0 = *(const GAS f32x4*)(rope + 2068 * 16 + pidx * 16 + 8 * hi), s1 = *(const GAS f32x4*)(rope + 2068 * 16 + pidx * 16 + 8 * hi + 4);
    const float cs[8] = {c0.x, c0.y, c0.z, c0.w, c1.x, c1.y, c1.z, c1.w}, sn[8] = {s0.x, s0.y, s0.z, s0.w, s1.x, s1.y, s1.z, s1.w};
#pragma unroll
    for (int j = 0; j < 8; ++j) { const float x1 = v[4][j], x2 = v[5][j]; v[4][j] = x1 * cs[j] - x2 * sn[j]; v[5][j] = x2 * cs[j] + x1 * sn[j]; }
    float ss = 0.f;
#pragma unroll
    for (int s = 0; s < 6; ++s)
#pragma unroll
        for (int j = 0; j < 8; ++j) ss += v[s][j] * v[s][j];
    { auto rr = __builtin_amdgcn_permlane32_swap(__float_as_uint(ss), __float_as_uint(ss), false, false); ss = __uint_as_float(rr[0]) + __uint_as_float(rr[1]); }
    const float rs = QSCALE / sqrtf(ss * (1.f / QKH) + EPS);
#pragma unroll
    for (int s = 0; s < 6; ++s) { const f32x4 g0 = *(const GAS f32x4*)(P.q_norm_g + 16 * s + 8 * hi), g1 = *(const GAS f32x4*)(P.q_norm_g + 16 * s + 8 * hi + 4);
        float e[8] = {v[s][0] * rs * g0.x, v[s][1] * rs * g0.y, v[s][2] * rs * g0.z, v[s][3] * rs * g0.w, v[s][4] * rs * g1.x, v[s][5] * rs * g1.y, v[s][6] * rs * g1.z, v[s][7] * rs * g1.w};
        qf[s] = __builtin_bit_cast(bf16x8, pack8(e)); }
}
constexpr int PA_KS = 0, PA_KROW = 208, PA_VS = 64 * PA_KROW  , PA_VROW = 192, PA_BYTES = PA_VS + 64 * PA_VROW;
#define MFMA32(a, b, c) __builtin_amdgcn_mfma_f32_32x32x16_bf16((a), (b), (c), 0, 0, 0)
#define MFMA16(a, b, c) __builtin_amdgcn_mfma_f32_16x16x32_bf16((a), (b), (c), 0, 0, 0)
typedef short v4i16_t __attribute__((ext_vector_type(4)));
__device__ __forceinline__ s16x4 tr_read(const LAS unsigned char* p) { return __builtin_bit_cast(s16x4, __builtin_amdgcn_ds_read_tr16_b64_v4i16((LAS v4i16_t*)p)); }
__device__ __forceinline__ int crow(int r, int hi) { return (r & 3) + 8 * (r >> 2) + 4 * hi; }

__device__ __forceinline__ void pattn_unit(const Params& P, Frame& F, int b, int h, int qb) {
    unsigned char* ws = P.ws; LAS unsigned char* lds = F.lds;
    int tid_ = F.tid; asm volatile("" : "+v"(tid_));
    const int tid = tid_, lane = tid & 63, wave = F.wave, r32 = lane & 31, hi = lane >> 5;
    const int q0 = qb * 256 + wave * 32;
    const int qpos = NMETA + q0 + r32, wfirst = NMETA + q0, wlast = NMETA + q0 + 31;
    bf16x8 qf[6];
    q_norm_frags(P, (const bf16*)(ws + WS_QRAW) + (size_t)(b * SEQ + q0 + r32) * 768 + h * QKH, qpos, hi, qf);
    const int NT = 4 * qb + 5;
    f32x16 o0, o1;
#pragma unroll
    for (int r = 0; r < 16; ++r) { o0[r] = 0.f; o1[r] = 0.f; }
    float l = 0.f;
    const bf16* Kb = (const bf16*)(ws + WS_K) + (size_t)(b * TPP) * 768 + h * QKH;
    const bf16* Vraw = (const bf16*)(ws + WS_KVRAW) + h * 128 + 64;
#define PA_VROWP(tp_) (Vraw + (size_t)(((tp_) < NMETA) ? MR + (tp_) : b * SEQ + (tp_) - NMETA) * 1024)
    const int k0r = tid / 12, k0c = tid % 12, k1r = (tid + 512) / 12, k1c = (tid + 512) % 12, v0r = tid >> 3, v0c = tid & 7;
    v4u kr0, kr1 = (v4u){0u, 0u, 0u, 0u}, vr;
    {
        kr0 = *(const GAS v4u*)(Kb + (size_t)k0r * 768 + 8 * k0c); if (tid < 256) kr1 = *(const GAS v4u*)(Kb + (size_t)k1r * 768 + 8 * k1c); vr = *(const GAS v4u*)(PA_VROWP(v0r) + 8 * v0c);
    }
    const int blk = (lane >> 4) & 1, tq = (lane & 15) >> 2, tp = lane & 3;
    for (int j = 0; j < NT; ++j) {
        __syncthreads();
        *(LAS v4u*)(lds + PA_KS + k0r * PA_KROW + 16 * k0c) = kr0; if (tid < 256) *(LAS v4u*)(lds + PA_KS + k1r * PA_KROW + 16 * k1c) = kr1; *(LAS v4u*)(lds + PA_VS + v0r * PA_VROW + 16 * v0c) = vr;
        __syncthreads();
        if (j + 1 < NT) { const bf16* Kt = Kb + (size_t)(64 * (j + 1)) * 768;
            kr0 = *(const GAS v4u*)(Kt + (size_t)k0r * 768 + 8 * k0c); if (tid < 256) kr1 = *(const GAS v4u*)(Kt + (size_t)k1r * 768 + 8 * k1c); vr = *(const GAS v4u*)(PA_VROWP(64 * (j + 1) + v0r) + 8 * v0c); }
        if (64 * j <= wlast) {
            f32x16 p0, p1;
#pragma unroll
            for (int r = 0; r < 16; ++r) { p0[r] = 0.f; p1[r] = 0.f; }
#pragma unroll
            for (int s = 0; s < 6; ++s) {
                const bf16x8 a0 = *(const LAS bf16x8*)(lds + PA_KS + r32 * PA_KROW + 32 * s + 16 * hi);
                const bf16x8 a1 = *(const LAS bf16x8*)(lds + PA_KS + (r32 + 32) * PA_KROW + 32 * s + 16 * hi);
                p0 = MFMA32(a0, qf[s], p0); p1 = MFMA32(a1, qf[s], p1);
            }
            int need_mask = __builtin_amdgcn_readfirstlane((64 * j + 63 > wfirst) ? 1 : 0); asm volatile("" : "+s"(need_mask));
            float ls = 0.f;
#pragma unroll
            for (int r = 0; r < 16; ++r) { p0[r] = __builtin_amdgcn_exp2f(p0[r]); p1[r] = __builtin_amdgcn_exp2f(p1[r]); }
            if (need_mask) {
#pragma unroll
                for (int r = 0; r < 16; ++r) { const int kp = 64 * j + crow(r, hi); if (kp > qpos) p0[r] = 0.f; if (kp + 32 > qpos) p1[r] = 0.f; }
            }
#pragma unroll
            for (int r = 0; r < 16; ++r) ls += p0[r] + p1[r];
            l += ls;
            bf16x8 pf[4];
#pragma unroll
            for (int ks = 0; ks < 4; ++ks) { v4u w;
                if (ks < 2) { w.x = pk2(p0[8 * ks + 0], p0[8 * ks + 1]); w.y = pk2(p0[8 * ks + 2], p0[8 * ks + 3]); w.z = pk2(p0[8 * ks + 4], p0[8 * ks + 5]); w.w = pk2(p0[8 * ks + 6], p0[8 * ks + 7]); }
                else { const int k2 = ks - 2; w.x = pk2(p1[8 * k2 + 0], p1[8 * k2 + 1]); w.y = pk2(p1[8 * k2 + 2], p1[8 * k2 + 3]); w.z = pk2(p1[8 * k2 + 4], p1[8 * k2 + 5]); w.w = pk2(p1[8 * k2 + 6], p1[8 * k2 + 7]); }
                pf[ks] = __builtin_bit_cast(bf16x8, w); }
#pragma unroll
            for (int ks = 0; ks < 4; ++ks) {
#pragma unroll
                for (int db = 0; db < 2; ++db) {
                    const LAS unsigned char* base = lds + PA_VS + (16 * ks + 4 * hi + tq) * PA_VROW + (32 * db + 16 * blk + 4 * tp) * 2;
                    const s16x4 t0 = tr_read(base), t1 = tr_read(base + 8 * PA_VROW);
                    const bf16x8 a = (bf16x8){t0[0], t0[1], t0[2], t0[3], t1[0], t1[1], t1[2], t1[3]};
                    if (db == 0) o0 = MFMA32(a, pf[ks], o0); else o1 = MFMA32(a, pf[ks], o1);
                }
            }
        }
    }
    { auto rr = __builtin_amdgcn_permlane32_swap(__float_as_uint(l), __float_as_uint(l), false, false); l = __uint_as_float(rr[0]) + __uint_as_float(rr[1]); }
    const float inv = 1.0f / l;
    { float ss = 0.f;
#pragma unroll
      for (int r = 0; r < 16; ++r) { const float a = o0[r] * inv, c = o1[r] * inv; ss += a * a + c * c; }
      auto rr = __builtin_amdgcn_permlane32_swap(__float_as_uint(ss), __float_as_uint(ss), false, false); ss = __uint_as_float(rr[0]) + __uint_as_float(rr[1]);
      if (hi == 0) ((float*)(ws + WS_SSQ))[(size_t)(b * SEQ + q0 + r32) * NH + h] = ss; }
    bf16* Op = (bf16*)(ws + WS_MIX) + (size_t)(b * SEQ + q0 + r32) * DM + h * VH;
#pragma unroll
    for (int g = 0; g < 4; ++g) {
        v2u w0, w1; w0.x = pk2(o0[4 * g] * inv, o0[4 * g + 1] * inv); w0.y = pk2(o0[4 * g + 2] * inv, o0[4 * g + 3] * inv);
        w1.x = pk2(o1[4 * g] * inv, o1[4 * g + 1] * inv); w1.y = pk2(o1[4 * g + 2] * inv, o1[4 * g + 3] * inv);
        *(GAS v2u*)(Op + 8 * g + 4 * hi) = w0; *(GAS v2u*)(Op + 32 + 8 * g + 4 * hi) = w1;
    }
}

constexpr int SA_LT = 0, SA_LTB = 16384  , SA_KP = 65536, SA_KPB = 2048  , SA_KSQ = 73728, SA_KSB = 128,
              SA_F8 = 74240, SA_F8B = 8192  , SA_RS = 90624, SA_RSB = 1024  , SA_PL = 92672, SA_PLB = 2048, SA_PROW = 64  ,
              SA_QAL = 96768, SA_QROW = 576  , SA_LRED = 115200  , SA_BYTES = SA_LRED + 512;
static_assert(SA_BYTES <= LDSCTL_OFF, "sample attention LDS map");
__device__ __forceinline__ int sa_pi(int x) { return (0x1320 >> (4 * x)) & 3; }
__device__ __forceinline__ int sa_g(int key) { return ((key & 3) << 2) | sa_pi((key >> 2) & 3); }
__device__ __forceinline__ int sa_g8(int key) { return ((key & 3) << 2) | ((0x2310 >> (4 * ((key >> 2) & 3))) & 3); }
typedef int v8i __attribute__((ext_vector_type(8)));
#define MFMA_F8(a, b, c) __builtin_amdgcn_mfma_scale_f32_16x16x128_f8f6f4((a), (b), (c), 0, 0, 0, 0x7F7F7F7F, 0, 0x7F7F7F7F)

__device__ __forceinline__ void sattn_unit(const Params& P, Frame& F, int b, int sp) {
    unsigned char* ws = P.ws; asm volatile("" : "+s"(ws)); LAS unsigned char* lds = F.lds;
    int tid_ = F.tid; asm volatile("" : "+v"(tid_));
    int wave_ = F.wave; asm volatile("" : "+s"(wave_));
    const int tid = tid_, lane = tid & 63, wave = wave_, r32 = lane & 31, hi = lane >> 5, fr = lane & 15, fq = lane >> 4;
    const int h = wave, sg = wave & 1, skb = (wave >> 1) & 1, spar = wave >> 2;
    const int srow0 = MP + b * DS;
    __syncthreads();
    {
        bf16x8 qn[6];
        q_norm_frags(P, (const bf16*)(ws + WS_QRAW) + (size_t)(srow0 + (r32 & 3)) * 768 + h * QKH, TP + (r32 & 3), hi, qn);
        bf16x8 bq[4];
#pragma unroll
        for (int ks = 0; ks < 4; ++ks) {
            float e[8]; unpack8(__builtin_bit_cast(v4u, qn[ks]), e);
#pragma unroll
            for (int i = 0; i < 8; ++i) e[i] = (r32 < 4) ? e[i] * P.k_norm_g[16 * ks + 8 * hi + i] : 0.f;
            bq[ks] = __builtin_bit_cast(bf16x8, pack8(e));
        }
        const bf16* WB = (const bf16*)(ws + WS_WUKVB);
        const int lr = lane >> 3, lc = lane & 7;
        const GAS unsigned char* wp = (const GAS unsigned char*)(WB + (size_t)lr * 1024 + h * 128) + 16 * lc;
        LAS unsigned char* wimg = lds + SA_LT + wave * 4608;
#pragma unroll 1
        for (int half = 0; half < 2; ++half) {
        v4u ra[4][4];
#pragma unroll
        for (int q = 0; q < 4; ++q)
#pragma unroll
            for (int j = 0; j < 4; ++j) ra[q][j] = *(const GAS v4u*)(wp + (size_t)(32 * (4 * half + q) + 8 * j) * 2048);
#pragma unroll
        for (int q = 0; q < 4; ++q) { const int cb = 4 * half + q;
#pragma unroll
            for (int j = 0; j < 4; ++j) *(LAS v4u*)(wimg + (lr + 8 * j) * 144 + lc * 16) = ra[q][j];
            f32x16 acc;
#pragma unroll
            for (int r = 0; r < 16; ++r) acc[r] = 0.f;
#pragma unroll
            for (int ks = 0; ks < 4; ++ks) { const bf16x8 a = *(const LAS bf16x8*)(wimg + r32 * 144 + (2 * ks + hi) * 16); acc = MFMA32(a, bq[ks], acc); }
            if (r32 < 4) {
#pragma unroll
                for (int g = 0; g < 4; ++g) { v2u w; w.x = pk2(acc[4 * g], acc[4 * g + 1]); w.y = pk2(acc[4 * g + 2], acc[4 * g + 3]);
                    *(LAS v2u*)(lds + SA_QAL + (h * 4 + r32) * SA_QROW + (32 * cb + 8 * g + 4 * hi) * 2) = w; }
            }
        }
        }
        if (r32 < 4) {
            float e[8], f[8]; unpack8(__builtin_bit_cast(v4u, qn[4]), e); unpack8(__builtin_bit_cast(v4u, qn[5]), f);
#pragma unroll
            for (int i = 0; i < 8; ++i) { e[i] *= P.k_norm_g[64 + 8 * hi + i]; f[i] *= P.k_norm_g[80 + 8 * hi + i]; }
            *(LAS v4u*)(lds + SA_QAL + (h * 4 + r32) * SA_QROW + (256 + 8 * hi) * 2) = pack8(e);
            *(LAS v4u*)(lds + SA_QAL + (h * 4 + r32) * SA_QROW + (256 + 16 + 8 * hi) * 2) = pack8(f);
        }
    }
    __syncthreads();
    const LAS unsigned char* qaf = lds + SA_QAL + (16 * sg + fr) * SA_QROW + 16 * fq;
    v8i Wf[4][2];
    {
        const unsigned char* WF = (const unsigned char*)(ws + WS_WF8);
#pragma unroll
        for (int db = 0; db < 4; ++db)
#pragma unroll
            for (int st = 0; st < 2; ++st) { const GAS v4u* p = (const GAS v4u*)(WF + (size_t)(h * 64 + 16 * db + fr) * 256 + 128 * st + 32 * fq); const v4u lo = p[0], hi4 = p[1];
                Wf[db][st] = (v8i){(int)lo.x, (int)lo.y, (int)lo.z, (int)lo.w, (int)hi4.x, (int)hi4.y, (int)hi4.z, (int)hi4.w}; }
    }
#pragma unroll
    for (int db = 0; db < 4; ++db)
#pragma unroll
        for (int st = 0; st < 2; ++st) asm volatile("" : "+v"(Wf[db][st]));
    constexpr int NCD = (NPAGES / SA_NS) * 4;
    const int NC = NCD + ((sp == SA_NS - 1) ? 1 : 0);
    int ptv = P.page_table[b * NPAGES + sp * (NPAGES / SA_NS) + (lane & 31)]; asm volatile("" : "+v"(ptv));
    f32x4 st[4]; f32x2_t kst;
    int woff[4], foff[4], koff, ksoff;
#pragma unroll
    for (int j = 0; j < 4; ++j) { const int f = tid + 512 * j, key = f >> 6, c4 = f & 63;
        woff[j] = key * 512 + (((c4 >> 1) ^ sa_g(key)) << 4) + 8 * (c4 & 1); foff[j] = key * 256 + (((c4 >> 2) ^ sa_g8(key)) << 4) + 4 * (c4 & 3);
        asm volatile("" : "+v"(woff[j]), "+v"(foff[j])); }
    { const int key = tid >> 4, c2 = tid & 15; koff = key * 64 + (((c2 >> 2) ^ sa_pi((key >> 2) & 3)) << 4) + 4 * (c2 & 3); ksoff = key * 4; asm volatile("" : "+v"(koff), "+v"(ksoff)); }
    unsigned goff = (unsigned)tid * 16u; asm volatile("" : "+v"(goff));
    int nbase[2];
#pragma unroll
    for (int kb = 0; kb < 2; ++kb) { const int key = 16 * kb + fr; nbase[kb] = key * 256 + (((2 * fq) ^ sa_g8(key)) << 4); asm volatile("" : "+v"(nbase[kb])); }
#define SA_LOAD(ii) do { const int i_ = (ii); const int page = __builtin_amdgcn_readlane(ptv, (i_ >> 2) & 31); const size_t k0 = (size_t)page * PAGE + (i_ & 3) * 32; \
        const GAS unsigned char* gl = (const GAS unsigned char*)((i_ < NCD) ? P.cache_lat + k0 * KVL : (const float*)(ws + WS_NEWLAT) + (size_t)b * 32 * KVL); \
        const GAS unsigned char* gk_ = (const GAS unsigned char*)((i_ < NCD) ? P.cache_kpe + k0 * QKR : (const float*)(ws + WS_NEWKPE) + (size_t)b * 32 * QKR); \
        _Pragma("unroll") \
        for (int j = 0; j < 4; ++j) st[j] = __builtin_nontemporal_load((const GAS f32x4*)(gl + (size_t)(goff + 8192u * j))); \
        kst = __builtin_nontemporal_load((const GAS f32x2_t*)(gk_ + (size_t)(goff >> 1))); \
    } while (0)
#define DPP_ADD(v, ctrl) ((v) + __builtin_bit_cast(float, __builtin_amdgcn_update_dpp(0, __builtin_bit_cast(int, (v)), (ctrl), 0xf, 0xf, true)))
#define SA_WRITE(q4, q2) do { const int lo_ = (q4) * SA_LTB, fo_ = (q2) * SA_F8B, ko_ = (q4) * SA_KPB, so_ = (q4) * SA_KSB; \
        _Pragma("unroll") \
        for (int j = 0; j < 4; ++j) { \
            v2u w; w.x = pk2(st[j].x, st[j].y); w.y = pk2(st[j].z, st[j].w); \
            *(LAS v2u*)(lds + SA_LT + lo_ + woff[j]) = w; \
            int f8 = (int)w.x; f8 = __builtin_amdgcn_cvt_pk_fp8_f32(st[j].x, st[j].y, f8, false); f8 = __builtin_amdgcn_cvt_pk_fp8_f32(st[j].z, st[j].w, f8, true); \
            *(LAS int*)(lds + SA_F8 + fo_ + foff[j]) = f8; } \
        { *(LAS unsigned*)(lds + SA_KP + ko_ + koff) = pk2(kst.x, kst.y); \
            float ss = kst.x * kst.x + kst.y * kst.y; \
            ss = DPP_ADD(ss, 0xB1); ss = DPP_ADD(ss, 0x4E); ss = DPP_ADD(ss, 0x141); ss = DPP_ADD(ss, 0x140);     \
            if ((tid & 15) == 0) *(LAS float*)(lds + SA_KSQ + so_ + ksoff) = ss; } \
    } while (0)
    float lsum[4] = {0.f, 0.f, 0.f, 0.f};
    f32x16 ol;
#pragma unroll
    for (int r = 0; r < 16; ++r) ol[r] = 0.f;
    const int blk = (lane >> 4) & 1, tq = (lane & 15) >> 2, tp = lane & 3;
    int tro[2][2], pro[2][2];
#pragma unroll
    for (int ks = 0; ks < 2; ++ks)
#pragma unroll
        for (int t2 = 0; t2 < 2; ++t2) { const int row = 16 * ks + 8 * hi + tq + 4 * t2, ch = 4 * wave + 2 * blk + (tp >> 1);
            tro[ks][t2] = row * 512 + ((ch ^ sa_g(row)) << 4) + 8 * (tp & 1); pro[ks][t2] = row * SA_PROW + (16 * blk + 4 * tp) * 2; asm volatile("" : "+v"(tro[ks][t2]), "+v"(pro[ks][t2])); }
    SA_LOAD(0); SA_WRITE(0, 0); SA_LOAD(1);
    asm volatile("s_waitcnt lgkmcnt(0)" ::: "memory"); __builtin_amdgcn_s_barrier(); asm volatile("" ::: "memory");
#define SA_PV(q4, q2) do { const int pb_ = (q4) * SA_LTB, pp_ = (q2) * SA_PLB; \
            const s16x4 t00 = tr_read(lds + SA_LT + pb_ + tro[0][0]), t01 = tr_read(lds + SA_LT + pb_ + tro[0][1]), p00 = tr_read(lds + SA_PL + pp_ + pro[0][0]), p01 = tr_read(lds + SA_PL + pp_ + pro[0][1]); \
            const s16x4 t10 = tr_read(lds + SA_LT + pb_ + tro[1][0]), t11 = tr_read(lds + SA_LT + pb_ + tro[1][1]), p10 = tr_read(lds + SA_PL + pp_ + pro[1][0]), p11 = tr_read(lds + SA_PL + pp_ + pro[1][1]); \
            __builtin_amdgcn_sched_barrier(0); \
            ol = MFMA32(((bf16x8){t00[0], t00[1], t00[2], t00[3], t01[0], t01[1], t01[2], t01[3]}), ((bf16x8){p00[0], p00[1], p00[2], p00[3], p01[0], p01[1], p01[2], p01[3]}), ol); \
            ol = MFMA32(((bf16x8){t10[0], t10[1], t10[2], t10[3], t11[0], t11[1], t11[2], t11[3]}), ((bf16x8){p10[0], p10[1], p10[2], p10[3], p11[0], p11[1], p11[2], p11[3]}), ol); } while (0)
#ifndef SA_STAGGER
#define SA_STAGGER 1
#endif
#define SA_NLOAD(kb, Q20, dst) do { int nb_ = nbase[kb]; asm volatile("" : "+v"(nb_));     \
        const LAS unsigned char* frow = lds + SA_F8 + (Q20) * SA_F8B; \
        _Pragma("unroll") \
        for (int st2 = 0; st2 < 2; ++st2) { const v4u lo = *(const LAS v4u*)(frow + (nb_ ^ ((8 * st2) << 4))), hi4 = *(const LAS v4u*)(frow + (nb_ ^ ((8 * st2 + 1) << 4))); \
            dst[st2] = (v8i){(int)lo.x, (int)lo.y, (int)lo.z, (int)lo.w, (int)hi4.x, (int)hi4.y, (int)hi4.z, (int)hi4.w}; } } while (0)
#define SA_NMMA(src, acc_) do { \
        _Pragma("unroll") \
        for (int a = 0; a < 4; ++a) acc_[a] = (f32x4){0.f, 0.f, 0.f, 0.f}; \
        _Pragma("unroll") \
        for (int st2 = 0; st2 < 2; ++st2) \
            _Pragma("unroll") \
            for (int db = 0; db < 4; ++db) acc_[db] = MFMA_F8(Wf[db][st2], src[st2], acc_[db]); } while (0)
#define SA_NTAIL(kb, Q20, acc_, ksq_) do { const int key_ = (kb) * 16 + fr; float ss = 0.f; \
        _Pragma("unroll") \
        for (int db = 0; db < 4; ++db) ss += (acc_[db][0] * acc_[db][0] + acc_[db][1] * acc_[db][1]) + (acc_[db][2] * acc_[db][2] + acc_[db][3] * acc_[db][3]); \
        ss *= (1.0f / 256.0f);                            \
        { auto r16 = __builtin_amdgcn_permlane16_swap(__float_as_uint(ss), __float_as_uint(ss), false, false); ss = __uint_as_float(r16[0]) + __uint_as_float(r16[1]); \
          auto r32_ = __builtin_amdgcn_permlane32_swap(__float_as_uint(ss), __float_as_uint(ss), false, false); ss = __uint_as_float(r32_[0]) + __uint_as_float(r32_[1]); } \
        ss += (ksq_); \
        const float rs = __builtin_amdgcn_rsqf(ss * (1.f / QKH) + EPS); \
        if (fq == 0) *(LAS float*)(lds + SA_RS + (Q20) * SA_RSB + h * 128 + key_ * 4) = rs; } while (0)
#define SA_NSTAGE(Q20, Q40) do { \
        const float ksq0 = *(const LAS float*)(lds + SA_KSQ + (Q40) * SA_KSB + fr * 4), ksq1 = *(const LAS float*)(lds + SA_KSQ + (Q40) * SA_KSB + (16 + fr) * 4); \
        v8i nb[2]; f32x4 na0[4], na1[4]; \
        SA_NLOAD(0, Q20, nb); __builtin_amdgcn_sched_barrier(0); \
        SA_NMMA(nb, na0); __builtin_amdgcn_sched_barrier(0); \
        SA_NLOAD(1, Q20, nb); __builtin_amdgcn_sched_barrier(0); \
        SA_NTAIL(0, Q20, na0, ksq0); __builtin_amdgcn_sched_barrier(0); \
        SA_NMMA(nb, na1); __builtin_amdgcn_sched_barrier(0); \
        SA_NTAIL(1, Q20, na1, ksq1); } while (0)
#define SA_BODY(I, FULL, Q4M2, Q4M1, Q40, Q4P1, Q2M2, Q2M1, Q20, Q2P1) do { const int i = (I); \
        if ((SA_STAGGER ? wave >= 4 : true) && ((FULL) || i >= 2)) SA_PV(Q4M2, Q2M2); \
          \
        if ((FULL) || i < NC) SA_NSTAGE(Q20, Q40); \
          \
        if (((FULL) || (i >= 1 && i <= NC)) && (Q2M1) == spar) { \
            const int key = skb * 16 + fr; const bool newc = (FULL) ? false : (i - 1 >= NCD); \
            const LAS unsigned char* lrow = lds + SA_LT + (Q4M1) * SA_LTB + key * 512; const int gk = sa_g(key); \
            const LAS unsigned char* krow = lds + SA_KP + (Q4M1) * SA_KPB + key * 64 + ((fq ^ sa_pi((key >> 2) & 3)) << 4); \
            const float rsv = *(const LAS float*)(lds + SA_RS + (Q2M1) * SA_RSB + (4 * sg + fq) * 128 + key * 4);        \
            f32x4 sacc = (f32x4){0.f, 0.f, 0.f, 0.f}; \
            _Pragma("unroll") \
            for (int s = 0; s < 9; ++s) { const bf16x8 bf = (s < 8) ? *(const LAS bf16x8*)(lrow + (((4 * s + fq) ^ gk) << 4)) : *(const LAS bf16x8*)(krow); const bf16x8 qa = *(const LAS bf16x8*)(qaf + 64 * s); sacc = MFMA16(qa, bf, sacc); } \
            float pv[4]; \
            _Pragma("unroll") \
            for (int i4 = 0; i4 < 4; ++i4) { float p = __builtin_amdgcn_exp2f(sacc[i4] * rsv); if (newc && (key >= DS || key > i4)) p = 0.f; lsum[i4] += p; pv[i4] = p; } \
            v2u w; w.x = pk2(pv[0], pv[1]); w.y = pk2(pv[2], pv[3]); \
            *(LAS v2u*)(lds + SA_PL + (Q2M1) * SA_PLB + key * SA_PROW + sg * 32 + fq * 8) = w;         \
        } \
        if (SA_STAGGER && wave < 4 && ((FULL) || i >= 2)) SA_PV(Q4M2, Q2M2); \
        if ((FULL) || i + 1 < NC) { SA_WRITE(Q4P1, Q2P1); if ((FULL) || i + 2 < NC) SA_LOAD(i + 2); } \
        asm volatile("s_waitcnt lgkmcnt(0)" ::: "memory"); __builtin_amdgcn_s_barrier(); asm volatile("" ::: "memory"); \
    } while (0)
#define SA_GEN(I) SA_BODY(I, false, ((I) - 2) & 3, ((I) - 1) & 3, (I) & 3, ((I) + 1) & 3, (I) & 1, ((I) - 1) & 1, (I) & 1, ((I) + 1) & 1)
    SA_GEN(0); SA_GEN(1);
    int ii = 2;
    for (; ii + 3 <= NC - 3; ii += 4) {
        SA_BODY(ii,     true, 0, 1, 2, 3, 0, 1, 0, 1);
        SA_BODY(ii + 1, true, 1, 2, 3, 0, 1, 0, 1, 0);
        SA_BODY(ii + 2, true, 2, 3, 0, 1, 0, 1, 0, 1);
        SA_BODY(ii + 3, true, 3, 0, 1, 2, 1, 0, 1, 0);
    }
    for (; ii <= NC + 1; ++ii) SA_GEN(ii);
    {
        int l2 = lane; asm volatile("" : "+v"(l2)); const int r32e = l2 & 31, hie = l2 >> 5; asm volatile("" : "+s"(ws));
        float* part = (float*)(ws + WS_PART) + ((size_t)(b * SA_NS + sp) * 32 + r32e) * KVL + 32 * wave;
#pragma unroll
        for (int g = 0; g < 4; ++g) *(GAS f32x4*)(part + 8 * g + 4 * hie) = (f32x4){ol[4 * g], ol[4 * g + 1], ol[4 * g + 2], ol[4 * g + 3]};
#pragma unroll
        for (int i4 = 0; i4 < 4; ++i4) { float v = lsum[i4]; v += __shfl_xor(v, 1); v += __shfl_xor(v, 2); v += __shfl_xor(v, 4); v += __shfl_xor(v, 8);
            if ((l2 & 15) == 0) *(LAS float*)(lds + SA_LRED + (wave * 16 + 4 * (l2 >> 4) + i4) * 4) = v; }
        __syncthreads();
        if (wave == 0 && l2 < 32) { const int g = l2 >> 4, idx = l2 & 15; float t = 0.f;
#pragma unroll
            for (int w4 = 0; w4 < 4; ++w4) t += *(const LAS float*)(lds + SA_LRED + ((2 * w4 + g) * 16 + idx) * 4);
            ((float*)(ws + WS_LPART))[(size_t)(b * SA_NS + sp) * 32 + l2] = t; }
    }
#undef SA_LOAD
#undef SA_WRITE
#undef SA_PV
#undef SA_BODY
#undef SA_GEN
#undef SA_NLOAD
#undef SA_NMMA
#undef SA_NTAIL
#undef SA_NSTAGE
}

__device__ __forceinline__ void p3_attention(const Params& P, Frame& F) {
    const int c = blockIdx.x, G = F.G;
#ifndef PA_REP
#define PA_REP 1
#endif
#ifndef SA_REP
#define SA_REP 1
#endif
#ifndef NO_PA
    for (int rep = 0; rep < PA_REP; ++rep)
    for (int u = c; u < 512; u += G) { const int i = u >> 8, cc = u & 255; const int k = cc >> 6, bh = cc & 63; const int qb = (i == 0) ? 7 - k : k; pattn_unit(P, F, bh >> 3, bh & 7, qb); }
#endif
#ifndef NO_SA
    for (int rep = 0; rep < SA_REP; ++rep)
    for (int u = c; u < DB * SA_NS; u += G) sattn_unit(P, F, u / SA_NS, u % SA_NS);
#endif
}

__device__ __forceinline__ void p4a_sample(const Params& P, Frame& F) {
    unsigned char* ws = P.ws; const int lane = F.lane, h = F.wave;
    LAS float* scr = (LAS float*)(F.lds + RING_OFF + F.wave * 2048);
    LAS float* ssb = (LAS float*)(F.lds + RING_OFF + 16384);
    const int r0 = MP + 2 * (int)blockIdx.x; if (r0 >= MR) return;
    const int b = (r0 - MP) >> 2, m0 = h * 4 + ((r0 - MP) & 3);
    {
        float l[2] = {0.f, 0.f}; f32x4 acc[2] = {(f32x4){0.f, 0.f, 0.f, 0.f}, (f32x4){0.f, 0.f, 0.f, 0.f}};
#pragma unroll
        for (int sp = 0; sp < SA_NS; ++sp)
#pragma unroll
            for (int q = 0; q < 2; ++q) { l[q] += ((const float*)(ws + WS_LPART))[(size_t)(b * SA_NS + sp) * 32 + m0 + q];
                acc[q] = acc[q] + *(const GAS f32x4*)((const float*)(ws + WS_PART) + ((size_t)(b * SA_NS + sp) * 32 + m0 + q) * KVL + 4 * lane); }
#pragma unroll
        for (int q = 0; q < 2; ++q) *(LAS f32x4*)(scr + 256 * q + 4 * lane) = acc[q] * (1.0f / l[q]);
    }
    LDS_WAIT(); asm volatile("" ::: "memory");
    const int cg = lane >> 3, dq = lane & 7;
    const GAS unsigned char* wp = (const GAS unsigned char*)((const bf16*)(ws + WS_WUKVB) + (size_t)cg * 1024 + h * 128 + 64 + 8 * dq);
    float o8[2][8];
#pragma unroll
    for (int i = 0; i < 8; ++i) { o8[0][i] = 0.f; o8[1][i] = 0.f; }
#pragma unroll 1
    for (int kb = 0; kb < 2; ++kb) {
        v4u w[16];
#pragma unroll
        for (int kk = 0; kk < 16; ++kk) w[kk] = *(const GAS v4u*)(wp + (size_t)(8 * (16 * kb + kk)) * 2048);
#pragma unroll
        for (int kk = 0; kk < 16; ++kk) { const float sc0 = scr[8 * (16 * kb + kk) + cg], sc1 = scr[256 + 8 * (16 * kb + kk) + cg]; float e[8]; unpack8(w[kk], e);
#pragma unroll
            for (int i = 0; i < 8; ++i) { o8[0][i] += sc0 * e[i]; o8[1][i] += sc1 * e[i]; } }
    }
    float ssw[2] = {0.f, 0.f};
#pragma unroll
    for (int q = 0; q < 2; ++q) {
#pragma unroll
        for (int i = 0; i < 8; ++i) { float v = o8[q][i]; v += __shfl_xor(v, 8); v += __shfl_xor(v, 16); v += __shfl_xor(v, 32); o8[q][i] = v; ssw[q] += v * v; }
        ssw[q] += __shfl_xor(ssw[q], 1); ssw[q] += __shfl_xor(ssw[q], 2); ssw[q] += __shfl_xor(ssw[q], 4);
    }
    if (lane == 0) { ssb[h] = ssw[0]; ssb[8 + h] = ssw[1]; }
    __syncthreads();
#pragma unroll
    for (int q = 0; q < 2; ++q) {
        float tot = 0.f;
#pragma unroll
        for (int j = 0; j < NH; ++j) tot += ssb[8 * q + j];
        const float rs = 1.0f / sqrtf(tot * (1.f / AW) + EPS);
        if (cg == 0) { float e[8];
#pragma unroll
            for (int i = 0; i < 8; ++i) e[i] = o8[q][i] * rs;
            *(GAS v4u*)((bf16*)(ws + WS_MIX) + (size_t)(r0 + q) * DM + h * VH + 8 * dq) = pack8(e); }
    }
    __syncthreads();
}

__device__ __forceinline__ f32x16 skinny_tile(LAS unsigned char* wl  , const bf16* A, int lda, const bf16* Bt, int ldb, int row0, int col0, int kbeg, int kend, int lane) {
    const int r32 = lane & 31, hi = lane >> 5, lr = lane >> 3, lc = lane & 7;
    const GAS unsigned char* ap = (const GAS unsigned char*)(A + (size_t)(row0 + lr) * lda + kbeg) + 16 * lc;
    const GAS unsigned char* bp = (const GAS unsigned char*)(Bt + (size_t)(col0 + lr) * ldb + kbeg) + 16 * lc;
    const size_t astep = (size_t)8 * lda * 2, bstep = (size_t)8 * ldb * 2;
    f32x16 acc;
#pragma unroll
    for (int r = 0; r < 16; ++r) acc[r] = 0.f;
    v4u ra[4], rb[4];
#pragma unroll
    for (int j = 0; j < 4; ++j) { ra[j] = *(const GAS v4u*)(ap + j * astep); rb[j] = *(const GAS v4u*)(bp + j * bstep); }
    const int nit = (kend - kbeg) >> 6;
    LAS unsigned char* wst = wl + lr * 144 + lc * 16;
    const LAS unsigned char* rfa = wl + r32 * 144 + hi * 16;
#pragma unroll 1
    for (int it = 0; it < nit; ++it) {
#pragma unroll
        for (int j = 0; j < 4; ++j) { *(LAS v4u*)(wst + j * (8 * 144)) = ra[j]; *(LAS v4u*)(wst + 4608 + j * (8 * 144)) = rb[j]; }
        if (it + 1 < nit) {
#pragma unroll
            for (int j = 0; j < 4; ++j) { ra[j] = *(const GAS v4u*)(ap + (size_t)(it + 1) * 128 + j * astep); rb[j] = *(const GAS v4u*)(bp + (size_t)(it + 1) * 128 + j * bstep); } }
        bf16x8 a[4], b[4];
#pragma unroll
        for (int s4 = 0; s4 < 4; ++s4) { a[s4] = *(const LAS bf16x8*)(rfa + 32 * s4); b[s4] = *(const LAS bf16x8*)(rfa + 4608 + 32 * s4); }
#pragma unroll
        for (int s4 = 0; s4 < 4; ++s4) acc = MFMA32(a[s4], b[s4], acc);
    }
    return acc;
}
__device__ __forceinline__ f32x16 coop_tile(LAS unsigned char* img  , const bf16* A, int lda, const bf16* Bt, int ldb, int row0, int col0, int K, int tid, int wave) {
    const int lane = tid & 63, r32 = lane & 31, hi = lane >> 5, lr = tid >> 3, lc = tid & 7;
    const GAS unsigned char* ap = (const GAS unsigned char*)(A + (size_t)(row0 + lr) * lda) + 16 * lc;
    const GAS unsigned char* bp = (const GAS unsigned char*)(Bt + (size_t)(col0 + lr) * ldb) + 16 * lc;
    const size_t bstep = (size_t)64 * ldb * 2;
    constexpr int STG = 192 * 144;
    LAS unsigned char* wst = img + lr * 144 + lc * 16;
    const LAS unsigned char* rfa = img + (32 * (wave >> 2) + r32) * 144 + hi * 16;
    const LAS unsigned char* rfb = img + 9216 + (32 * (wave & 3) + r32) * 144 + hi * 16;
    f32x16 acc;
#pragma unroll
    for (int r = 0; r < 16; ++r) acc[r] = 0.f;
    v4u r0[3], r1[3];
#define CT_LOAD(R, blk) do { const size_t ko_ = (size_t)(blk) * 128; R[0] = *(const GAS v4u*)(ap + ko_); R[1] = *(const GAS v4u*)(bp + ko_); R[2] = *(const GAS v4u*)(bp + bstep + ko_); } while (0)
#define CT_PUT(R, st) do { *(LAS v4u*)(wst + (st) * STG) = R[0]; *(LAS v4u*)(wst + (st) * STG + 9216) = R[1]; *(LAS v4u*)(wst + (st) * STG + 9216 + 64 * 144) = R[2]; } while (0)
#define CT_MMA(st) do { bf16x8 a[4], b[4]; \
        _Pragma("unroll") \
        for (int s4 = 0; s4 < 4; ++s4) { a[s4] = *(const LAS bf16x8*)(rfa + (st) * STG + 32 * s4); b[s4] = *(const LAS bf16x8*)(rfb + (st) * STG + 32 * s4); } \
        _Pragma("unroll") \
        for (int s4 = 0; s4 < 4; ++s4) acc = MFMA32(a[s4], b[s4], acc); } while (0)
    CT_LOAD(r0, 0); CT_LOAD(r1, 1);
    const int nit = K >> 6;
#pragma unroll 1
    for (int it = 0; it < nit; it += 2) {
        CT_PUT(r0, 0); if (it + 2 < nit) CT_LOAD(r0, it + 2);
        __syncthreads();
        CT_MMA(0);
        CT_PUT(r1, 1); if (it + 3 < nit) CT_LOAD(r1, it + 3);
        __syncthreads();
        CT_MMA(1);
    }
#undef CT_LOAD
#undef CT_PUT
#undef CT_MMA
    __syncthreads();
    return acc;
}
template <bool XCOPY> __device__ __forceinline__ void skinny_res_n1024(Frame& F, const bf16* A, int lda, const bf16* Bt, int K, const float* base, float* out, bf16* xb, float* rowss) {
    int tid_ = threadIdx.x; asm volatile("" : "+v"(tid_)); const int lane = tid_ & 63, wave = __builtin_amdgcn_readfirstlane(tid_ >> 6), r32 = lane & 31, hi = lane >> 5;
    const int t = 2 * blockIdx.x + (wave >> 2), kq = wave & 3; const int row0 = 32 * (t >> 5), col0 = 32 * (t & 31);
    LAS float* red = (LAS float*)(F.lds + RING_OFF);
    f32x16 acc;
#pragma unroll
    for (int r = 0; r < 16; ++r) acc[r] = 0.f;
    if (t < 512) acc = skinny_tile(F.lds + RING_OFF + 32768 + wave * 9216, A, lda, Bt, K, row0, col0, kq * (K >> 2), (kq + 1) * (K >> 2), lane);
    if (kq != 0) {
#pragma unroll
        for (int r = 0; r < 16; ++r) red[wave * 1024 + r * 64 + lane] = acc[r]; }
    __syncthreads();
    if (kq == 0 && t < 512) {
        float res[16];
#pragma unroll
        for (int r = 0; r < 16; ++r) { const size_t o = (size_t)(row0 + crow(r, hi)) * DM + col0 + r32; res[r] = XCOPY ? base[o] : __uint_as_float((unsigned)xb[o] << 16); }
#pragma unroll
        for (int r = 0; r < 16; ++r) { const float v = acc[r] + red[(wave + 1) * 1024 + r * 64 + lane] + red[(wave + 2) * 1024 + r * 64 + lane] + red[(wave + 3) * 1024 + r * 64 + lane];
            const size_t o = (size_t)(row0 + crow(r, hi)) * DM + col0 + r32;
            if (!XCOPY) { out[o] = res[r] + v; }
            else { const float x1 = res[r] + v; xb[o] = (bf16)(pk2(x1, 0.f) & 0xffffu); float q = x1 * x1; q += __shfl_xor(q, 1); q += __shfl_xor(q, 2); q += __shfl_xor(q, 4); q += __shfl_xor(q, 8); q += __shfl_xor(q, 16);
                if (r32 == 0) atomicAdd(rowss + row0 + crow(r, hi), q); } }
    }
    __syncthreads();
}
__device__ __forceinline__ void skinny_up(Frame& F, const bf16* A, const bf16* Bt, bf16* H, const float* rowss) {
    int tid_ = threadIdx.x; asm volatile("" : "+v"(tid_)); const int lane = tid_ & 63, wave = __builtin_amdgcn_readfirstlane(tid_ >> 6), r32 = lane & 31, hi = lane >> 5;
    const int c = blockIdx.x; if (c >= 256) return;
    const int row0 = 64 * (c >> 5) + 32 * (wave >> 2), col0 = 128 * (c & 31) + 32 * (wave & 3);
    const f32x16 acc = coop_tile(F.lds + RING_OFF, A, DM, Bt, DM, 64 * (c >> 5), 128 * (c & 31), DM, tid_, wave);
    float rq[16];
#pragma unroll
    for (int r = 0; r < 16; ++r) rq[r] = rowss[row0 + crow(r, hi)];
#pragma unroll
    for (int r = 0; r < 16; ++r) { const float a = acc[r] * __builtin_amdgcn_rsqf(rq[r] * (1.0f / 1024.0f) + 1e-6f); const float v = a > 0.f ? a : 0.f; H[(size_t)(row0 + crow(r, hi)) * DFF + col0 + r32] = (bf16)(pk2(v * v, 0.f) & 0xffffu); }
}

__device__ __forceinline__ void p1_leftover(const Params& P, Frame& F) {
    unsigned char* ws = P.ws;
    int tid_ = threadIdx.x; asm volatile("" : "+v"(tid_)); const int lane = tid_ & 63, wave = __builtin_amdgcn_readfirstlane(tid_ >> 6), r32 = lane & 31, hi = lane >> 5;
    const bf16* XN = (const bf16*)(ws + WS_XN); const bf16* WIN = (const bf16*)(ws + WS_WIN); bf16* Z = (bf16*)(ws + WS_Z);
    for (int ta = blockIdx.x; ta < 256 + 9 * 18; ta += gridDim.x) {
        int R0, C0; if (ta < 256) { R0 = 64 * ta; C0 = 2048; } else { const int u = ta - 256; R0 = MP + 64 * (u / 18); C0 = 128 * (u % 18); }
        const f32x16 acc = coop_tile(F.lds + RING_OFF, XN, DM, WIN, DM, R0, C0, DM, tid_, wave);
        const int row0 = R0 + 32 * (wave >> 2), col0 = C0 + 32 * (wave & 3);
#pragma unroll
        for (int r = 0; r < 16; ++r) Z[(size_t)(row0 + crow(r, hi)) * INWP + col0 + r32] = (bf16)(pk2(acc[r], 0.f) & 0xffffu);
    }
    LAS float* red = (LAS float*)(F.lds + RING_OFF);
    for (int tc = blockIdx.x; tc < MP / 64; tc += gridDim.x) {
        const int row0 = 64 * tc + 32 * (wave >> 2), kq = wave & 3;
        const f32x16 acc = skinny_tile(F.lds + RING_OFF + 32768 + wave * 9216, XN, DM, WIN, DM, row0, 2176, 256 * kq, 256 * (kq + 1), lane);
        if (kq != 0) {
#pragma unroll
            for (int r = 0; r < 16; ++r) red[wave * 1024 + r * 64 + lane] = acc[r]; }
        __syncthreads();
        if (kq == 0) {
#pragma unroll
            for (int r = 0; r < 16; ++r) { const float v = acc[r] + red[(wave + 1) * 1024 + r * 64 + lane] + red[(wave + 2) * 1024 + r * 64 + lane] + red[(wave + 3) * 1024 + r * 64 + lane];
                Z[(size_t)(row0 + crow(r, hi)) * INWP + 2176 + r32] = (bf16)(pk2(v, 0.f) & 0xffffu); } }
        __syncthreads();
    }
}

struct EpiKV {
    static constexpr bool PERM = true, AFTER_DRAIN = false, HAS_MID = false;
    bf16* KV; bf16* K; const float* kper; const float* kss; const float* g; LAS float* ex;
    __device__ __forceinline__ void operator()(const pg8::f32x4 (&acc)[2][2][4][2], const pg8::Unit& u, int wr_in, int wc_in, int fr_in, int fq_in) const {
        int wr = wr_in, wc = wc_in, fr = fr_in, fq = fq_in; asm volatile("" : "+s"(wr), "+s"(wc), "+v"(fr), "+v"(fq));
        const bool kpart = wc < 2;
        const int rowb = u.pm * 256 + wr * 64 + fr;
        if (kpart) {
#pragma unroll
            for (int ai = 0; ai < 2; ++ai)
#pragma unroll
                for (int m = 0; m < 4; ++m)
#pragma unroll
                    for (int bj = 0; bj < 2; ++bj) { const pg8::f32x4 a0 = acc[ai][bj][m][0], a1 = acc[ai][bj][m][1];
                        float ss = ((a0[0] * a0[0] + a0[1] * a0[1]) + (a0[2] * a0[2] + a0[3] * a0[3])) + ((a1[0] * a1[0] + a1[1] * a1[1]) + (a1[2] * a1[2] + a1[3] * a1[3]));
                        { auto r16 = __builtin_amdgcn_permlane16_swap(__float_as_uint(ss), __float_as_uint(ss), false, false); ss = __uint_as_float(r16[0]) + __uint_as_float(r16[1]);
                          auto r32 = __builtin_amdgcn_permlane32_swap(__float_as_uint(ss), __float_as_uint(ss), false, false); ss = __uint_as_float(r32[0]) + __uint_as_float(r32[1]); }
                        if (fq == 0) ex[((((wr * 2 + wc) * 2 + ai) * 4 + m) * 2 + bj) * 16 + fr] = ss; }
        } else {
            const int col0 = u.pn * 256 + wc * 32 + 8 * fq;
#pragma unroll
            for (int ai = 0; ai < 2; ++ai)
#pragma unroll
                for (int m = 0; m < 4; ++m) { bf16* rowp = KV + (size_t)(rowb + ai * 128 + m * 16) * 1024 + col0;
#pragma unroll
                    for (int bj = 0; bj < 2; ++bj) { const pg8::f32x4 v0 = acc[ai][bj][m][0], v1 = acc[ai][bj][m][1];
                        v4u w; w.x = pk2(v0[0], v0[1]); w.y = pk2(v0[2], v0[3]); w.z = pk2(v1[0], v1[1]); w.w = pk2(v1[2], v1[3]);
                        pg8::st_wt16(rowp + bj * 128, w); } }
        }
        asm volatile("s_waitcnt lgkmcnt(0)" ::: "memory"); __builtin_amdgcn_s_barrier(); asm volatile("" ::: "memory");
        const bool prompt = u.pm < MP / 256;
        if (!prompt && u.pm != MR / 256) return;
        const int d0 = kpart ? 32 * wc + 8 * fq : 64 + 8 * fq;
        const int nrep = prompt ? 1 : NB;
        const int bjr = wc & 1;
        const LAS float* exr = ex + wr * 512 + fr;
        float ksv[2][4];
#pragma unroll
        for (int ai = 0; ai < 2; ++ai)
#pragma unroll
            for (int m = 0; m < 4; ++m) ksv[ai][m] = kss[rowb + ai * 128 + m * 16];
#pragma unroll
        for (int ai = 0; ai < 2; ++ai) {
            const pg8::f32x4 g0 = *(const GAS pg8::f32x4*)(g + d0), g1 = *(const GAS pg8::f32x4*)(g + d0 + 4);
            pg8::f32x4 kp[4][2];
            if (!kpart) {
#pragma unroll
                for (int m = 0; m < 4; ++m) { const float* kr = kper + (size_t)(rowb + ai * 128 + m * 16) * QKR + 8 * fq; kp[m][0] = *(const GAS pg8::f32x4*)kr; kp[m][1] = *(const GAS pg8::f32x4*)(kr + 4); }
            }
#pragma unroll
            for (int m = 0; m < 4; ++m) { const int row = rowb + ai * 128 + m * 16;
                const bool rv = prompt || row < MR + NMETA;
                const float ks = ksv[ai][m];
                const int kofs = (prompt ? ((row >> 11) * TPP + NMETA + (row & 2047)) : (row - MR)) * 768 + 2 * u.pn * QKH + d0;
                if (kpart) {
#pragma unroll
                    for (int bj = 0; bj < 2; ++bj) {
                        const float tot = exr[(ai * 4 + m) * 32 + bj * 16] + exr[256 + (ai * 4 + m) * 32 + bj * 16] + ks;
                        const float rs = __builtin_amdgcn_rsqf(tot * (1.f / QKH) + EPS);
                        const pg8::f32x4 v0 = acc[ai][bj][m][0] * rs * g0, v1 = acc[ai][bj][m][1] * rs * g1;
                        v4u w; w.x = pk2(v0[0], v0[1]); w.y = pk2(v0[2], v0[3]); w.z = pk2(v1[0], v1[1]); w.w = pk2(v1[2], v1[3]);
                        if (rv) for (int b = 0; b < nrep; ++b) *(GAS v4u*)(K + (size_t)(kofs + bj * QKH) + (size_t)b * (TPP * 768)) = w; }
                } else {
                    const float tot = exr[(ai * 4 + m) * 32 + bjr * 16] + exr[256 + (ai * 4 + m) * 32 + bjr * 16] + ks;
                    const float rs = __builtin_amdgcn_rsqf(tot * (1.f / QKH) + EPS);
                    const pg8::f32x4 v0 = kp[m][0] * rs * g0, v1 = kp[m][1] * rs * g1;
                    v4u w; w.x = pk2(v0[0], v0[1]); w.y = pk2(v0[2], v0[3]); w.z = pk2(v1[0], v1[1]); w.w = pk2(v1[2], v1[3]);
                    if (rv) for (int b = 0; b < nrep; ++b) *(GAS v4u*)(K + (size_t)(kofs + bjr * QKH) + (size_t)b * (TPP * 768)) = w;
                }
            }
            asm volatile("" ::: "memory");
        }
    }
};

__global__ void __launch_bounds__(NWAVES * 64, 2) hymba_fwd(Params P) {
    extern __shared__ __attribute__((aligned(16))) unsigned char lds_raw[];
    Frame F;
    F.lds = (LAS unsigned char*)lds_raw;
    F.MISC = (volatile LAS unsigned*)(F.lds + MISC_OFF);
    F.tid = threadIdx.x; F.lane = F.tid & 63; F.wave = __builtin_amdgcn_readfirstlane(F.tid >> 6);
    F.G = gridDim.x; F.gw = blockIdx.x * NWAVES + F.wave; F.NGW = F.G * NWAVES;
    unsigned char* ws = P.ws;
    F.ctl = (gu32*)(ws + WS_CTL);
    for (int u = F.tid; u < (LDS_BYTES - LDSCTL_OFF) / 4; u += NWAVES * 64) ((LAS unsigned*)(F.lds + LDSCTL_OFF))[u] = 0u;
    __syncthreads();
    const bool multi = (P.ph_hi - P.ph_lo) > 1;
    XcdBarrier bar; bar.bar = (unsigned*)(F.ctl + CW_BAR); bar.x = 0; bar.st = nullptr;
    if (multi) bar = xcd_barrier_post((unsigned*)(F.ctl + CW_BAR), F.MISC + 8);
    const int lo = P.ph_lo, hi = P.ph_hi;
#define REFRESH() do { int t_ = threadIdx.x; asm volatile("" : "+v"(t_)); F.tid = t_; F.lane = t_ & 63; F.wave = __builtin_amdgcn_readfirstlane(t_ >> 6); F.gw = blockIdx.x * NWAVES + F.wave; } while (0)
#ifndef PHM
#define PHM 0x7ff
#endif
#ifndef PROBE_REP
#define PROBE_REP 0
#endif
#define DUP(k) (IN(k) && ((PROBE_REP >> (k)) & 1))
#define IN(k) (((PHM >> (k)) & 1) && lo <= (k) && (k) < hi)
#define SEAM(k) do { if (IN(k) && IN((k) + 1)) xcd_barrier(bar); } while (0)

    if (IN(0)) { REFRESH(); p0_prologue(P, F); } if (DUP(0)) { REFRESH(); p0_prologue(P, F); } SEAM(0);
    if (IN(1)) {
        pg8::Gemm g{(const bf16*)(ws + WS_XN), (const bf16*)(ws + WS_WIN), MP, 2048, DM}; pg8::StaticOrder S; S.init(MP, 2048, F.G, (int)blockIdx.x);
        pg8::EpiBf16<0> E{(bf16*)(ws + WS_Z), INWP, nullptr, 4};
        const bool early = ((blockIdx.x >> 3) & 1) != 0;
        if (early) { p1_leftover(P, F); __syncthreads(); REFRESH(); p0_late(P, F, F.gw, F.NGW); __syncthreads(); }
        pg8::gemm_phase<pg8::EpiBf16<0>, pg8::StaticOrder, true, true>(F.lds + RING_OFF, g, S, E);
        __syncthreads();
        if (!early) {
        p1_leftover(P, F);
        __syncthreads(); REFRESH(); p0_late(P, F, F.gw, F.NGW);
        }
    }
    SEAM(1);
    if (IN(2)) { REFRESH(); for (int r = F.gw; r < MALL; r += F.NGW) p2a_row(P, F, r); } if (DUP(2)) { REFRESH(); for (int r = F.gw; r < MALL; r += F.NGW) p2a_row(P, F, r); } SEAM(2);
    if (IN(3)) {
        { pg8::Gemm g{(const bf16*)(ws + WS_CQN), (const bf16*)(ws + WS_WUQ), MR, 768, QL}; pg8::StaticOrder S; S.init(MR, 768, F.G, (int)blockIdx.x);
          pg8::EpiBf16<0> E{(bf16*)(ws + WS_QRAW), 768, nullptr, 0};
          pg8::gemm_phase<pg8::EpiBf16<0>, pg8::StaticOrder, true, true>(F.lds + RING_OFF, g, S, E); }
        __syncthreads();
        { pg8::Gemm g{(const bf16*)(ws + WS_LATB), (const bf16*)(ws + WS_WUKV), MPAD, 1024, KVL}; pg8::StaticOrder S; S.init(MPAD, 1024, F.G, (int)((blockIdx.x + 58) % F.G));
          EpiKV E{(bf16*)(ws + WS_KVRAW), (bf16*)(ws + WS_K), (const float*)(ws + WS_KPER), (const float*)(ws + WS_KSS), P.k_norm_g, (LAS float*)(F.lds + RING_OFF + RING_BYTES)};
          pg8::gemm_phase<EpiKV, pg8::StaticOrder, true, true>(F.lds + RING_OFF, g, S, E); }
    }
    SEAM(4);
    if (IN(5)) { REFRESH(); p3_attention(P, F); } SEAM(5);
    if (IN(6)) { REFRESH();
        { const int i = (int)blockIdx.x * 512 + F.tid; if (i < MP) { const f32x4 a = ((const GAS f32x4*)(ws + WS_SSQ))[2 * i], c = ((const GAS f32x4*)(ws + WS_SSQ))[2 * i + 1];
            ((float*)(ws + WS_RSA))[i] = 1.0f / sqrtf(((a.x + a.y) + (a.z + a.w) + (c.x + c.y) + (c.z + c.w)) * (1.f / AW) + EPS); } }
        p4a_sample(P, F); } SEAM(6);
    if (IN(7)) {
        pg8::Gemm g{(const bf16*)(ws + WS_MIX), (const bf16*)(ws + WS_WO), MP, DM, DM}; pg8::StaticOrder S; S.init(MP, DM, F.G, (int)blockIdx.x);
        pg8::EpiF32ResX E{P.x_prompt, (bf16*)(ws + WS_XN), (float*)(ws + WS_ROWSS), DM, (const float*)(ws + WS_RSA)};
        const bool early = ((blockIdx.x >> 3) & 1) != 0;
        if (early) skinny_res_n1024<true>(F, (const bf16*)(ws + WS_MIX) + (size_t)MP * DM, DM, (const bf16*)(ws + WS_WO), DM, P.x_sample, nullptr, (bf16*)(ws + WS_XN) + (size_t)MP * DM, (float*)(ws + WS_ROWSS) + MP);
        pg8::gemm_phase<pg8::EpiF32ResX, pg8::StaticOrder, true, true>(F.lds + RING_OFF, g, S, E);
        __syncthreads();
        if (!early) skinny_res_n1024<true>(F, (const bf16*)(ws + WS_MIX) + (size_t)MP * DM, DM, (const bf16*)(ws + WS_WO), DM, P.x_sample, nullptr, (bf16*)(ws + WS_XN) + (size_t)MP * DM, (float*)(ws + WS_ROWSS) + MP);
    }
    SEAM(7);
    if (IN(9)) {
        pg8::Gemm g{(const bf16*)(ws + WS_XN), (const bf16*)(ws + WS_WUP), MP, DFF, DM}; pg8::StaticOrder S; S.init(MP, DFF, F.G, (int)blockIdx.x);
        pg8::EpiBf16<2> E{(bf16*)(ws + WS_H), DFF, (const float*)(ws + WS_ROWSS), 12};
        const bool early = ((blockIdx.x >> 3) & 1) != 0;
        if (early) { skinny_up(F, (const bf16*)(ws + WS_XN) + (size_t)MP * DM, (const bf16*)(ws + WS_WUP), (bf16*)(ws + WS_H) + (size_t)MP * DFF, (const float*)(ws + WS_ROWSS) + MP); __syncthreads(); }
        pg8::gemm_phase<pg8::EpiBf16<2>, pg8::StaticOrder, true, true>(F.lds + RING_OFF, g, S, E);
        __syncthreads();
        if (!early) skinny_up(F, (const bf16*)(ws + WS_XN) + (size_t)MP * DM, (const bf16*)(ws + WS_WUP), (bf16*)(ws + WS_H) + (size_t)MP * DFF, (const float*)(ws + WS_ROWSS) + MP);
    }
    SEAM(9);
    if (IN(10)) {
        pg8::Gemm g{(const bf16*)(ws + WS_H), (const bf16*)(ws + WS_WDN), MP, DM, DFF}; pg8::StaticOrder S; S.init(MP, DM, F.G, (int)blockIdx.x);
        pg8::EpiF32ResB E{(const bf16*)(ws + WS_XN), P.out + O_YP, DM};
        const bool early = ((blockIdx.x >> 3) & 1) != 0;
        if (early) skinny_res_n1024<false>(F, (const bf16*)(ws + WS_H) + (size_t)MP * DFF, DFF, (const bf16*)(ws + WS_WDN), DFF, nullptr, P.out + O_YS, (bf16*)(ws + WS_XN) + (size_t)MP * DM, nullptr);
        pg8::gemm_phase<pg8::EpiF32ResB, pg8::StaticOrder, true, true>(F.lds + RING_OFF, g, S, E);
        __syncthreads();
        if (!early) skinny_res_n1024<false>(F, (const bf16*)(ws + WS_H) + (size_t)MP * DFF, DFF, (const bf16*)(ws + WS_WDN), DFF, nullptr, P.out + O_YS, (bf16*)(ws + WS_XN) + (size_t)MP * DM, nullptr);
    }
#undef IN
#undef SEAM
}

extern "C" void kernel_launch(void* const* d_in, const int* in_sizes, int n_in, void* d_out, int out_size, void* d_ws, size_t ws_size, hipStream_t stream) {
    static int grid = 0;
    if (grid == 0) {
        if (n_in != 23 || (size_t)out_size != O_END || ws_size < WS_END) { fprintf(stderr, "kernel_launch: unexpected shapes (n_in %d out %d ws %zu)\n", n_in, out_size, ws_size); grid = -1; return; }
        int dev = 0, cus = 0, per_cu = 0;
        if (hipGetDevice(&dev) != hipSuccess || hipDeviceGetAttribute(&cus, hipDeviceAttributeMultiprocessorCount, dev) != hipSuccess) { grid = -1; return; }
        if (hipFuncSetAttribute((const void*)hymba_fwd, hipFuncAttributeMaxDynamicSharedMemorySize, LDS_BYTES) != hipSuccess) { fprintf(stderr, "kernel_launch: hipFuncSetAttribute failed\n"); grid = -1; return; }
        if (hipOccupancyMaxActiveBlocksPerMultiprocessor(&per_cu, (const void*)hymba_fwd, NWAVES * 64, LDS_BYTES) != hipSuccess || per_cu < 1) fprintf(stderr, "kernel_launch: occupancy query reports %d\n", per_cu);
        (void)hipGetLastError();
        grid = cus;
    }
    if (grid < 0) return;
    if (hipMemsetAsync((char*)d_ws + WS_CTL, 0, CTL_ZERO_BYTES, stream) != hipSuccess) return;
    Params p{};
    p.x_prompt = (const float*)d_in[0]; p.x_sample = (const float*)d_in[1]; p.cache_lat = (const float*)d_in[2]; p.cache_kpe = (const float*)d_in[3]; p.state_conv = (const float*)d_in[4];
    p.page_table = (const int*)d_in[5]; p.meta = (const float*)d_in[6]; p.norm_mix_g = (const float*)d_in[7]; p.w_in = (const float*)d_in[8]; p.q_lora_g = (const float*)d_in[9];
    p.kv_lora_g = (const float*)d_in[10]; p.w_uq = (const float*)d_in[11]; p.w_ukv = (const float*)d_in[12]; p.q_norm_g = (const float*)d_in[13]; p.k_norm_g = (const float*)d_in[14];
    p.conv_w = (const float*)d_in[15]; p.conv_b = (const float*)d_in[16]; p.attn_out_g = (const float*)d_in[17]; p.conv_out_g = (const float*)d_in[18]; p.w_o = (const float*)d_in[19];
    p.norm_ffn_g = (const float*)d_in[20]; p.w_up = (const float*)d_in[21]; p.w_down = (const float*)d_in[22];
    p.out = (float*)d_out; p.ws = (unsigned char*)d_ws;
#if MK_N_LAUNCHES == 1
    p.ph_lo = 0; p.ph_hi = N_PHASES; p.li = 0; p.pad = 0;
    hipLaunchKernelGGL(hymba_fwd, dim3(grid), dim3(NWAVES * 64), LDS_BYTES, stream, p);
#else
    for (int li = 0; li < N_PHASES; ++li) { p.ph_lo = li; p.ph_hi = li + 1; p.li = li; p.pad = 0;
        hipLaunchKernelGGL(hymba_fwd, dim3(grid), dim3(NWAVES * 64), LDS_BYTES, stream, p); }
#endif
}
```
